# Optimizing an MI355X kernel written in HIP

```python
import math
import jax, jax.numpy as jnp
from jax import lax
import numpy as np

D_MODEL = 1024
BATCH = 8
SEQ = 4096
DEPTH = 2

CTX_LEN = 256
GRID_W = 64

MIX_W = D_MODEL
N_GROUPS = 4
GROUP_W = MIX_W // N_GROUPS
IN_W = 8 * GROUP_W

NA_HEADS = 4
NA_HEAD_DIM = GROUP_W // NA_HEADS
NA_ROWS = 8
NA_COLS = 16

CONV_K = 3

FOURIER_HEADS = 4
FOURIER_DIM = GROUP_W // FOURIER_HEADS

S5_CH = 16
S5_GROUPS = GROUP_W // S5_CH
S5_STATE = 64

PEER_HEADS = 8
PEER_KEYS = 128
PEER_EXPERTS = PEER_KEYS * PEER_KEYS
PEER_TOPK = 16
PEER_QDIM = 256
PEER_HALF = PEER_QDIM // 2
PEER_CHUNK = 128

N_MOD = 6
EPS = 1e-6
NEG = -1e30

kernel_name = "hybrid_natten_conv_fnet_s5_peer_dit"


def rmsnorm(x, g):
    xf = x.astype(jnp.float32)
    y = xf * lax.rsqrt(jnp.mean(xf * xf, axis=-1, keepdims=True) + EPS)
    return y.astype(x.dtype) * g


def split_heads(t, n):
    b, l, _ = t.shape
    return t.reshape(b, l, n, -1).transpose(0, 2, 1, 3)


def neighbourhood_attention(q, k, v, q_c, k_c, v_c, rpb):
    b, s, _ = q.shape
    rows = s // GRID_W
    wr = min(NA_ROWS, rows)
    wc = min(NA_COLS, GRID_W)
    scale = NA_HEAD_DIM ** -0.5
    qg = split_heads(q, NA_HEADS).reshape(b, NA_HEADS, rows, GRID_W, NA_HEAD_DIM)
    kg = split_heads(k, NA_HEADS).reshape(b, NA_HEADS, rows, GRID_W, NA_HEAD_DIM)
    vg = split_heads(v, NA_HEADS).reshape(b, NA_HEADS, rows, GRID_W, NA_HEAD_DIM)
    kh_c = split_heads(k_c, NA_HEADS)
    vh_c = split_heads(v_c, NA_HEADS)

    r = jnp.arange(rows)
    col = jnp.arange(GRID_W)
    row_start = jnp.clip(r - wr // 2, 0, rows - wr)
    key_rows = row_start[:, None] + jnp.arange(wr)[None, :]
    col_start = jnp.clip(col - wc // 2, 0, GRID_W - wc)
    nk = wr * GRID_W
    k_blk = kg[:, :, key_rows].reshape(b, NA_HEADS, rows, nk, NA_HEAD_DIM)
    v_blk = vg[:, :, key_rows].reshape(b, NA_HEADS, rows, nk, NA_HEAD_DIM)
    key_col = jnp.broadcast_to(col[None, :], (wr, GRID_W)).reshape(nk)
    col_ok = (key_col[None, :] >= col_start[:, None]) & (key_col[None, :] < col_start[:, None] + wc)
    d_row = jnp.repeat(key_rows, GRID_W, axis=1) - r[:, None]
    d_col = jnp.clip(key_col[None, :] - col[:, None], -(NA_COLS - 1), NA_COLS - 1)
    bias = rpb[:, (d_row + NA_ROWS - 1)[:, None, :], (d_col + NA_COLS - 1)[None, :, :]]

    s_lat = jnp.einsum('bhrqd,bhrkd->bhrqk', qg, k_blk).astype(jnp.float32) * scale + bias.astype(jnp.float32)
    s_lat = jnp.where(col_ok, s_lat, NEG)
    s_ctx = jnp.einsum('bhrqd,bhcd->bhrqc', qg, kh_c).astype(jnp.float32) * scale
    p = jax.nn.softmax(jnp.concatenate([s_lat, s_ctx], axis=-1), axis=-1).astype(q.dtype)
    o = (jnp.einsum('bhrqk,bhrkd->bhrqd', p[..., :nk], v_blk)
         + jnp.einsum('bhrqc,bhcd->bhrqd', p[..., nk:], vh_c))
    o = o.transpose(0, 2, 3, 1, 4).reshape(b, s, GROUP_W)

    o_c = None
    if q_c is not None:
        lc = q_c.shape[1]
        qh_c = split_heads(q_c, NA_HEADS)
        s_cc = jnp.einsum('bhqd,bhkd->bhqk', qh_c, kh_c).astype(jnp.float32) * scale
        p_cc = jax.nn.softmax(s_cc, axis=-1).astype(q_c.dtype)
        o_c = jnp.einsum('bhqk,bhkd->bhqd', p_cc, vh_c).transpose(0, 2, 1, 3).reshape(b, lc, GROUP_W)
    return o, o_c


def short_gated_conv(gate_b, gate_c, xin, conv_w):
    z = gate_c * xin
    z = lax.conv_general_dilated(z, conv_w[:, None, :], window_strides=(1,),
                                 padding=((CONV_K // 2, CONV_K // 2),),
                                 dimension_numbers=('NWC', 'WIO', 'NWC'),
                                 feature_group_count=GROUP_W)
    return gate_b * z


def fourier_mix(z):
    b, l, _ = z.shape
    zz = z.astype(jnp.float32).reshape(b, l, FOURIER_HEADS, FOURIER_DIM)
    f = jnp.fft.fft2(zz, axes=(1, 3), norm='ortho').real
    return f.reshape(b, l, GROUP_W).astype(z.dtype)


def _linear_combine(e1, e2):
    a1, b1 = e1
    a2, b2 = e2
    return a1 * a2, a2 * b1 + b2


def s5_bidirectional(u, u_c, a_re, a_im, b_re, b_im, c_re, c_im, log_dt, d_skip, w_glu, ctx_out):
    f32 = jnp.float32
    A = lax.complex(a_re.astype(f32), a_im.astype(f32))
    dt = jnp.exp(log_dt.astype(f32))[..., None]
    a_bar = jnp.exp(A * dt)
    b_bar = ((a_bar - 1.0) / A)[..., None] * lax.complex(b_re.astype(f32), b_im.astype(f32))
    c_mat = lax.complex(c_re.astype(f32), c_im.astype(f32))

    def drive(t, dr):
        bz, l, _ = t.shape
        tg = t.astype(f32).reshape(bz, l, S5_GROUPS, S5_CH).astype(jnp.complex64)
        return jnp.einsum('blgh,gph->lbgp', tg, b_bar[dr])

    def scan(bseq, dr, reverse):
        a = jnp.broadcast_to(a_bar[dr][None, None], (bseq.shape[0], 1) + a_bar.shape[1:])
        _, h = lax.associative_scan(_linear_combine, (a, bseq), reverse=reverse)
        return h

    def readout(h, dr):
        return jnp.einsum('lbgp,ghp->blgh', h, c_mat[dr]).real

    def finish(t, y):
        bz, l, _ = t.shape
        y = y.reshape(bz, l, GROUP_W) + d_skip.astype(f32) * t.astype(f32)
        g = jax.nn.gelu(y)
        return (g * jax.nn.sigmoid(g @ w_glu.astype(f32))).astype(t.dtype)

    hf_c = scan(drive(u_c, 0), 0, False)
    hb_c = scan(drive(u_c, 1), 1, True)
    bf = drive(u, 0).at[0].add(a_bar[0] * hf_c[-1])
    bb = drive(u, 1).at[-1].add(a_bar[1] * hb_c[0])
    y_x = finish(u, readout(scan(bf, 0, False), 0) + readout(scan(bb, 1, True), 1))
    y_c = finish(u_c, readout(hf_c, 0) + readout(hb_c, 1)) if ctx_out else None
    return y_x, y_c


def peer_ffn(h, wq, keys, u, v):
    bz, l, d = h.shape
    t = bz * l
    ht = h.reshape(t, d)
    q = (ht @ wq).reshape(t, PEER_HEADS, 2, PEER_HALF)
    s = jnp.einsum('thzd,hznd->thzn', q, keys).astype(jnp.float32)
    s1, i1 = lax.top_k(s[:, :, 0], PEER_TOPK)
    s2, i2 = lax.top_k(s[:, :, 1], PEER_TOPK)
    cand = (s1[..., :, None] + s2[..., None, :]).reshape(t, PEER_HEADS, PEER_TOPK * PEER_TOPK)
    cidx = (i1[..., :, None] * PEER_KEYS + i2[..., None, :]).reshape(t, PEER_HEADS, PEER_TOPK * PEER_TOPK)
    top, pos = lax.top_k(cand, PEER_TOPK)
    eidx = jnp.take_along_axis(cidx, pos, axis=-1)
    gate = jax.nn.softmax(top, axis=-1)
    n_chunks = t // PEER_CHUNK

    def chunk_fn(args):
        xc, ic, gc = args
        act = jax.nn.gelu(jnp.einsum('td,thkd->thk', xc, u[ic]).astype(jnp.float32)) * gc
        return jnp.einsum('thk,thkd->td', act.astype(xc.dtype), v[ic])

    out = lax.map(chunk_fn, (ht.reshape(n_chunks, PEER_CHUNK, d),
                             eidx.reshape(n_chunks, PEER_CHUNK, PEER_HEADS, PEER_TOPK),
                             gate.reshape(n_chunks, PEER_CHUNK, PEER_HEADS, PEER_TOPK)))
    return out.reshape(bz, l, d).astype(h.dtype)


def merge_groups(outs, grp_g, w_out):
    y = rmsnorm(jnp.stack(outs, axis=-2), grp_g)
    return y.reshape(y.shape[:-2] + (MIX_W,)) @ w_out


def hybrid_layer(x, ctx, c, c_ctx, ada_w, ada_b, norm1_g, norm2_g, w_in, na_rpb, conv_w,
                 s5_a_re, s5_a_im, s5_b_re, s5_b_im, s5_c_re, s5_c_im, s5_log_dt, s5_d, s5_w_glu,
                 grp_g, w_out, peer_wq, peer_keys, peer_u, peer_v, update_ctx):
    G = GROUP_W
    mod_x = (jax.nn.silu(c) @ ada_w + ada_b)[:, None, :]
    mod_c = (jax.nn.silu(c_ctx) @ ada_w + ada_b)[None, None, :]
    sh1, sc1, g1, sh2, sc2, g2 = jnp.split(mod_x, N_MOD, axis=-1)
    csh1, csc1, cg1, csh2, csc2, cg2 = jnp.split(mod_c, N_MOD, axis=-1)

    hx = rmsnorm(x, norm1_g) * (1.0 + sc1) + sh1
    hc = rmsnorm(ctx, norm1_g) * (1.0 + csc1) + csh1
    q, k, v, cb, cc, cx, fz, su = jnp.split(hx @ w_in, 8, axis=-1)
    if update_ctx:
        q_c, k_c, v_c, cb_c, cc_c, cx_c, fz_c, su_c = jnp.split(hc @ w_in, 8, axis=-1)
    else:
        q_c = None
        k_c = hc @ w_in[:, 1 * G:2 * G]
        v_c = hc @ w_in[:, 2 * G:3 * G]
        su_c = hc @ w_in[:, 7 * G:8 * G]

    att_x, att_c = neighbourhood_attention(q, k, v, q_c, k_c, v_c, na_rpb)
    conv_x = short_gated_conv(cb, cc, cx, conv_w)
    four_x = fourier_mix(fz)
    ssm_x, ssm_c = s5_bidirectional(su, su_c, s5_a_re, s5_a_im, s5_b_re, s5_b_im, s5_c_re, s5_c_im,
                                    s5_log_dt, s5_d, s5_w_glu, update_ctx)

    x = x + g1 * merge_groups([att_x, conv_x, four_x, ssm_x], grp_g, w_out)
    x = x + g2 * peer_ffn(rmsnorm(x, norm2_g) * (1.0 + sc2) + sh2, peer_wq, peer_keys, peer_u, peer_v)

    if update_ctx:
        conv_c = short_gated_conv(cb_c, cc_c, cx_c, conv_w)
        four_c = fourier_mix(fz_c)
        ctx = ctx + cg1 * merge_groups([att_c, conv_c, four_c, ssm_c], grp_g, w_out)
        ctx = ctx + cg2 * peer_ffn(rmsnorm(ctx, norm2_g) * (1.0 + csc2) + csh2,
                                   peer_wq, peer_keys, peer_u, peer_v)
    return x, ctx


def setup_inputs(seed: int = 0) -> dict:
    key = jax.random.key(seed)
    ks = iter(jax.random.split(key, 40))
    f32 = jnp.float32

    def nrm(shape, s):
        return jax.random.normal(next(ks), shape, f32) * s

    D = D_MODEL
    n_idx = jnp.arange(S5_STATE, dtype=f32)
    return {
        "x": nrm((BATCH, SEQ, D), 1.0),
        "c": nrm((BATCH, D), 1.0),
        "ctx": nrm((BATCH, CTX_LEN, D), 1.0),
        "c_ctx": nrm((D,), 1.0),
        "ada_w": nrm((DEPTH, D, N_MOD * D), 0.5 * D ** -0.5),
        "ada_b": nrm((DEPTH, N_MOD * D), 0.02),
        "norm1_g": 1.0 + nrm((DEPTH, D), 0.02),
        "norm2_g": 1.0 + nrm((DEPTH, D), 0.02),
        "w_in": nrm((DEPTH, D, IN_W), D ** -0.5),
        "na_rpb": nrm((DEPTH, NA_HEADS, 2 * NA_ROWS - 1, 2 * NA_COLS - 1), 0.02),
        "conv_w": nrm((DEPTH, CONV_K, GROUP_W), CONV_K ** -0.5),
        "s5_a_re": -0.5 + nrm((DEPTH, 2, S5_GROUPS, S5_STATE), 0.01),
        "s5_a_im": math.pi * n_idx + nrm((DEPTH, 2, S5_GROUPS, S5_STATE), 0.01),
        "s5_b_re": nrm((DEPTH, 2, S5_GROUPS, S5_STATE, S5_CH), (2.0 * S5_CH) ** -0.5),
        "s5_b_im": nrm((DEPTH, 2, S5_GROUPS, S5_STATE, S5_CH), (2.0 * S5_CH) ** -0.5),
        "s5_c_re": nrm((DEPTH, 2, S5_GROUPS, S5_CH, S5_STATE), (2.0 * S5_STATE) ** -0.5),
        "s5_c_im": nrm((DEPTH, 2, S5_GROUPS, S5_CH, S5_STATE), (2.0 * S5_STATE) ** -0.5),
        "s5_log_dt": jax.random.uniform(next(ks), (DEPTH, 2, S5_GROUPS), f32,
                                        minval=math.log(1e-3), maxval=math.log(1e-1)),
        "s5_d": nrm((DEPTH, GROUP_W), 1.0),
        "s5_w_glu": nrm((DEPTH, GROUP_W, GROUP_W), GROUP_W ** -0.5),
        "grp_g": 1.0 + nrm((DEPTH, N_GROUPS, GROUP_W), 0.02),
        "w_out": nrm((DEPTH, MIX_W, D), MIX_W ** -0.5),
        "peer_wq": nrm((DEPTH, D, PEER_HEADS * PEER_QDIM), D ** -0.5),
        "peer_keys": nrm((DEPTH, PEER_HEADS, 2, PEER_KEYS, PEER_HALF), PEER_HALF ** -0.5),
        "peer_u": nrm((DEPTH, PEER_EXPERTS, D), D ** -0.5),
        "peer_v": nrm((DEPTH, PEER_EXPERTS, D), 1.0),
        "final_g": 1.0 + nrm((D,), 0.02),
    }


def reference(x, c, ctx, c_ctx, ada_w, ada_b, norm1_g, norm2_g, w_in, na_rpb, conv_w,
              s5_a_re, s5_a_im, s5_b_re, s5_b_im, s5_c_re, s5_c_im, s5_log_dt, s5_d, s5_w_glu,
              grp_g, w_out, peer_wq, peer_keys, peer_u, peer_v, final_g):
    for i in range(DEPTH):
        x, ctx = hybrid_layer(x, ctx, c, c_ctx, ada_w[i], ada_b[i], norm1_g[i], norm2_g[i], w_in[i],
                              na_rpb[i], conv_w[i], s5_a_re[i], s5_a_im[i], s5_b_re[i], s5_b_im[i],
                              s5_c_re[i], s5_c_im[i], s5_log_dt[i], s5_d[i], s5_w_glu[i], grp_g[i],
                              w_out[i], peer_wq[i], peer_keys[i], peer_u[i], peer_v[i],
                              update_ctx=(i < DEPTH - 1))
    return rmsnorm(x, final_g)
```

```cpp
#include <hip/hip_runtime.h>
#include <hip/hip_cooperative_groups.h>
#include <cstdio>
#include <cstdint>
namespace cg = cooperative_groups;

#define NTHREADS 512
#ifndef SPLIT_LAUNCH
#define SPLIT_LAUNCH 0
#endif

typedef unsigned short bf16_t;
typedef __attribute__((ext_vector_type(8))) short bf16x8;
typedef __attribute__((ext_vector_type(4))) float f32x4;
typedef __attribute__((ext_vector_type(2))) __bf16 bf16x2_t;

constexpr int D = 1024, NB = 8, SEQ = 4096, T = NB * SEQ, CTXL = 256, TC = NB * CTXL, TT = T + TC;
constexpr int INW = 2048;
constexpr int NCHB = 136;
constexpr int NCH = NB * NCHB;
constexpr int NCHP = 1152;
constexpr int KV = 768;
constexpr float EPS = 1e-6f;

constexpr size_t al256(size_t x) { return (x + 255) & ~(size_t)255; }
constexpr size_t OFF_ACT = 0;                                   constexpr size_t SZ_ACT = (size_t)TT * 1024 * 2;
constexpr size_t OFF_XIN = al256(OFF_ACT + SZ_ACT);             constexpr size_t SZ_XIN = (size_t)TT * 2048 * 2;
constexpr size_t OFF_YMIX = al256(OFF_XIN + SZ_XIN);            constexpr size_t SZ_YMIX = (size_t)TT * 1024 * 2;
constexpr size_t OFF_XCTX = al256(OFF_YMIX + SZ_YMIX);          constexpr size_t SZ_XCTX = (size_t)TC * 1024 * 4;
constexpr size_t OFF_ZT = al256(OFF_XCTX + SZ_XCTX);            constexpr size_t SZ_ZT = (size_t)NB * 256 * 8192 * 2;
constexpr size_t OFF_ZTC = al256(OFF_ZT + SZ_ZT);               constexpr size_t SZ_ZTC = (size_t)NB * 256 * 512 * 2;
constexpr size_t OFF_VG = al256(OFF_ZTC + SZ_ZTC);              constexpr size_t SZ_VG = (size_t)16 * NCHP * KV * 2;
constexpr size_t OFF_SC = al256(OFF_VG + SZ_VG);                constexpr size_t SZ_SC = (size_t)16 * NCH * 256 * 4;
constexpr size_t OFF_GBUF = al256(OFF_SC + SZ_SC);              constexpr size_t SZ_GBUF = (size_t)TT * 256 * 2;
constexpr size_t OFF_DFTL = al256(OFF_GBUF + SZ_GBUF);          constexpr size_t SZ_DFTL = (size_t)4096 * 8192 * 2;
constexpr size_t OFF_DFTC = al256(OFF_DFTL + SZ_DFTL);          constexpr size_t SZ_DFTC = (size_t)256 * 512 * 2;
constexpr size_t OFF_DFTD = al256(OFF_DFTC + SZ_DFTC);          constexpr size_t SZ_DFTD = (size_t)128 * 64 * 2;
constexpr size_t SZ_WINT = (size_t)2048 * 1024 * 2, SZ_WOUTT = (size_t)1024 * 1024 * 2, SZ_WQKT = (size_t)2048 * 1024 * 2, SZ_WGLUT = (size_t)256 * 256 * 2;
constexpr size_t OFF_WINT = al256(OFF_DFTD + SZ_DFTD);
constexpr size_t OFF_WOUTT = al256(OFF_WINT + 2 * SZ_WINT);
constexpr size_t OFF_WQKT = al256(OFF_WOUTT + 2 * SZ_WOUTT);
constexpr size_t OFF_WGLUT = al256(OFF_WQKT + 2 * SZ_WQKT);
constexpr size_t OFF_WCOMB = al256(OFF_WGLUT + 2 * SZ_WGLUT);   constexpr size_t SZ_WCOMB = (size_t)16 * 512 * KV * 2;
constexpr size_t OFF_WST = al256(OFF_WCOMB + SZ_WCOMB);         constexpr size_t SZ_WST = (size_t)16 * 256 * 512 * 2;
constexpr size_t OFF_POWA = al256(OFF_WST + SZ_WST);            constexpr size_t SZ_POWA = (size_t)2 * 2 * 16 * 33 * 64 * 8;
constexpr size_t OFF_BBAR = al256(OFF_POWA + SZ_POWA);          constexpr size_t SZ_BBAR = (size_t)2 * 2 * 16 * 64 * 16 * 8;
constexpr size_t OFF_KTAU = al256(OFF_BBAR + SZ_BBAR);          constexpr size_t SZ_KTAU = (size_t)2 * 2 * 16 * 32 * 256 * 4;
constexpr size_t OFF_MOD = al256(OFF_KTAU + SZ_KTAU);           constexpr size_t SZ_MOD = (size_t)2 * 9 * 6144 * 4;
constexpr size_t WS_END = al256(OFF_MOD + SZ_MOD);
constexpr size_t OFF_PEERU = OFF_XIN;                            constexpr size_t SZ_PEERT = (size_t)16384 * 1024 * 2;
constexpr size_t OFF_PEERV = OFF_PEERU + SZ_PEERT;
constexpr size_t OFF_CAND = OFF_PEERV + SZ_PEERT;                constexpr size_t SZ_CAND = (size_t)TT * 256 * 4;
constexpr size_t OFF_EIDX = OFF_CAND + SZ_CAND;                  constexpr size_t SZ_EIDX = (size_t)TT * 128 * 4;
constexpr size_t OFF_GATE = OFF_EIDX + SZ_EIDX;
static_assert(OFF_GATE + SZ_EIDX <= OFF_XIN + SZ_XIN, "PEER overlays must fit in the XIN region");

constexpr int SMEM_BYTES = 116736;

struct Params {
    const float* in[27];
    float* out;
    unsigned char* ws;
    int ph_lo, ph_hi;
};
enum { I_X = 0, I_C, I_CTX, I_CCTX, I_ADAW, I_ADAB, I_N1G, I_N2G, I_WIN, I_RPB, I_CONVW, I_ARE, I_AIM, I_BRE, I_BIM, I_CRE, I_CIM,
       I_LOGDT, I_S5D, I_WGLU, I_GRPG, I_WOUT, I_WQ, I_KEYS, I_PU, I_PV, I_FING };


__device__ __forceinline__ int tidx_l() { int t = threadIdx.x; asm volatile("" : "+v"(t)); return t; }
__device__ __forceinline__ int bidx_l() { int t = blockIdx.x; asm volatile("" : "+s"(t)); return t; }
#define TIDX (tidx_l())
#define BIDX (bidx_l())
__device__ __forceinline__ bf16_t f2bf(float f) { unsigned u = __float_as_uint(f); u += 0x7FFFu + ((u >> 16) & 1u); return (bf16_t)(u >> 16); }
__device__ __forceinline__ float bf2f(bf16_t h) { return __uint_as_float(((unsigned)h) << 16); }
__device__ __forceinline__ unsigned pack2(float a, float b) { return (unsigned)f2bf(a) | ((unsigned)f2bf(b) << 16); }
__device__ __forceinline__ float bflo(unsigned u) { return __uint_as_float(u << 16); }
__device__ __forceinline__ float bfhi(unsigned u) { return __uint_as_float(u & 0xffff0000u); }
__device__ __forceinline__ float dot2bf(unsigned a, unsigned b, float c) {
    return __builtin_amdgcn_fdot2_f32_bf16(__builtin_bit_cast(bf16x2_t, a), __builtin_bit_cast(bf16x2_t, b), c, false);
}
__device__ __forceinline__ float gelu_tanh(float x) {
    float z = 0.7978845608028654f * (x + 0.044715f * x * x * x);
    float e = __expf(2.0f * z);
    float th = 1.0f - 2.0f / (e + 1.0f);
    return 0.5f * x * (1.0f + th);
}
__device__ __forceinline__ float sigmoidf_(float x) { return 1.0f / (1.0f + __expf(-x)); }
__device__ __forceinline__ float wave_sum(float v) {
#pragma unroll
    for (int o = 32; o >= 1; o >>= 1) v += __shfl_xor(v, o);
    return v;
}
__device__ __forceinline__ int sortable(float v) { int b = __float_as_int(v); return b ^ ((b >> 31) & 0x7FFFFFFF); }
__device__ __forceinline__ float unsortable(int s) { return __int_as_float(s ^ ((s >> 31) & 0x7FFFFFFF)); }
__device__ __forceinline__ void top16_insert(int (&top)[16], int x) {
#pragma unroll
    for (int j = 0; j < 16; ++j) { int hi = max(top[j], x); x = min(top[j], x); top[j] = hi; }
}
__device__ __forceinline__ int tok_modrow(int tt) { return tt < T ? (tt >> 12) : 8; }

template <bool TO_LDS, typename FA, typename FB, typename FE>
__device__ __forceinline__ void gemm128(FA arow, FB brow, int K, FE epi, unsigned char* smem) {
    const int tid = TIDX, lane = tid & 63, w = tid >> 6;
    const int wm = w >> 2, wn = w & 3;
    const bf16_t* pa[2]; const bf16_t* pb[2]; int soff[2];
#pragma unroll
    for (int i = 0; i < 2; ++i) {
        int c = tid + 512 * i, row = c >> 3, kc = c & 7;
        pa[i] = arow(row) + kc * 8; pb[i] = brow(row) + kc * 8;
        soff[i] = row * 128 + ((kc ^ (row & 7)) << 4);
    }
    __syncthreads();
    f32x4 acc[4][2];
#pragma unroll
    for (int i = 0; i < 4; ++i)
#pragma unroll
        for (int j = 0; j < 2; ++j) acc[i][j] = f32x4{0.f, 0.f, 0.f, 0.f};
    uint4 ra[2], rb[2];
#pragma unroll
    for (int i = 0; i < 2; ++i) { ra[i] = *(const uint4*)pa[i]; rb[i] = *(const uint4*)pb[i]; }
#pragma unroll
    for (int i = 0; i < 2; ++i) { *(uint4*)(smem + soff[i]) = ra[i]; *(uint4*)(smem + 16384 + soff[i]) = rb[i]; }
    __syncthreads();
    const int nk = K >> 6;
    const int lr = lane & 15, lg = lane >> 4, sw = lane & 7;
    for (int kt = 0; kt < nk; ++kt) {
        const int cur = kt & 1;
        if (kt + 1 < nk) {
#pragma unroll
            for (int i = 0; i < 2; ++i) { ra[i] = *(const uint4*)(pa[i] + (kt + 1) * 64); rb[i] = *(const uint4*)(pb[i] + (kt + 1) * 64); }
        }
        const unsigned char* sA = smem + cur * 32768;
        const unsigned char* sB = sA + 16384;
#pragma unroll
        for (int ks = 0; ks < 2; ++ks) {
            bf16x8 af[4], bfv[2];
            const int choff = (((ks * 4 + lg) ^ sw) << 4);
#pragma unroll
            for (int fi = 0; fi < 4; ++fi) af[fi] = *(const bf16x8*)(sA + (wm * 64 + fi * 16 + lr) * 128 + choff);
#pragma unroll
            for (int fj = 0; fj < 2; ++fj) bfv[fj] = *(const bf16x8*)(sB + (wn * 32 + fj * 16 + lr) * 128 + choff);
#pragma unroll
            for (int fi = 0; fi < 4; ++fi)
#pragma unroll
                for (int fj = 0; fj < 2; ++fj) acc[fi][fj] = __builtin_amdgcn_mfma_f32_16x16x32_bf16(af[fi], bfv[fj], acc[fi][fj], 0, 0, 0);
        }
        if (kt + 1 < nk) {
            unsigned char* dA = smem + (cur ^ 1) * 32768;
#pragma unroll
            for (int i = 0; i < 2; ++i) { *(uint4*)(dA + soff[i]) = ra[i]; *(uint4*)(dA + 16384 + soff[i]) = rb[i]; }
        }
        __syncthreads();
    }
    if (TO_LDS) {
        float* tc = (float*)smem;
#pragma unroll
        for (int fi = 0; fi < 4; ++fi)
#pragma unroll
            for (int fj = 0; fj < 2; ++fj)
#pragma unroll
                for (int j = 0; j < 4; ++j) tc[(wm * 64 + fi * 16 + lg * 4 + j) * 129 + wn * 32 + fj * 16 + lr] = acc[fi][fj][j];
        __syncthreads();
    } else {
#pragma unroll
        for (int fi = 0; fi < 4; ++fi)
#pragma unroll
            for (int fj = 0; fj < 2; ++fj)
#pragma unroll
                for (int j = 0; j < 4; ++j) epi(wm * 64 + fi * 16 + lg * 4 + j, wn * 32 + fj * 16 + lr, acc[fi][fj][j]);
    }
}

__device__ void phase_prep(const Params& p, unsigned char* smem) {
    const int tid = TIDX, lane = tid & 63, w = tid >> 6;
    unsigned char* ws = p.ws;
    constexpr int N_MOD = 192, N_TR = 1568, N_WQK = 512, N_DFTL = 4096, N_DFTS = 1, N_S5T = 8;
    constexpr int O_TR = N_MOD, O_WQK = O_TR + N_TR, O_DFTL = O_WQK + N_WQK, O_DFTS = O_DFTL + N_DFTL, O_S5T = O_DFTS + N_DFTS, N_ALL = O_S5T + N_S5T;
    float* tab = (float*)(smem + 98304);
    for (int j = tid; j < 4096; j += NTHREADS) tab[j] = cospif((float)j * (1.0f / 2048.0f));
    __syncthreads();
    for (int it = BIDX; it < N_ALL; it += gridDim.x) {
        if (it < O_TR) {
            const int L = it / 96, c0 = (it % 96) * 64;
            float* sv = (float*)smem;
            float* red = (float*)(smem + 36864);
            for (int idx = tid; idx < 9 * 1024; idx += NTHREADS) {
                int r = idx >> 10, k = idx & 1023;
                float v = (r < 8) ? p.in[I_C][r * 1024 + k] : p.in[I_CCTX][k];
                sv[idx] = v / (1.0f + __expf(-v));
            }
            __syncthreads();
            float acc[9];
#pragma unroll
            for (int r = 0; r < 9; ++r) acc[r] = 0.f;
            const float* aw = p.in[I_ADAW] + (size_t)L * 1024 * 6144 + c0 + lane;
            for (int k = w * 128; k < w * 128 + 128; ++k) {
                float wv = aw[(size_t)k * 6144];
#pragma unroll
                for (int r = 0; r < 9; ++r) acc[r] += sv[r * 1024 + k] * wv;
            }
#pragma unroll
            for (int r = 0; r < 9; ++r) red[(w * 9 + r) * 64 + lane] = acc[r];
            __syncthreads();
            for (int o = tid; o < 576; o += NTHREADS) {
                int r = o >> 6, col = o & 63;
                float s = 0.f;
#pragma unroll
                for (int ww = 0; ww < 8; ++ww) s += red[(ww * 9 + r) * 64 + col];
                ((float*)(ws + OFF_MOD))[(size_t)(L * 9 + r) * 6144 + c0 + col] = s + p.in[I_ADAB][L * 6144 + c0 + col];
            }
            __syncthreads();
        } else if (it < O_WQK) {
            int idx = it - O_TR;
            const int L = idx / 784; int rem = idx % 784;
            const float* src; bf16_t* dst; int Kd, Nd, tk, tn;
            if (rem < 512) { tk = rem >> 5; tn = rem & 31; Kd = 1024; Nd = 2048; src = p.in[I_WIN] + (size_t)L * 1024 * 2048; dst = (bf16_t*)(ws + OFF_WINT + L * SZ_WINT); }
            else if (rem < 768) { rem -= 512; tk = rem >> 4; tn = rem & 15; Kd = 1024; Nd = 1024; src = p.in[I_WOUT] + (size_t)L * 1024 * 1024; dst = (bf16_t*)(ws + OFF_WOUTT + L * SZ_WOUTT); }
            else { rem -= 768; tk = rem >> 2; tn = rem & 3; Kd = 256; Nd = 256; src = p.in[I_WGLU] + (size_t)L * 256 * 256; dst = (bf16_t*)(ws + OFF_WGLUT + L * SZ_WGLUT); }
            float* tl = (float*)smem;
#pragma unroll
            for (int i = 0; i < 8; ++i) { int kk = i * 8 + w, nn = lane; tl[kk * 65 + nn] = src[(size_t)(tk * 64 + kk) * Nd + tn * 64 + nn]; }
            __syncthreads();
#pragma unroll
            for (int i = 0; i < 8; ++i) { int nn = i * 8 + w, kk = lane; dst[(size_t)(tn * 64 + nn) * Kd + tk * 64 + kk] = f2bf(tl[kk * 65 + nn]); }
            __syncthreads();
        } else if (it < O_DFTL) {
            int idx = it - O_WQK;
            const int L = idx >> 8, hz = (idx >> 4) & 15, kb = idx & 15;
            const int kk = kb * 64 + lane;
            const float* wqrow = p.in[I_WQ] + (size_t)L * 1024 * 2048 + (size_t)kk * 2048 + hz * 128;
            const float* keys = p.in[I_KEYS] + ((size_t)(L * 16 + hz) * 128 + w * 16) * 128;
            float acc[16];
#pragma unroll
            for (int j = 0; j < 16; ++j) acc[j] = 0.f;
            for (int d4 = 0; d4 < 32; ++d4) {
                float4 wv = *(const float4*)(wqrow + d4 * 4);
#pragma unroll
                for (int j = 0; j < 16; ++j) {
                    float4 kv = *(const float4*)(keys + j * 128 + d4 * 4);
                    acc[j] += wv.x * kv.x + wv.y * kv.y + wv.z * kv.z + wv.w * kv.w;
                }
            }
            bf16_t* dst = (bf16_t*)(ws + OFF_WQKT + L * SZ_WQKT);
#pragma unroll
            for (int j = 0; j < 16; ++j) dst[(size_t)(hz * 128 + w * 16 + j) * 1024 + kk] = f2bf(acc[j]);
        } else if (it < O_DFTS) {
            const int k = it - O_DFTL;
            bf16_t* dst = (bf16_t*)(ws + OFF_DFTL) + (size_t)k * 8192;
#pragma unroll
            for (int i = 0; i < 2; ++i) {
                int c = tid + 512 * i, part = c >> 9, l0 = (c & 511) * 8;
                unsigned pk[4];
#pragma unroll
                for (int e = 0; e < 4; ++e) {
                    int i0 = ((k * (l0 + 2 * e)) + part * 1024) & 4095, i1 = ((k * (l0 + 2 * e + 1)) + part * 1024) & 4095;
                    pk[e] = pack2(tab[i0] * (1.0f / 512.0f), tab[i1] * (1.0f / 512.0f));
                }
                *(uint4*)(dst + part * 4096 + l0) = make_uint4(pk[0], pk[1], pk[2], pk[3]);
            }
        } else if (it < O_S5T) {
            bf16_t* dc = (bf16_t*)(ws + OFF_DFTC);
            for (int c = tid; c < 16384; c += NTHREADS) {
                int k = c >> 6, cc = c & 63, part = cc >> 5, l0 = (cc & 31) * 8;
                unsigned pk[4];
#pragma unroll
                for (int e = 0; e < 4; ++e) {
                    int i0 = ((((k * (l0 + 2 * e)) & 255) << 4) + part * 1024) & 4095, i1 = ((((k * (l0 + 2 * e + 1)) & 255) << 4) + part * 1024) & 4095;
                    pk[e] = pack2(tab[i0] * (1.0f / 128.0f), tab[i1] * (1.0f / 128.0f));
                }
                *(uint4*)(dc + (size_t)k * 512 + part * 256 + l0) = make_uint4(pk[0], pk[1], pk[2], pk[3]);
            }
            bf16_t* dd = (bf16_t*)(ws + OFF_DFTD);
            for (int c = tid; c < 1024; c += NTHREADS) {
                int m = c >> 3, d0 = (c & 7) * 8, kd = m & 63, sh = (m >= 64) ? 3072 : 0;
                unsigned pk[4];
#pragma unroll
                for (int e = 0; e < 4; ++e) {
                    int i0 = ((((kd * (d0 + 2 * e)) & 63) << 6) + sh) & 4095, i1 = ((((kd * (d0 + 2 * e + 1)) & 63) << 6) + sh) & 4095;
                    pk[e] = pack2(tab[i0], tab[i1]);
                }
                *(uint4*)(dd + m * 64 + d0) = make_uint4(pk[0], pk[1], pk[2], pk[3]);
            }
        } else {
            const int gid = (it - O_S5T) * NTHREADS + tid;
            const int ia = gid;
            const float are = p.in[I_ARE][ia], aim = p.in[I_AIM][ia];
            const float dt = expf(p.in[I_LOGDT][ia >> 6]);
            float2* pw = (float2*)(ws + OFF_POWA) + (size_t)(ia >> 6) * 33 * 64 + (ia & 63);
            float abr = 1.f, abi = 0.f;
            for (int tau = 0; tau <= 32; ++tau) {
                float mag = expf(are * dt * (float)tau), s, c;
                sincosf(aim * dt * (float)tau, &s, &c);
                pw[tau * 64] = make_float2(mag * c, mag * s);
                if (tau == 1) { abr = mag * c; abi = mag * s; }
            }
            const float nr = abr - 1.0f, ni = abi, den = are * are + aim * aim;
            const float qr = (nr * are + ni * aim) / den, qi = (ni * are - nr * aim) / den;
            float2* bb = (float2*)(ws + OFF_BBAR) + (size_t)ia * 16;
#pragma unroll
            for (int h = 0; h < 16; ++h) {
                float br = p.in[I_BRE][(size_t)ia * 16 + h], bi = p.in[I_BIM][(size_t)ia * 16 + h];
                bb[h] = make_float2(qr * br - qi * bi, qr * bi + qi * br);
            }
        }
    }
}

__device__ void norm_tokens(const Params& p, int L, int which, int ntok, bool from_input, int item0, int nitems_total) {
    const int tid = TIDX, lane = tid & 63, w = tid >> 6;
    const float* modL = (const float*)(p.ws + OFF_MOD) + (size_t)L * 9 * 6144;
    const float* gvec = p.in[which ? I_N2G : I_N1G] + L * 1024;
    bf16_t* dst = (bf16_t*)(p.ws + OFF_ACT);
    for (int it = item0 + BIDX; it < nitems_total; it += gridDim.x) {
        if (it < item0) continue;
        const int tt = (it - item0) * 8 + w;
        if (tt >= ntok) continue;
        const float* src;
        if (tt < T) src = (from_input ? p.in[I_X] : p.out) + (size_t)tt * 1024;
        else src = (from_input ? p.in[I_CTX] : (const float*)(p.ws + OFF_XCTX)) + (size_t)(tt - T) * 1024;
        const float* sh = modL + (size_t)tok_modrow(tt) * 6144 + (which ? 3072 : 0);
        const float* sc = sh + 1024;
        float4 v[4]; float ss = 0.f;
#pragma unroll
        for (int i = 0; i < 4; ++i) { v[i] = *(const float4*)(src + (i * 64 + lane) * 4); ss += v[i].x * v[i].x + v[i].y * v[i].y + v[i].z * v[i].z + v[i].w * v[i].w; }
        ss = wave_sum(ss);
        const float r = rsqrtf(ss * (1.0f / 1024.0f) + EPS);
#pragma unroll
        for (int i = 0; i < 4; ++i) {
            const int k = (i * 64 + lane) * 4;
            float4 g = *(const float4*)(gvec + k), a = *(const float4*)(sc + k), b = *(const float4*)(sh + k);
            float o0 = v[i].x * r * g.x * (1.f + a.x) + b.x, o1 = v[i].y * r * g.y * (1.f + a.y) + b.y;
            float o2 = v[i].z * r * g.z * (1.f + a.z) + b.z, o3 = v[i].w * r * g.w * (1.f + a.w) + b.w;
            *(uint2*)(dst + (size_t)tt * 1024 + k) = make_uint2(pack2(o0, o1), pack2(o2, o3));
        }
    }
}

__device__ void phase_A(const Params& p, int L) {
    const int n_norm = TT / 8;
    const int n_kt = (L == 0) ? 1024 : 0;
    for (int it = BIDX; it < n_kt; it += gridDim.x) {
        const int gid = it * NTHREADS + TIDX;
        const int hp = gid & 15, h = (gid >> 4) & 15, tau = (gid >> 8) & 31, ldg = gid >> 13;
        const float* cre = p.in[I_CRE] + ((size_t)ldg * 16 + h) * 64;
        const float* cim = p.in[I_CIM] + ((size_t)ldg * 16 + h) * 64;
        const float2* pw = (const float2*)(p.ws + OFF_POWA) + ((size_t)ldg * 33 + tau) * 64;
        const float2* bb = (const float2*)(p.ws + OFF_BBAR) + (size_t)ldg * 64 * 16 + hp;
        float acc = 0.f;
        for (int q = 0; q < 64; ++q) {
            float2 a = pw[q], b = bb[q * 16];
            float cr = cre[q], ci = cim[q];
            float wr = cr * a.x - ci * a.y, wi = cr * a.y + ci * a.x;
            acc += wr * b.x - wi * b.y;
        }
        ((float*)(p.ws + OFF_KTAU))[gid] = acc;
    }
    norm_tokens(p, L, 0, TT, L == 0, n_kt, n_kt + n_norm);
}

__device__ void phase_B(const Params& p, int L, unsigned char* smem) {
    unsigned char* ws = p.ws;
    constexpr int N_G = (TT / 128) * 16, N_WC = 1536, N_WS = 512;
    const bf16_t* A = (const bf16_t*)(ws + OFF_ACT);
    const bf16_t* Bt = (const bf16_t*)(ws + OFF_WINT + L * SZ_WINT);
    bf16_t* xin = (bf16_t*)(ws + OFF_XIN);
    for (int it = BIDX; it < N_G + N_WC + N_WS; it += gridDim.x) {
        if (it < N_G) {
            const int mt = it >> 4, nt = it & 15;
            gemm128<false>([&](int r) { return A + (size_t)(mt * 128 + r) * 1024; },
                           [&](int r) { return Bt + (size_t)(nt * 128 + r) * 1024; }, 1024,
                           [&](int m, int n, float v) { xin[(size_t)(mt * 128 + m) * 2048 + nt * 128 + n] = f2bf(v); }, smem);
        } else if (it < N_G + N_WC) {
            const int cid = (it - N_G) * NTHREADS + TIDX;
            const int kc = cid % 96, m = (cid / 96) & 511, g = cid / (96 * 512);
            const int i = m >> 4, h = m & 15;
            float vals[8];
            if (kc < 32) {
                const int dr = kc >> 4, ri = (kc >> 3) & 1, p0 = (kc & 7) * 8;
                const int ldg = (L * 2 + dr) * 16 + g;
                const int e = dr == 0 ? (i + 1) : (32 - i);
                const float2* pw = (const float2*)(ws + OFF_POWA) + ((size_t)ldg * 33 + e) * 64 + p0;
                const float* cre = p.in[I_CRE] + ((size_t)ldg * 16 + h) * 64 + p0;
                const float* cim = p.in[I_CIM] + ((size_t)ldg * 16 + h) * 64 + p0;
#pragma unroll
                for (int q = 0; q < 8; ++q) {
                    float2 a = pw[q]; float cr = cre[q], ci = cim[q];
                    float wr = cr * a.x - ci * a.y, wi = cr * a.y + ci * a.x;
                    vals[q] = ri == 0 ? wr : -wi;
                }
            } else {
                const int kk = (kc - 32) * 8, j = kk >> 4, h0 = kk & 15;
                const float* kf = (const float*)(ws + OFF_KTAU) + (size_t)((L * 2 + 0) * 16 + g) * 32 * 256;
                const float* kb = (const float*)(ws + OFF_KTAU) + (size_t)((L * 2 + 1) * 16 + g) * 32 * 256;
#pragma unroll
                for (int q = 0; q < 8; ++q) {
                    float v = 0.f;
                    if (j <= i) v += kf[((i - j) * 16 + h) * 16 + h0 + q];
                    if (j >= i) v += kb[((j - i) * 16 + h) * 16 + h0 + q];
                    vals[q] = v;
                }
            }
            bf16_t* dst = (bf16_t*)(ws + OFF_WCOMB) + ((size_t)g * 512 + m) * KV + kc * 8;
            *(uint4*)dst = make_uint4(pack2(vals[0], vals[1]), pack2(vals[2], vals[3]), pack2(vals[4], vals[5]), pack2(vals[6], vals[7]));
        } else {
            const int cid = (it - N_G - N_WC) * NTHREADS + TIDX;
            const int kc = cid & 63, m = (cid >> 6) & 255, g = cid >> 14;
            const int dr = m >> 7, ri = (m >> 6) & 1, pp = m & 63;
            const int j = kc >> 1, h0 = (kc & 1) * 8;
            const int ldg = (L * 2 + dr) * 16 + g;
            const int e = dr == 0 ? (31 - j) : j;
            const float2 a = ((const float2*)(ws + OFF_POWA))[((size_t)ldg * 33 + e) * 64 + pp];
            const float2* bb = (const float2*)(ws + OFF_BBAR) + ((size_t)ldg * 64 + pp) * 16 + h0;
            float vals[8];
#pragma unroll
            for (int q = 0; q < 8; ++q) { float2 b = bb[q]; vals[q] = ri == 0 ? (a.x * b.x - a.y * b.y) : (a.x * b.y + a.y * b.x); }
            bf16_t* dst = (bf16_t*)(ws + OFF_WST) + ((size_t)g * 256 + m) * 512 + kc * 8;
            *(uint4*)dst = make_uint4(pack2(vals[0], vals[1]), pack2(vals[2], vals[3]), pack2(vals[4], vals[5]), pack2(vals[6], vals[7]));
        }
    }
}

__device__ __forceinline__ void attn_block16(const unsigned (&qp)[32], const bf16_t* kbase, const float* rp, float* sl,
                                             float& mrun, float& lrun, float (&acc)[64]) {
    float bm = -3.0e38f;
#pragma unroll 1
    for (int jj = 0; jj < 16; ++jj) {
        const uint4* kp = (const uint4*)(kbase + (size_t)jj * 2048);
        float d = 0.f;
#pragma unroll
        for (int c = 0; c < 8; ++c) {
            uint4 kv = kp[c];
            d = dot2bf(qp[c * 4 + 0], kv.x, d); d = dot2bf(qp[c * 4 + 1], kv.y, d);
            d = dot2bf(qp[c * 4 + 2], kv.z, d); d = dot2bf(qp[c * 4 + 3], kv.w, d);
        }
        d = d * 0.125f + (rp ? rp[jj] : 0.f);
        sl[jj * NTHREADS] = d;
        bm = fmaxf(bm, d);
    }
    const float mn = fmaxf(mrun, bm);
    const float corr = __expf(mrun - mn);
    mrun = mn; lrun *= corr;
#pragma unroll
    for (int d = 0; d < 64; ++d) acc[d] *= corr;
#pragma unroll 1
    for (int jj = 0; jj < 16; ++jj) {
        const float pw = __expf(sl[jj * NTHREADS] - mn);
        lrun += pw;
        const uint4* vp = (const uint4*)(kbase + (size_t)jj * 2048 + 256);
#pragma unroll
        for (int c = 0; c < 8; ++c) {
            uint4 vv = vp[c];
            acc[c * 8 + 0] += pw * bflo(vv.x); acc[c * 8 + 1] += pw * bfhi(vv.x);
            acc[c * 8 + 2] += pw * bflo(vv.y); acc[c * 8 + 3] += pw * bfhi(vv.y);
            acc[c * 8 + 4] += pw * bflo(vv.z); acc[c * 8 + 5] += pw * bfhi(vv.z);
            acc[c * 8 + 6] += pw * bflo(vv.w); acc[c * 8 + 7] += pw * bfhi(vv.w);
        }
    }
}

__device__ void attn_item(const Params& p, int L, int item, float* sl) {
    const int lane = TIDX & 63;
    const bf16_t* xin = (const bf16_t*)(p.ws + OFF_XIN);
    bf16_t* ymix = (bf16_t*)(p.ws + OFF_YMIX);
    int b, h, r = 0, qtok; bool lat = item < 2048;
    if (lat) { b = item >> 8; r = (item >> 2) & 63; h = item & 3; qtok = b * 4096 + r * 64 + lane; }
    else { int q = item - 2048; b = q >> 4; h = (q >> 2) & 3; qtok = T + b * 256 + (q & 3) * 64 + lane; }
    unsigned qp[32];
    {
        const uint4* qs = (const uint4*)(xin + (size_t)qtok * 2048 + h * 64);
#pragma unroll
        for (int c = 0; c < 8; ++c) { uint4 v = qs[c]; qp[c * 4] = v.x; qp[c * 4 + 1] = v.y; qp[c * 4 + 2] = v.z; qp[c * 4 + 3] = v.w; }
    }
    float acc[64];
#pragma unroll
    for (int d = 0; d < 64; ++d) acc[d] = 0.f;
    float mrun = -3.0e38f, lrun = 0.f;
    const bf16_t* kctx = xin + (size_t)(T + b * 256) * 2048 + 256 + h * 64;
#pragma unroll 1
    for (int blk = 0; blk < 16; ++blk) attn_block16(qp, kctx + (size_t)(blk * 16) * 2048, nullptr, sl, mrun, lrun, acc);
    if (lat) {
        const int rs = min(max(r - 4, 0), 56), cs = min(max(lane - 8, 0), 48);
        const float* rpb = p.in[I_RPB] + (size_t)(L * 4 + h) * 15 * 31;
#pragma unroll 1
        for (int kr = 0; kr < 8; ++kr) {
            const int R = rs + kr;
            const bf16_t* kbase = xin + (size_t)(b * 4096 + R * 64 + cs) * 2048 + 256 + h * 64;
            const float* rp = rpb + (R - r + 7) * 31 + (cs - lane + 15);
            attn_block16(qp, kbase, rp, sl, mrun, lrun, acc);
        }
    }
    const float inv = 1.0f / lrun;
    uint4* dst = (uint4*)(ymix + (size_t)qtok * 1024 + h * 64);
#pragma unroll
    for (int c = 0; c < 8; ++c)
        dst[c] = make_uint4(pack2(acc[c * 8] * inv, acc[c * 8 + 1] * inv), pack2(acc[c * 8 + 2] * inv, acc[c * 8 + 3] * inv),
                            pack2(acc[c * 8 + 4] * inv, acc[c * 8 + 5] * inv), pack2(acc[c * 8 + 6] * inv, acc[c * 8 + 7] * inv));
}

__device__ void phase_C(const Params& p, int L, unsigned char* smem) {
    unsigned char* ws = p.ws;
    const int tid = TIDX, w = tid >> 6;
    const bf16_t* xin = (const bf16_t*)(ws + OFF_XIN);
    bf16_t* ymix = (bf16_t*)(ws + OFF_YMIX);
    const int n_attn_w = (L == 0) ? 2048 + 128 : 2048;
    const int N_ATT = (n_attn_w + 7) / 8;
    const int N_F1 = 1024 + ((L == 0) ? 64 : 0);
    const int N_CONV = TT * 32 / NTHREADS;
    const int N_S1 = TT * 16 / NTHREADS;
    const int O_F1 = N_ATT, O_CONV = O_F1 + N_F1, O_S1 = O_CONV + N_CONV, N_ALL = O_S1 + N_S1;
    for (int it = BIDX; it < N_ALL; it += gridDim.x) {
        if (it < O_F1) {
            const int item = it * 8 + w;
            if (item < n_attn_w) attn_item(p, L, item, (float*)smem + tid);
        } else if (it < O_CONV) {
            int idx = it - O_F1;
            const bf16_t* dd = (const bf16_t*)(ws + OFF_DFTD);
            if (idx < 1024) {
                const int b = idx >> 7, h = (idx >> 5) & 3, nt = idx & 31;
                bf16_t* zt = (bf16_t*)(ws + OFF_ZT);
                gemm128<false>([&](int r) { return dd + r * 64; },
                               [&](int r) { return xin + (size_t)(b * 4096 + nt * 128 + r) * 2048 + 1536 + h * 64; }, 64,
                               [&](int m, int n, float v) { zt[((size_t)(b * 256 + h * 64 + (m & 63)) * 2 + (m >> 6)) * 4096 + nt * 128 + n] = f2bf(v); }, smem);
            } else {
                idx -= 1024;
                const int b = idx >> 3, h = (idx >> 1) & 3, nt = idx & 1;
                bf16_t* zt = (bf16_t*)(ws + OFF_ZTC);
                gemm128<false>([&](int r) { return dd + r * 64; },
                               [&](int r) { return xin + (size_t)(T + b * 256 + nt * 128 + r) * 2048 + 1536 + h * 64; }, 64,
                               [&](int m, int n, float v) { zt[((size_t)(b * 256 + h * 64 + (m & 63)) * 2 + (m >> 6)) * 256 + nt * 128 + n] = f2bf(v); }, smem);
            }
        } else if (it < O_S1) {
            const int gid = (it - O_CONV) * NTHREADS + tid;
            const int tt = gid >> 5, ch0 = (gid & 31) * 8;
            bool first, last;
            if (tt < T) { int l = tt & 4095; first = l == 0; last = l == 4095; } else { int j = (tt - T) & 255; first = j == 0; last = j == 255; }
            const bf16_t* row = xin + (size_t)tt * 2048;
            const uint4 cb = *(const uint4*)(row + 768 + ch0), cc = *(const uint4*)(row + 1024 + ch0), cx = *(const uint4*)(row + 1280 + ch0);
            uint4 ccp = make_uint4(0, 0, 0, 0), cxp = ccp, ccn = ccp, cxn = ccp;
            if (!first) { ccp = *(const uint4*)(row - 2048 + 1024 + ch0); cxp = *(const uint4*)(row - 2048 + 1280 + ch0); }
            if (!last) { ccn = *(const uint4*)(row + 2048 + 1024 + ch0); cxn = *(const uint4*)(row + 2048 + 1280 + ch0); }
            const float* cw = p.in[I_CONVW] + (size_t)L * 3 * 256 + ch0;
            const unsigned cbv[4] = {cb.x, cb.y, cb.z, cb.w}, ccv[4] = {cc.x, cc.y, cc.z, cc.w}, cxv[4] = {cx.x, cx.y, cx.z, cx.w};
            const unsigned cpv[4] = {ccp.x, ccp.y, ccp.z, ccp.w}, xpv[4] = {cxp.x, cxp.y, cxp.z, cxp.w};
            const unsigned cnv[4] = {ccn.x, ccn.y, ccn.z, ccn.w}, xnv[4] = {cxn.x, cxn.y, cxn.z, cxn.w};
            unsigned o[4];
#pragma unroll
            for (int e = 0; e < 4; ++e) {
                float w0a = cw[2 * e], w0b = cw[2 * e + 1], w1a = cw[256 + 2 * e], w1b = cw[256 + 2 * e + 1], w2a = cw[512 + 2 * e], w2b = cw[512 + 2 * e + 1];
                float za = w0a * bflo(cpv[e]) * bflo(xpv[e]) + w1a * bflo(ccv[e]) * bflo(cxv[e]) + w2a * bflo(cnv[e]) * bflo(xnv[e]);
                float zb = w0b * bfhi(cpv[e]) * bfhi(xpv[e]) + w1b * bfhi(ccv[e]) * bfhi(cxv[e]) + w2b * bfhi(cnv[e]) * bfhi(xnv[e]);
                o[e] = pack2(bflo(cbv[e]) * za, bfhi(cbv[e]) * zb);
            }
            *(uint4*)(ymix + (size_t)tt * 1024 + 256 + ch0) = make_uint4(o[0], o[1], o[2], o[3]);
        } else {
            const int gid = (it - O_S1) * NTHREADS + tid;
            const int tt = gid >> 4, g = gid & 15;
            int n, j;
            if (tt < T) { int b = tt >> 12, l = tt & 4095; n = b * NCHB + 8 + (l >> 5); j = l & 31; }
            else { int c = tt - T; int b = c >> 8; n = b * NCHB + ((c & 255) >> 5); j = c & 31; }
            const uint4* src = (const uint4*)(xin + (size_t)tt * 2048 + 1792 + g * 16);
            uint4* dst = (uint4*)((bf16_t*)(ws + OFF_VG) + ((size_t)g * NCHP + n) * KV + 256 + j * 16);
            dst[0] = src[0]; dst[1] = src[1];
        }
    }
}

__device__ void phase_D(const Params& p, int L, unsigned char* smem) {
    unsigned char* ws = p.ws;
    bf16_t* ymix = (bf16_t*)(ws + OFF_YMIX);
    const int N_F2 = 512, N_F2C = (L == 0) ? 32 : 0, N_S2 = 288;
    const int O_F2C = N_F2, O_S2 = O_F2C + N_F2C, N_ALL = O_S2 + N_S2;
    for (int it = BIDX; it < N_ALL; it += gridDim.x) {
        if (it < O_F2C) {
            const int b = it >> 6, mt = (it >> 1) & 31, nt = it & 1;
            const bf16_t* dl = (const bf16_t*)(ws + OFF_DFTL);
            const bf16_t* zt = (const bf16_t*)(ws + OFF_ZT);
            gemm128<false>([&](int r) { return dl + (size_t)(mt * 128 + r) * 8192; },
                           [&](int r) { return zt + (size_t)(b * 256 + nt * 128 + r) * 8192; }, 8192,
                           [&](int m, int n, float v) { ymix[(size_t)(b * 4096 + mt * 128 + m) * 1024 + 512 + nt * 128 + n] = f2bf(v); }, smem);
        } else if (it < O_S2) {
            const int idx = it - O_F2C;
            const int b = idx >> 2, mt = (idx >> 1) & 1, nt = idx & 1;
            const bf16_t* dc = (const bf16_t*)(ws + OFF_DFTC);
            const bf16_t* zt = (const bf16_t*)(ws + OFF_ZTC);
            gemm128<false>([&](int r) { return dc + (size_t)(mt * 128 + r) * 512; },
                           [&](int r) { return zt + (size_t)(b * 256 + nt * 128 + r) * 512; }, 512,
                           [&](int m, int n, float v) { ymix[(size_t)(T + b * 256 + mt * 128 + m) * 1024 + 512 + nt * 128 + n] = f2bf(v); }, smem);
        } else {
            const int idx = it - O_S2;
            const int g = idx / 18, rem = idx % 18, mt = rem / 9, nt = rem % 9;
            const bf16_t* wst = (const bf16_t*)(ws + OFF_WST) + (size_t)g * 256 * 512;
            const bf16_t* vg = (const bf16_t*)(ws + OFF_VG) + (size_t)g * NCHP * KV;
            float* sc = (float*)(ws + OFF_SC) + (size_t)g * NCH * 256;
            gemm128<false>([&](int r) { return wst + (size_t)(mt * 128 + r) * 512; },
                           [&](int r) { return vg + (size_t)(nt * 128 + r) * KV + 256; }, 512,
                           [&](int m, int n, float v) { int nn = nt * 128 + n; if (nn < NCH) sc[(size_t)nn * 256 + mt * 128 + m] = v; }, smem);
        }
    }
}

__device__ void phase_E(const Params& p, int L) {
    unsigned char* ws = p.ws;
    for (int it = BIDX; it < 32; it += gridDim.x) {
        const int gid = it * NTHREADS + TIDX;
        const int b = gid >> 11, g = (gid >> 7) & 15, dr = (gid >> 6) & 1, pp = gid & 63;
        const float2 a32 = ((const float2*)(ws + OFF_POWA))[((size_t)((L * 2 + dr) * 16 + g) * 33 + 32) * 64 + pp];
        bf16_t* vg = (bf16_t*)(ws + OFF_VG) + (size_t)g * NCHP * KV + dr * 128 + pp;
        const float* sc = (const float*)(ws + OFF_SC) + (size_t)g * NCH * 256 + dr * 128 + pp;
        float hr = 0.f, hi = 0.f;
        for (int s0 = 0; s0 < NCHB; s0 += 8) {
            float sr[8], si[8]; int nn[8];
#pragma unroll
            for (int q = 0; q < 8; ++q) {
                const int s = s0 + q;
                const int cidx = dr == 0 ? s : (s < 8 ? 7 - s : NCHB - 1 - (s - 8));
                nn[q] = b * NCHB + cidx;
                sr[q] = sc[(size_t)nn[q] * 256]; si[q] = sc[(size_t)nn[q] * 256 + 64];
            }
#pragma unroll
            for (int q = 0; q < 8; ++q) {
                vg[(size_t)nn[q] * KV] = f2bf(hr); vg[(size_t)nn[q] * KV + 64] = f2bf(hi);
                const float nr = a32.x * hr - a32.y * hi + sr[q], ni = a32.x * hi + a32.y * hr + si[q];
                hr = nr; hi = ni;
            }
        }
    }
}

__device__ void phase_F(const Params& p, int L, unsigned char* smem) {
    unsigned char* ws = p.ws;
    bf16_t* gbuf = (bf16_t*)(ws + OFF_GBUF);
    const float* dsk = p.in[I_S5D] + L * 256;
    for (int it = BIDX; it < 576; it += gridDim.x) {
        const int g = it / 36, rem = it % 36, mt = rem >> 2, nt = rem & 3;
        const bf16_t* vg = (const bf16_t*)(ws + OFF_VG) + (size_t)g * NCHP * KV;
        const bf16_t* wc = (const bf16_t*)(ws + OFF_WCOMB) + (size_t)g * 512 * KV;
        gemm128<false>([&](int r) { return vg + (size_t)(mt * 128 + r) * KV; },
                       [&](int r) { return wc + (size_t)(nt * 128 + r) * KV; }, KV,
                       [&](int m, int n, float v) {
                           const int nn = mt * 128 + m;
                           if (nn < NCH) {
                               const int nc = nt * 128 + n, i = nc >> 4, h = nc & 15;
                               const int b = nn / NCHB, cidx = nn % NCHB;
                               const int tt = cidx < 8 ? (T + b * 256 + cidx * 32 + i) : (b * 4096 + (cidx - 8) * 32 + i);
                               const float u = bf2f(vg[(size_t)nn * KV + 256 + nc]);
                               const float y = v + dsk[g * 16 + h] * u;
                               gbuf[(size_t)tt * 256 + g * 16 + h] = f2bf(gelu_tanh(y));
                           }
                       }, smem);
    }
}

__device__ void phase_G(const Params& p, int L, unsigned char* smem) {
    unsigned char* ws = p.ws;
    const bf16_t* gbuf = (const bf16_t*)(ws + OFF_GBUF);
    const bf16_t* wg = (const bf16_t*)(ws + OFF_WGLUT + L * SZ_WGLUT);
    bf16_t* ymix = (bf16_t*)(ws + OFF_YMIX);
    for (int it = BIDX; it < (TT / 128) * 2; it += gridDim.x) {
        const int mt = it >> 1, nt = it & 1;
        gemm128<false>([&](int r) { return gbuf + (size_t)(mt * 128 + r) * 256; },
                       [&](int r) { return wg + (size_t)(nt * 128 + r) * 256; }, 256,
                       [&](int m, int n, float v) {
                           const size_t tt = mt * 128 + m; const int nn = nt * 128 + n;
                           const float gg = bf2f(gbuf[tt * 256 + nn]);
                           ymix[tt * 1024 + 768 + nn] = f2bf(gg * sigmoidf_(v));
                       }, smem);
    }
}

__device__ void phase_H(const Params& p, int L) {
    const int lane = TIDX & 63, w = TIDX >> 6;
    const bf16_t* ymix = (const bf16_t*)(p.ws + OFF_YMIX);
    bf16_t* dst = (bf16_t*)(p.ws + OFF_ACT);
    const float* gg = p.in[I_GRPG] + (size_t)L * 1024 + lane * 16;
    for (int it = BIDX; it < TT / 8; it += gridDim.x) {
        const int tt = it * 8 + w;
        const uint4* src = (const uint4*)(ymix + (size_t)tt * 1024 + lane * 16);
        const uint4 a = src[0], b = src[1];
        const unsigned u[8] = {a.x, a.y, a.z, a.w, b.x, b.y, b.z, b.w};
        float v[16], ss = 0.f;
#pragma unroll
        for (int e = 0; e < 8; ++e) { v[2 * e] = bflo(u[e]); v[2 * e + 1] = bfhi(u[e]); ss += v[2 * e] * v[2 * e] + v[2 * e + 1] * v[2 * e + 1]; }
        ss += __shfl_xor(ss, 1); ss += __shfl_xor(ss, 2); ss += __shfl_xor(ss, 4); ss += __shfl_xor(ss, 8);
        const float r = rsqrtf(ss * (1.0f / 256.0f) + EPS);
        unsigned o[8];
#pragma unroll
        for (int e = 0; e < 8; ++e) o[e] = pack2(v[2 * e] * r * gg[2 * e], v[2 * e + 1] * r * gg[2 * e + 1]);
        uint4* d = (uint4*)(dst + (size_t)tt * 1024 + lane * 16);
        d[0] = make_uint4(o[0], o[1], o[2], o[3]); d[1] = make_uint4(o[4], o[5], o[6], o[7]);
    }
}

__device__ void phase_I(const Params& p, int L, unsigned char* smem) {
    unsigned char* ws = p.ws;
    const int mtok = (L == 0) ? TT : T;
    const int N_G = (mtok / 128) * 8, N_CV = 8192;
    const bf16_t* A = (const bf16_t*)(ws + OFF_ACT);
    const bf16_t* Bt = (const bf16_t*)(ws + OFF_WOUTT + L * SZ_WOUTT);
    const float* g1 = (const float*)(ws + OFF_MOD) + (size_t)L * 9 * 6144 + 2048;
    float* xctx = (float*)(ws + OFF_XCTX);
    for (int it = BIDX; it < N_G + N_CV; it += gridDim.x) {
        if (it < N_G) {
            const int mt = it >> 3, nt = it & 7;
            gemm128<false>([&](int r) { return A + (size_t)(mt * 128 + r) * 1024; },
                           [&](int r) { return Bt + (size_t)(nt * 128 + r) * 1024; }, 1024,
                           [&](int m, int n, float v) {
                               const int tt = mt * 128 + m, nn = nt * 128 + n;
                               const float gate = g1[(size_t)tok_modrow(tt) * 6144 + nn];
                               if (tt < T) {
                                   const size_t o = (size_t)tt * 1024 + nn;
                                   const float xr = (L == 0) ? p.in[I_X][o] : p.out[o];
                                   p.out[o] = xr + gate * v;
                               } else {
                                   const size_t o = (size_t)(tt - T) * 1024 + nn;
                                   xctx[o] = p.in[I_CTX][o] + gate * v;
                               }
                           }, smem);
        } else {
            const size_t gid = (size_t)(it - N_G) * NTHREADS + TIDX;
            const int which = (int)(gid >> 21); const size_t e0 = (gid & 2097151) * 8;
            const float* src = p.in[which ? I_PV : I_PU] + (size_t)L * 16384 * 1024 + e0;
            const float4 a = *(const float4*)src, b = *(const float4*)(src + 4);
            bf16_t* dst = (bf16_t*)(ws + (which ? OFF_PEERV : OFF_PEERU)) + e0;
            *(uint4*)dst = make_uint4(pack2(a.x, a.y), pack2(a.z, a.w), pack2(b.x, b.y), pack2(b.z, b.w));
        }
    }
}

__device__ void phase_K(const Params& p, int L, unsigned char* smem) {
    unsigned char* ws = p.ws;
    const int tid = TIDX;
    const int mtok = (L == 0) ? TT : T;
    const bf16_t* A = (const bf16_t*)(ws + OFF_ACT);
    const bf16_t* Bt = (const bf16_t*)(ws + OFF_WQKT + L * SZ_WQKT);
    int* cand = (int*)(ws + OFF_CAND);
    const float* tc = (const float*)smem;
    int* cl = (int*)(smem + 66048);
    int* cl2 = (int*)(smem + 66048 + 32768);
    for (int it = BIDX; it < (mtok / 128) * 16; it += gridDim.x) {
        const int mt = it >> 4, hz = it & 15;
        gemm128<true>([&](int r) { return A + (size_t)(mt * 128 + r) * 1024; },
                      [&](int r) { return Bt + (size_t)(hz * 128 + r) * 1024; }, 1024,
                      [&](int, int, float) {}, smem);
        const int row = tid & 127, q = tid >> 7;
        int top[16];
#pragma unroll
        for (int j = 0; j < 16; ++j) top[j] = (int)0x80000000;
        for (int j = 0; j < 32; ++j) {
            const int col = q * 32 + j;
            const int key = (sortable(tc[row * 129 + col]) & ~0x7F) | col;
            top16_insert(top, key);
        }
#pragma unroll
        for (int j = 0; j < 16; ++j) cl[(row * 4 + q) * 16 + j] = top[j];
        __syncthreads();
        if (q < 2) {
#pragma unroll
            for (int j = 0; j < 16; ++j) top[j] = (int)0x80000000;
            for (int j = 0; j < 32; ++j) top16_insert(top, cl[(row * 4 + q * 2) * 16 + j]);
#pragma unroll
            for (int j = 0; j < 16; ++j) cl2[(row * 2 + q) * 16 + j] = top[j];
        }
        __syncthreads();
        if (q == 0) {
#pragma unroll
            for (int j = 0; j < 16; ++j) top[j] = (int)0x80000000;
            for (int j = 0; j < 32; ++j) top16_insert(top, cl2[row * 32 + j]);
            int4* dst = (int4*)(cand + ((size_t)(mt * 128 + row) * 16 + hz) * 16);
            dst[0] = make_int4(top[0], top[1], top[2], top[3]); dst[1] = make_int4(top[4], top[5], top[6], top[7]);
            dst[2] = make_int4(top[8], top[9], top[10], top[11]); dst[3] = make_int4(top[12], top[13], top[14], top[15]);
        }
        __syncthreads();
    }
}

__device__ void phase_L(const Params& p, int L) {
    const int mtok = (L == 0) ? TT : T;
    const int* cand = (const int*)(p.ws + OFF_CAND);
    int* eidx = (int*)(p.ws + OFF_EIDX);
    float* gate = (float*)(p.ws + OFF_GATE);
    const int nit = mtok * 8 / NTHREADS;
    for (int it = BIDX; it < nit; it += gridDim.x) {
        const int gid = it * NTHREADS + TIDX;
        const int tt = gid >> 3, hd = gid & 7;
        const int* c1 = cand + ((size_t)tt * 16 + hd * 2) * 16;
        const int* c2 = c1 + 16;
        float s1[16], s2[16];
        {
            const int4* a = (const int4*)c1; const int4* b = (const int4*)c2;
#pragma unroll
            for (int q = 0; q < 4; ++q) {
                int4 x = a[q], y = b[q];
                s1[q * 4] = unsortable(x.x & ~0x7F); s1[q * 4 + 1] = unsortable(x.y & ~0x7F); s1[q * 4 + 2] = unsortable(x.z & ~0x7F); s1[q * 4 + 3] = unsortable(x.w & ~0x7F);
                s2[q * 4] = unsortable(y.x & ~0x7F); s2[q * 4 + 1] = unsortable(y.y & ~0x7F); s2[q * 4 + 2] = unsortable(y.z & ~0x7F); s2[q * 4 + 3] = unsortable(y.w & ~0x7F);
            }
        }
        int top[16];
#pragma unroll
        for (int j = 0; j < 16; ++j) top[j] = (int)0x80000000;
#pragma unroll
        for (int i = 0; i < 16; ++i)
#pragma unroll
            for (int j = 0; j < 16; ++j)
                if ((i + 1) * (j + 1) <= 16) top16_insert(top, (sortable(s1[i] + s2[j]) & ~0xFF) | (i * 16 + j));
        float vals[16], sum = 0.f;
        const float mx = unsortable(top[0] & ~0xFF);
#pragma unroll
        for (int j = 0; j < 16; ++j) { vals[j] = __expf(unsortable(top[j] & ~0xFF) - mx); sum += vals[j]; }
        const float inv = 1.0f / sum;
        int ei[16];
#pragma unroll
        for (int j = 0; j < 16; ++j) {
            const int pr = top[j] & 0xFF;
            ei[j] = (c1[pr >> 4] & 0x7F) * 128 + (c2[pr & 15] & 0x7F);
            vals[j] *= inv;
        }
        int4* de = (int4*)(eidx + (size_t)tt * 128 + hd * 16);
        float4* dg = (float4*)(gate + (size_t)tt * 128 + hd * 16);
#pragma unroll
        for (int q = 0; q < 4; ++q) {
            de[q] = make_int4(ei[q * 4], ei[q * 4 + 1], ei[q * 4 + 2], ei[q * 4 + 3]);
            dg[q] = make_float4(vals[q * 4], vals[q * 4 + 1], vals[q * 4 + 2], vals[q * 4 + 3]);
        }
    }
}

__device__ void phase_M(const Params& p, int L) {
    const int lane = TIDX & 63, w = TIDX >> 6;
    const int mtok = (L == 0) ? TT : T;
    const bf16_t* hact = (const bf16_t*)(p.ws + OFF_ACT);
    const bf16_t* pu = (const bf16_t*)(p.ws + OFF_PEERU);
    const bf16_t* pv = (const bf16_t*)(p.ws + OFF_PEERV);
    const int* eidx = (const int*)(p.ws + OFF_EIDX);
    const float* gate = (const float*)(p.ws + OFF_GATE);
    const float* g2 = (const float*)(p.ws + OFF_MOD) + (size_t)L * 9 * 6144 + 5120;
    for (int it = BIDX; it < mtok / 8; it += gridDim.x) {
        const int tt = it * 8 + w;
        unsigned hp[8];
        {
            const uint4 a = *(const uint4*)(hact + (size_t)tt * 1024 + lane * 8), b = *(const uint4*)(hact + (size_t)tt * 1024 + 512 + lane * 8);
            hp[0] = a.x; hp[1] = a.y; hp[2] = a.z; hp[3] = a.w; hp[4] = b.x; hp[5] = b.y; hp[6] = b.z; hp[7] = b.w;
        }
        const int e0 = eidx[(size_t)tt * 128 + lane], e1 = eidx[(size_t)tt * 128 + 64 + lane];
        const float g0 = gate[(size_t)tt * 128 + lane], g1v = gate[(size_t)tt * 128 + 64 + lane];
        float acc[16];
#pragma unroll
        for (int d = 0; d < 16; ++d) acc[d] = 0.f;
        for (int j0 = 0; j0 < 128; j0 += 4) {
            uint4 ua[4], ub[4], va[4], vb[4]; float gt[4];
#pragma unroll
            for (int q = 0; q < 4; ++q) {
                const int j = j0 + q;
                const int e = __builtin_amdgcn_readlane(j0 < 64 ? e0 : e1, j & 63);
                gt[q] = __builtin_bit_cast(float, __builtin_amdgcn_readlane(__builtin_bit_cast(int, j0 < 64 ? g0 : g1v), j & 63));
                const bf16_t* ur = pu + (size_t)e * 1024 + lane * 8;
                const bf16_t* vr = pv + (size_t)e * 1024 + lane * 8;
                ua[q] = *(const uint4*)ur; ub[q] = *(const uint4*)(ur + 512);
                va[q] = *(const uint4*)vr; vb[q] = *(const uint4*)(vr + 512);
            }
#pragma unroll
            for (int q = 0; q < 4; ++q) {
                float d = 0.f;
                d = dot2bf(hp[0], ua[q].x, d); d = dot2bf(hp[1], ua[q].y, d); d = dot2bf(hp[2], ua[q].z, d); d = dot2bf(hp[3], ua[q].w, d);
                d = dot2bf(hp[4], ub[q].x, d); d = dot2bf(hp[5], ub[q].y, d); d = dot2bf(hp[6], ub[q].z, d); d = dot2bf(hp[7], ub[q].w, d);
                d = wave_sum(d);
                const float a = gelu_tanh(d) * gt[q];
                acc[0] += a * bflo(va[q].x); acc[1] += a * bfhi(va[q].x); acc[2] += a * bflo(va[q].y); acc[3] += a * bfhi(va[q].y);
                acc[4] += a * bflo(va[q].z); acc[5] += a * bfhi(va[q].z); acc[6] += a * bflo(va[q].w); acc[7] += a * bfhi(va[q].w);
                acc[8] += a * bflo(vb[q].x); acc[9] += a * bfhi(vb[q].x); acc[10] += a * bflo(vb[q].y); acc[11] += a * bfhi(vb[q].y);
                acc[12] += a * bflo(vb[q].z); acc[13] += a * bfhi(vb[q].z); acc[14] += a * bflo(vb[q].w); acc[15] += a * bfhi(vb[q].w);
            }
        }
        float* xr = (tt < T) ? (p.out + (size_t)tt * 1024) : ((float*)(p.ws + OFF_XCTX) + (size_t)(tt - T) * 1024);
        const float* gr = g2 + (size_t)tok_modrow(tt) * 6144;
        float xv[16];
#pragma unroll
        for (int hsel = 0; hsel < 2; ++hsel) {
            const int k = hsel * 512 + lane * 8;
            const float4 x0 = *(const float4*)(xr + k), x1 = *(const float4*)(xr + k + 4);
            const float4 q0 = *(const float4*)(gr + k), q1 = *(const float4*)(gr + k + 4);
            xv[hsel * 8 + 0] = x0.x + q0.x * acc[hsel * 8 + 0]; xv[hsel * 8 + 1] = x0.y + q0.y * acc[hsel * 8 + 1];
            xv[hsel * 8 + 2] = x0.z + q0.z * acc[hsel * 8 + 2]; xv[hsel * 8 + 3] = x0.w + q0.w * acc[hsel * 8 + 3];
            xv[hsel * 8 + 4] = x1.x + q1.x * acc[hsel * 8 + 4]; xv[hsel * 8 + 5] = x1.y + q1.y * acc[hsel * 8 + 5];
            xv[hsel * 8 + 6] = x1.z + q1.z * acc[hsel * 8 + 6]; xv[hsel * 8 + 7] = x1.w + q1.w * acc[hsel * 8 + 7];
        }
        if (L == 1) {
            float ss = 0.f;
#pragma unroll
            for (int d = 0; d < 16; ++d) ss += xv[d] * xv[d];
            ss = wave_sum(ss);
            const float r = rsqrtf(ss * (1.0f / 1024.0f) + EPS);
#pragma unroll
            for (int hsel = 0; hsel < 2; ++hsel) {
                const int k = hsel * 512 + lane * 8;
                const float4 f0 = *(const float4*)(p.in[I_FING] + k), f1 = *(const float4*)(p.in[I_FING] + k + 4);
                xv[hsel * 8 + 0] *= r * f0.x; xv[hsel * 8 + 1] *= r * f0.y; xv[hsel * 8 + 2] *= r * f0.z; xv[hsel * 8 + 3] *= r * f0.w;
                xv[hsel * 8 + 4] *= r * f1.x; xv[hsel * 8 + 5] *= r * f1.y; xv[hsel * 8 + 6] *= r * f1.z; xv[hsel * 8 + 7] *= r * f1.w;
            }
        }
#pragma unroll
        for (int hsel = 0; hsel < 2; ++hsel) {
            const int k = hsel * 512 + lane * 8;
            *(float4*)(xr + k) = make_float4(xv[hsel * 8 + 0], xv[hsel * 8 + 1], xv[hsel * 8 + 2], xv[hsel * 8 + 3]);
            *(float4*)(xr + k + 4) = make_float4(xv[hsel * 8 + 4], xv[hsel * 8 + 5], xv[hsel * 8 + 6], xv[hsel * 8 + 7]);
        }
    }
}

constexpr int N_PHASES = 1 + 2 * 13;

__device__ __forceinline__ void run_phase(const Params& p, int ph, unsigned char* smem) {
    if (ph == 0) { phase_prep(p, smem); return; }
    const int L = (ph - 1) / 13, s = (ph - 1) % 13;
    switch (s) {
        case 0: phase_A(p, L); break;
        case 1: phase_B(p, L, smem); break;
        case 2: phase_C(p, L, smem); break;
        case 3: phase_D(p, L, smem); break;
        case 4: phase_E(p, L); break;
        case 5: phase_F(p, L, smem); break;
        case 6: phase_G(p, L, smem); break;
        case 7: phase_H(p, L); break;
        case 8: phase_I(p, L, smem); break;
        case 9: norm_tokens(p, L, 1, (L == 0) ? TT : T, false, 0, ((L == 0) ? TT : T) / 8); break;
        case 10: phase_K(p, L, smem); break;
        case 11: phase_L(p, L); break;
        default: phase_M(p, L); break;
    }
}

__global__ void __launch_bounds__(NTHREADS) fwd_megakernel(Params p) {
    extern __shared__ __attribute__((aligned(16))) unsigned char smem[];
    cg::grid_group grid = cg::this_grid();
    for (int ph = p.ph_lo; ph < p.ph_hi; ++ph) {
        run_phase(p, ph, smem);
        if (ph + 1 < p.ph_hi) grid.sync();
    }
}

extern "C" void kernel_launch(void* const* d_in, const int* in_sizes, int n_in, void* d_out, int out_size, void* d_ws, size_t ws_size,
                              hipStream_t stream) {
    static int grid_blocks = 0;
    if (grid_blocks == 0) {
        if (n_in != 27 || out_size != T * D || ws_size < WS_END) {
            fprintf(stderr, "kernel_launch: unexpected problem (n_in %d, out %d, ws %zu, need %zu)\n", n_in, out_size, ws_size, (size_t)WS_END);
            grid_blocks = -1; return;
        }
        int dev = 0, cus = 0, per_cu = 0;
        hipGetDevice(&dev);
        hipDeviceGetAttribute(&cus, hipDeviceAttributeMultiprocessorCount, dev);
        hipFuncSetAttribute((const void*)fwd_megakernel, hipFuncAttributeMaxDynamicSharedMemorySize, SMEM_BYTES);
        hipOccupancyMaxActiveBlocksPerMultiprocessor(&per_cu, (const void*)fwd_megakernel, NTHREADS, SMEM_BYTES);
        if (per_cu < 1) { fprintf(stderr, "kernel_launch: occupancy query returned %d\n", per_cu); per_cu = 1; }
        if (per_cu > 1) per_cu = 1;
        grid_blocks = cus * per_cu;
    }
    if (grid_blocks < 0) return;
    Params p{};
    for (int i = 0; i < 27; ++i) p.in[i] = (const float*)d_in[i];
    p.out = (float*)d_out; p.ws = (unsigned char*)d_ws;
#if SPLIT_LAUNCH
    for (int ph = 0; ph < N_PHASES; ++ph) {
        p.ph_lo = ph; p.ph_hi = ph + 1;
        void* args[] = {&p};
        hipError_t e = hipLaunchCooperativeKernel((const void*)fwd_megakernel, dim3(grid_blocks), dim3(NTHREADS), args, SMEM_BYTES, stream);
        if (e != hipSuccess) { fprintf(stderr, "launch failed: %s\n", hipGetErrorString(e)); return; }
    }
#else
    p.ph_lo = 0; p.ph_hi = N_PHASES;
    void* args[] = {&p};
    hipError_t e = hipLaunchCooperativeKernel((const void*)fwd_megakernel, dim3(grid_blocks), dim3(NTHREADS), args, SMEM_BYTES, stream);
    if (e != hipSuccess) fprintf(stderr, "cooperative launch failed: %s (grid %d)\n", hipGetErrorString(e), grid_blocks);
#endif
}
```

```cpp
#include <hip/hip_runtime.h>
#include <hip/hip_cooperative_groups.h>
#include <cstdio>
#include <cstdint>
namespace cg = cooperative_groups;

#define NTHREADS 512
#ifndef PROBE_MASK
#define PROBE_MASK 0
#endif
#ifndef SPLIT_LAUNCH
#define SPLIT_LAUNCH 0
#endif

typedef unsigned short bf16_t;
typedef __attribute__((ext_vector_type(8))) short bf16x8;
typedef __attribute__((ext_vector_type(4))) float f32x4;
typedef __attribute__((ext_vector_type(2))) __bf16 bf16x2_t;

constexpr int D = 1024, NB = 8, SEQ = 4096, T = NB * SEQ, CTXL = 256, TC = NB * CTXL, TT = T + TC;
constexpr int INW = 2048;
constexpr int NCHB = 136;
constexpr int NCH = NB * NCHB;
constexpr int NCHP = 1152;
constexpr int KV = 768;
constexpr float EPS = 1e-6f;

constexpr size_t al256(size_t x) { return (x + 255) & ~(size_t)255; }
constexpr size_t OFF_ACT = 0;                                   constexpr size_t SZ_ACT = (size_t)TT * 1024 * 2;
constexpr size_t OFF_XIN = al256(OFF_ACT + SZ_ACT);             constexpr size_t SZ_XIN = (size_t)TT * 2048 * 2;
constexpr size_t OFF_YMIX = al256(OFF_XIN + SZ_XIN);            constexpr size_t SZ_YMIX = (size_t)TT * 1024 * 2;
constexpr size_t OFF_XCTX = al256(OFF_YMIX + SZ_YMIX);          constexpr size_t SZ_XCTX = (size_t)TC * 1024 * 4;
constexpr size_t OFF_ZT = al256(OFF_XCTX + SZ_XCTX);            constexpr size_t SZ_ZT = (size_t)NB * 256 * 8192 * 2;
constexpr size_t OFF_ZTC = al256(OFF_ZT + SZ_ZT);               constexpr size_t SZ_ZTC = (size_t)NB * 256 * 512 * 2;
constexpr size_t OFF_VG = al256(OFF_ZTC + SZ_ZTC);              constexpr size_t SZ_VG = (size_t)16 * NCHP * KV * 2;
constexpr size_t OFF_SC = al256(OFF_VG + SZ_VG);                constexpr size_t SZ_SC = (size_t)16 * NCH * 256 * 4;
constexpr size_t OFF_GBUF = al256(OFF_SC + SZ_SC);              constexpr size_t SZ_GBUF = (size_t)TT * 256 * 2;
constexpr size_t OFF_DFTL = al256(OFF_GBUF + SZ_GBUF);          constexpr size_t SZ_DFTL = (size_t)4096 * 8192 * 2;
constexpr size_t OFF_DFTC = al256(OFF_DFTL + SZ_DFTL);          constexpr size_t SZ_DFTC = (size_t)256 * 512 * 2;
constexpr size_t OFF_DFTD = al256(OFF_DFTC + SZ_DFTC);          constexpr size_t SZ_DFTD = (size_t)128 * 64 * 2;
constexpr size_t SZ_WINT = (size_t)2048 * 1024 * 2, SZ_WOUTT = (size_t)1024 * 1024 * 2, SZ_WQKT = (size_t)2048 * 1024 * 2, SZ_WGLUT = (size_t)256 * 256 * 2;
constexpr size_t OFF_WINT = al256(OFF_DFTD + SZ_DFTD);
constexpr size_t OFF_WOUTT = al256(OFF_WINT + 2 * SZ_WINT);
constexpr size_t OFF_WQKT = al256(OFF_WOUTT + 2 * SZ_WOUTT);
constexpr size_t OFF_WGLUT = al256(OFF_WQKT + 2 * SZ_WQKT);
constexpr size_t OFF_WCOMB = al256(OFF_WGLUT + 2 * SZ_WGLUT);   constexpr size_t SZ_WCOMB = (size_t)16 * 512 * KV * 2;
constexpr size_t OFF_WST = al256(OFF_WCOMB + SZ_WCOMB);         constexpr size_t SZ_WST = (size_t)16 * 256 * 512 * 2;
constexpr size_t OFF_POWA = al256(OFF_WST + SZ_WST);            constexpr size_t SZ_POWA = (size_t)2 * 2 * 16 * 33 * 64 * 8;
constexpr size_t OFF_BBAR = al256(OFF_POWA + SZ_POWA);          constexpr size_t SZ_BBAR = (size_t)2 * 2 * 16 * 64 * 16 * 8;
constexpr size_t OFF_KTAU = al256(OFF_BBAR + SZ_BBAR);          constexpr size_t SZ_KTAU = (size_t)2 * 2 * 16 * 32 * 256 * 4;
constexpr size_t OFF_MOD = al256(OFF_KTAU + SZ_KTAU);           constexpr size_t SZ_MOD = (size_t)2 * 9 * 6144 * 4;
constexpr size_t WS_END = al256(OFF_MOD + SZ_MOD);
constexpr size_t OFF_PEERU = OFF_XIN;                            constexpr size_t SZ_PEERT = (size_t)16384 * 1024;
constexpr size_t OFF_PEERV = OFF_PEERU + SZ_PEERT;
constexpr size_t OFF_PSCU = OFF_PEERV + SZ_PEERT;                constexpr size_t SZ_PSC = (size_t)16384 * 4;
constexpr size_t OFF_PSCV = OFF_PSCU + SZ_PSC;
constexpr size_t OFF_CAND = OFF_PSCV + SZ_PSC;                   constexpr size_t SZ_CAND = (size_t)TT * 256 * 4;
constexpr size_t OFF_EIDX = OFF_CAND + SZ_CAND;                  constexpr size_t SZ_EIDX = (size_t)TT * 128 * 4;
constexpr size_t OFF_GATE = OFF_EIDX + SZ_EIDX;
static_assert(OFF_GATE + SZ_EIDX <= OFF_XIN + SZ_XIN, "PEER overlays must fit in the XIN region");

constexpr int SMEM_BYTES = 116736;

struct Params {
    const float* in[27];
    float* out;
    unsigned char* ws;
    int ph_lo, ph_hi;
};
enum { I_X = 0, I_C, I_CTX, I_CCTX, I_ADAW, I_ADAB, I_N1G, I_N2G, I_WIN, I_RPB, I_CONVW, I_ARE, I_AIM, I_BRE, I_BIM, I_CRE, I_CIM,
       I_LOGDT, I_S5D, I_WGLU, I_GRPG, I_WOUT, I_WQ, I_KEYS, I_PU, I_PV, I_FING };


__device__ __forceinline__ int tidx_l() { int t = threadIdx.x; asm volatile("" : "+v"(t)); return t; }
__device__ __forceinline__ int bidx_l() { int t = blockIdx.x; asm volatile("" : "+s"(t)); return t; }
#define TIDX (tidx_l())
#define BIDX (bidx_l())
__device__ __forceinline__ bf16_t f2bf(float f) { unsigned u = __float_as_uint(f); u += 0x7FFFu + ((u >> 16) & 1u); return (bf16_t)(u >> 16); }
__device__ __forceinline__ float bf2f(bf16_t h) { return __uint_as_float(((unsigned)h) << 16); }
__device__ __forceinline__ unsigned pack2(float a, float b) { return (unsigned)f2bf(a) | ((unsigned)f2bf(b) << 16); }
__device__ __forceinline__ float bflo(unsigned u) { return __uint_as_float(u << 16); }
__device__ __forceinline__ float bfhi(unsigned u) { return __uint_as_float(u & 0xffff0000u); }
__device__ __forceinline__ float dot2bf(unsigned a, unsigned b, float c) {
    return __builtin_amdgcn_fdot2_f32_bf16(__builtin_bit_cast(bf16x2_t, a), __builtin_bit_cast(bf16x2_t, b), c, false);
}
__device__ __forceinline__ float gelu_tanh(float x) {
    float z = 0.7978845608028654f * (x + 0.044715f * x * x * x);
    float e = __expf(2.0f * z);
    float th = 1.0f - 2.0f / (e + 1.0f);
    return 0.5f * x * (1.0f + th);
}
__device__ __forceinline__ float sigmoidf_(float x) { return 1.0f / (1.0f + __expf(-x)); }
__device__ __forceinline__ float wave_sum(float v) {
#pragma unroll
    for (int o = 32; o >= 1; o >>= 1) v += __shfl_xor(v, o);
    return v;
}
__device__ __forceinline__ int sortable(float v) { int b = __float_as_int(v); return b ^ ((b >> 31) & 0x7FFFFFFF); }
__device__ __forceinline__ float unsortable(int s) { return __int_as_float(s ^ ((s >> 31) & 0x7FFFFFFF)); }
__device__ __forceinline__ void top16_insert(int (&top)[16], int x) {
#pragma unroll
    for (int j = 0; j < 16; ++j) { int hi = max(top[j], x); x = min(top[j], x); top[j] = hi; }
}
__device__ __forceinline__ int tok_modrow(int tt) { return tt < T ? (tt >> 12) : 8; }

template <bool TO_LDS, typename FA, typename FB, typename FE>
__device__ __forceinline__ void gemm128(FA arow, FB brow, int K, FE epi, unsigned char* smem) {
    const int tid = TIDX, lane = tid & 63, w = tid >> 6;
    const int wm = w >> 2, wn = w & 3;
    const bf16_t* pa[2]; const bf16_t* pb[2]; int soff[2];
#pragma unroll
    for (int i = 0; i < 2; ++i) {
        int c = tid + 512 * i, row = c >> 3, kc = c & 7;
        pa[i] = arow(row) + kc * 8; pb[i] = brow(row) + kc * 8;
        soff[i] = row * 128 + ((kc ^ (row & 7)) << 4);
    }
    __syncthreads();
    f32x4 acc[4][2];
#pragma unroll
    for (int i = 0; i < 4; ++i)
#pragma unroll
        for (int j = 0; j < 2; ++j) acc[i][j] = f32x4{0.f, 0.f, 0.f, 0.f};
    uint4 ra[2], rb[2];
#pragma unroll
    for (int i = 0; i < 2; ++i) { ra[i] = *(const uint4*)pa[i]; rb[i] = *(const uint4*)pb[i]; }
#pragma unroll
    for (int i = 0; i < 2; ++i) { *(uint4*)(smem + soff[i]) = ra[i]; *(uint4*)(smem + 16384 + soff[i]) = rb[i]; }
    __syncthreads();
    const int nk = K >> 6;
    const int lr = lane & 15, lg = lane >> 4, sw = lane & 7;
    for (int kt = 0; kt < nk; ++kt) {
        const int cur = kt & 1;
        if (kt + 1 < nk) {
#pragma unroll
            for (int i = 0; i < 2; ++i) { ra[i] = *(const uint4*)(pa[i] + (kt + 1) * 64); rb[i] = *(const uint4*)(pb[i] + (kt + 1) * 64); }
        }
        const unsigned char* sA = smem + cur * 32768;
        const unsigned char* sB = sA + 16384;
#pragma unroll
        for (int ks = 0; ks < 2; ++ks) {
            bf16x8 af[4], bfv[2];
            const int choff = (((ks * 4 + lg) ^ sw) << 4);
#pragma unroll
            for (int fi = 0; fi < 4; ++fi) af[fi] = *(const bf16x8*)(sA + (wm * 64 + fi * 16 + lr) * 128 + choff);
#pragma unroll
            for (int fj = 0; fj < 2; ++fj) bfv[fj] = *(const bf16x8*)(sB + (wn * 32 + fj * 16 + lr) * 128 + choff);
#pragma unroll
            for (int fi = 0; fi < 4; ++fi)
#pragma unroll
                for (int fj = 0; fj < 2; ++fj) acc[fi][fj] = __builtin_amdgcn_mfma_f32_16x16x32_bf16(af[fi], bfv[fj], acc[fi][fj], 0, 0, 0);
        }
        if (kt + 1 < nk) {
            unsigned char* dA = smem + (cur ^ 1) * 32768;
#pragma unroll
            for (int i = 0; i < 2; ++i) { *(uint4*)(dA + soff[i]) = ra[i]; *(uint4*)(dA + 16384 + soff[i]) = rb[i]; }
        }
        __syncthreads();
    }
    if (TO_LDS) {
        float* tc = (float*)smem;
#pragma unroll
        for (int fi = 0; fi < 4; ++fi)
#pragma unroll
            for (int fj = 0; fj < 2; ++fj)
#pragma unroll
                for (int j = 0; j < 4; ++j) tc[(wm * 64 + fi * 16 + lg * 4 + j) * 129 + wn * 32 + fj * 16 + lr] = acc[fi][fj][j];
        __syncthreads();
    } else {
#pragma unroll
        for (int fi = 0; fi < 4; ++fi)
#pragma unroll
            for (int fj = 0; fj < 2; ++fj)
#pragma unroll
                for (int j = 0; j < 4; ++j) epi(wm * 64 + fi * 16 + lg * 4 + j, wn * 32 + fj * 16 + lr, acc[fi][fj][j]);
    }
}

__device__ void phase_prep(const Params& p, unsigned char* smem) {
    const int tid = TIDX, lane = tid & 63, w = tid >> 6;
    unsigned char* ws = p.ws;
    constexpr int N_MOD = 192, N_TR = 1568, N_WQK = 512, N_DFTL = 4096, N_DFTS = 1, N_S5T = 8;
    constexpr int O_TR = N_MOD, O_WQK = O_TR + N_TR, O_DFTL = O_WQK + N_WQK, O_DFTS = O_DFTL + N_DFTL, O_S5T = O_DFTS + N_DFTS, N_ALL = O_S5T + N_S5T;
    float* tab = (float*)(smem + 98304);
    for (int j = tid; j < 4096; j += NTHREADS) tab[j] = cospif((float)j * (1.0f / 2048.0f));
    __syncthreads();
    for (int it = BIDX; it < N_ALL; it += gridDim.x) {
        if (it < O_TR) {
            const int L = it / 96, c0 = (it % 96) * 64;
            float* sv = (float*)smem;
            float* red = (float*)(smem + 36864);
            for (int idx = tid; idx < 9 * 1024; idx += NTHREADS) {
                int r = idx >> 10, k = idx & 1023;
                float v = (r < 8) ? p.in[I_C][r * 1024 + k] : p.in[I_CCTX][k];
                sv[idx] = v / (1.0f + __expf(-v));
            }
            __syncthreads();
            float acc[9];
#pragma unroll
            for (int r = 0; r < 9; ++r) acc[r] = 0.f;
            const float* aw = p.in[I_ADAW] + (size_t)L * 1024 * 6144 + c0 + lane;
            for (int k = w * 128; k < w * 128 + 128; ++k) {
                float wv = aw[(size_t)k * 6144];
#pragma unroll
                for (int r = 0; r < 9; ++r) acc[r] += sv[r * 1024 + k] * wv;
            }
#pragma unroll
            for (int r = 0; r < 9; ++r) red[(w * 9 + r) * 64 + lane] = acc[r];
            __syncthreads();
            for (int o = tid; o < 576; o += NTHREADS) {
                int r = o >> 6, col = o & 63;
                float s = 0.f;
#pragma unroll
                for (int ww = 0; ww < 8; ++ww) s += red[(ww * 9 + r) * 64 + col];
                ((float*)(ws + OFF_MOD))[(size_t)(L * 9 + r) * 6144 + c0 + col] = s + p.in[I_ADAB][L * 6144 + c0 + col];
            }
            __syncthreads();
        } else if (it < O_WQK) {
            int idx = it - O_TR;
            const int L = idx / 784; int rem = idx % 784;
            const float* src; bf16_t* dst; int Kd, Nd, tk, tn;
            if (rem < 512) { tk = rem >> 5; tn = rem & 31; Kd = 1024; Nd = 2048; src = p.in[I_WIN] + (size_t)L * 1024 * 2048; dst = (bf16_t*)(ws + OFF_WINT + L * SZ_WINT); }
            else if (rem < 768) { rem -= 512; tk = rem >> 4; tn = rem & 15; Kd = 1024; Nd = 1024; src = p.in[I_WOUT] + (size_t)L * 1024 * 1024; dst = (bf16_t*)(ws + OFF_WOUTT + L * SZ_WOUTT); }
            else { rem -= 768; tk = rem >> 2; tn = rem & 3; Kd = 256; Nd = 256; src = p.in[I_WGLU] + (size_t)L * 256 * 256; dst = (bf16_t*)(ws + OFF_WGLUT + L * SZ_WGLUT); }
            float* tl = (float*)smem;
#pragma unroll
            for (int i = 0; i < 8; ++i) { int kk = i * 8 + w, nn = lane; tl[kk * 65 + nn] = src[(size_t)(tk * 64 + kk) * Nd + tn * 64 + nn]; }
            __syncthreads();
#pragma unroll
            for (int i = 0; i < 8; ++i) { int nn = i * 8 + w, kk = lane; dst[(size_t)(tn * 64 + nn) * Kd + tk * 64 + kk] = f2bf(tl[kk * 65 + nn]); }
            __syncthreads();
        } else if (it < O_DFTL) {
            int idx = it - O_WQK;
            const int L = idx >> 8, hz = (idx >> 4) & 15, kb = idx & 15;
            const int kk = kb * 64 + lane;
            const float* wqrow = p.in[I_WQ] + (size_t)L * 1024 * 2048 + (size_t)kk * 2048 + hz * 128;
            const float* keys = p.in[I_KEYS] + ((size_t)(L * 16 + hz) * 128 + w * 16) * 128;
            float acc[16];
#pragma unroll
            for (int j = 0; j < 16; ++j) acc[j] = 0.f;
            for (int d4 = 0; d4 < 32; ++d4) {
                float4 wv = *(const float4*)(wqrow + d4 * 4);
#pragma unroll
                for (int j = 0; j < 16; ++j) {
                    float4 kv = *(const float4*)(keys + j * 128 + d4 * 4);
                    acc[j] += wv.x * kv.x + wv.y * kv.y + wv.z * kv.z + wv.w * kv.w;
                }
            }
            bf16_t* dst = (bf16_t*)(ws + OFF_WQKT + L * SZ_WQKT);
#pragma unroll
            for (int j = 0; j < 16; ++j) dst[(size_t)(hz * 128 + w * 16 + j) * 1024 + kk] = f2bf(acc[j]);
        } else if (it < O_DFTS) {
            const int k = it - O_DFTL;
            bf16_t* dst = (bf16_t*)(ws + OFF_DFTL) + (size_t)k * 8192;
#pragma unroll
            for (int i = 0; i < 2; ++i) {
                int c = tid + 512 * i, part = c >> 9, l0 = (c & 511) * 8;
                unsigned pk[4];
#pragma unroll
                for (int e = 0; e < 4; ++e) {
                    int i0 = ((k * (l0 + 2 * e)) + part * 1024) & 4095, i1 = ((k * (l0 + 2 * e + 1)) + part * 1024) & 4095;
                    pk[e] = pack2(tab[i0] * (1.0f / 512.0f), tab[i1] * (1.0f / 512.0f));
                }
                *(uint4*)(dst + part * 4096 + l0) = make_uint4(pk[0], pk[1], pk[2], pk[3]);
            }
        } else if (it < O_S5T) {
            bf16_t* dc = (bf16_t*)(ws + OFF_DFTC);
            for (int c = tid; c < 16384; c += NTHREADS) {
                int k = c >> 6, cc = c & 63, part = cc >> 5, l0 = (cc & 31) * 8;
                unsigned pk[4];
#pragma unroll
                for (int e = 0; e < 4; ++e) {
                    int i0 = ((((k * (l0 + 2 * e)) & 255) << 4) + part * 1024) & 4095, i1 = ((((k * (l0 + 2 * e + 1)) & 255) << 4) + part * 1024) & 4095;
                    pk[e] = pack2(tab[i0] * (1.0f / 128.0f), tab[i1] * (1.0f / 128.0f));
                }
                *(uint4*)(dc + (size_t)k * 512 + part * 256 + l0) = make_uint4(pk[0], pk[1], pk[2], pk[3]);
            }
            bf16_t* dd = (bf16_t*)(ws + OFF_DFTD);
            for (int c = tid; c < 1024; c += NTHREADS) {
                int m = c >> 3, d0 = (c & 7) * 8, kd = m & 63, sh = (m >= 64) ? 3072 : 0;
                unsigned pk[4];
#pragma unroll
                for (int e = 0; e < 4; ++e) {
                    int i0 = ((((kd * (d0 + 2 * e)) & 63) << 6) + sh) & 4095, i1 = ((((kd * (d0 + 2 * e + 1)) & 63) << 6) + sh) & 4095;
                    pk[e] = pack2(tab[i0], tab[i1]);
                }
                *(uint4*)(dd + m * 64 + d0) = make_uint4(pk[0], pk[1], pk[2], pk[3]);
            }
        } else {
            const int gid = (it - O_S5T) * NTHREADS + tid;
            const int ia = gid;
            const float are = p.in[I_ARE][ia], aim = p.in[I_AIM][ia];
            const float dt = expf(p.in[I_LOGDT][ia >> 6]);
            float2* pw = (float2*)(ws + OFF_POWA) + (size_t)(ia >> 6) * 33 * 64 + (ia & 63);
            float abr = 1.f, abi = 0.f;
            for (int tau = 0; tau <= 32; ++tau) {
                float mag = expf(are * dt * (float)tau), s, c;
                sincosf(aim * dt * (float)tau, &s, &c);
                pw[tau * 64] = make_float2(mag * c, mag * s);
                if (tau == 1) { abr = mag * c; abi = mag * s; }
            }
            const float nr = abr - 1.0f, ni = abi, den = are * are + aim * aim;
            const float qr = (nr * are + ni * aim) / den, qi = (ni * are - nr * aim) / den;
            float2* bb = (float2*)(ws + OFF_BBAR) + (size_t)ia * 16;
#pragma unroll
            for (int h = 0; h < 16; ++h) {
                float br = p.in[I_BRE][(size_t)ia * 16 + h], bi = p.in[I_BIM][(size_t)ia * 16 + h];
                bb[h] = make_float2(qr * br - qi * bi, qr * bi + qi * br);
            }
        }
    }
}

__device__ void norm_tokens(const Params& p, int L, int which, int ntok, bool from_input, int item0, int nitems_total) {
    const int tid = TIDX, lane = tid & 63, w = tid >> 6;
    const float* modL = (const float*)(p.ws + OFF_MOD) + (size_t)L * 9 * 6144;
    const float* gvec = p.in[which ? I_N2G : I_N1G] + L * 1024;
    bf16_t* dst = (bf16_t*)(p.ws + OFF_ACT);
    for (int it = item0 + BIDX; it < nitems_total; it += gridDim.x) {
        if (it < item0) continue;
        const int tt = (it - item0) * 8 + w;
        if (tt >= ntok) continue;
        const float* src;
        if (tt < T) src = (from_input ? p.in[I_X] : p.out) + (size_t)tt * 1024;
        else src = (from_input ? p.in[I_CTX] : (const float*)(p.ws + OFF_XCTX)) + (size_t)(tt - T) * 1024;
        const float* sh = modL + (size_t)tok_modrow(tt) * 6144 + (which ? 3072 : 0);
        const float* sc = sh + 1024;
        float4 v[4]; float ss = 0.f;
#pragma unroll
        for (int i = 0; i < 4; ++i) { v[i] = *(const float4*)(src + (i * 64 + lane) * 4); ss += v[i].x * v[i].x + v[i].y * v[i].y + v[i].z * v[i].z + v[i].w * v[i].w; }
        ss = wave_sum(ss);
        const float r = rsqrtf(ss * (1.0f / 1024.0f) + EPS);
#pragma unroll
        for (int i = 0; i < 4; ++i) {
            const int k = (i * 64 + lane) * 4;
            float4 g = *(const float4*)(gvec + k), a = *(const float4*)(sc + k), b = *(const float4*)(sh + k);
            float o0 = v[i].x * r * g.x * (1.f + a.x) + b.x, o1 = v[i].y * r * g.y * (1.f + a.y) + b.y;
            float o2 = v[i].z * r * g.z * (1.f + a.z) + b.z, o3 = v[i].w * r * g.w * (1.f + a.w) + b.w;
            *(uint2*)(dst + (size_t)tt * 1024 + k) = make_uint2(pack2(o0, o1), pack2(o2, o3));
        }
    }
}

__device__ void phase_A(const Params& p, int L) {
    const int n_norm = TT / 8;
    const int n_kt = (L == 0) ? 1024 : 0;
    for (int it = BIDX; it < n_kt; it += gridDim.x) {
        const int gid = it * NTHREADS + TIDX;
        const int hp = gid & 15, h = (gid >> 4) & 15, tau = (gid >> 8) & 31, ldg = gid >> 13;
        const float* cre = p.in[I_CRE] + ((size_t)ldg * 16 + h) * 64;
        const float* cim = p.in[I_CIM] + ((size_t)ldg * 16 + h) * 64;
        const float2* pw = (const float2*)(p.ws + OFF_POWA) + ((size_t)ldg * 33 + tau) * 64;
        const float2* bb = (const float2*)(p.ws + OFF_BBAR) + (size_t)ldg * 64 * 16 + hp;
        float acc = 0.f;
        for (int q = 0; q < 64; ++q) {
            float2 a = pw[q], b = bb[q * 16];
            float cr = cre[q], ci = cim[q];
            float wr = cr * a.x - ci * a.y, wi = cr * a.y + ci * a.x;
            acc += wr * b.x - wi * b.y;
        }
        ((float*)(p.ws + OFF_KTAU))[gid] = acc;
    }
    norm_tokens(p, L, 0, TT, L == 0, n_kt, n_kt + n_norm);
}

__device__ void phase_B(const Params& p, int L, unsigned char* smem) {
    unsigned char* ws = p.ws;
    constexpr int N_G = (TT / 128) * 16, N_WC = 1536, N_WS = 512;
    const bf16_t* A = (const bf16_t*)(ws + OFF_ACT);
    const bf16_t* Bt = (const bf16_t*)(ws + OFF_WINT + L * SZ_WINT);
    bf16_t* xin = (bf16_t*)(ws + OFF_XIN);
    for (int it = BIDX; it < N_G + N_WC + N_WS; it += gridDim.x) {
        if (it < N_G) {
            const int mt = it >> 4, nt = it & 15;
            gemm128<false>([&](int r) { return A + (size_t)(mt * 128 + r) * 1024; },
                           [&](int r) { return Bt + (size_t)(nt * 128 + r) * 1024; }, 1024,
                           [&](int m, int n, float v) { xin[(size_t)(mt * 128 + m) * 2048 + nt * 128 + n] = f2bf(v); }, smem);
        } else if (it < N_G + N_WC) {
            const int cid = (it - N_G) * NTHREADS + TIDX;
            const int kc = cid % 96, m = (cid / 96) & 511, g = cid / (96 * 512);
            const int i = m >> 4, h = m & 15;
            float vals[8];
            if (kc < 32) {
                const int dr = kc >> 4, ri = (kc >> 3) & 1, p0 = (kc & 7) * 8;
                const int ldg = (L * 2 + dr) * 16 + g;
                const int e = dr == 0 ? (i + 1) : (32 - i);
                const float2* pw = (const float2*)(ws + OFF_POWA) + ((size_t)ldg * 33 + e) * 64 + p0;
                const float* cre = p.in[I_CRE] + ((size_t)ldg * 16 + h) * 64 + p0;
                const float* cim = p.in[I_CIM] + ((size_t)ldg * 16 + h) * 64 + p0;
#pragma unroll
                for (int q = 0; q < 8; ++q) {
                    float2 a = pw[q]; float cr = cre[q], ci = cim[q];
                    float wr = cr * a.x - ci * a.y, wi = cr * a.y + ci * a.x;
                    vals[q] = ri == 0 ? wr : -wi;
                }
            } else {
                const int kk = (kc - 32) * 8, j = kk >> 4, h0 = kk & 15;
                const float* kf = (const float*)(ws + OFF_KTAU) + (size_t)((L * 2 + 0) * 16 + g) * 32 * 256;
                const float* kb = (const float*)(ws + OFF_KTAU) + (size_t)((L * 2 + 1) * 16 + g) * 32 * 256;
#pragma unroll
                for (int q = 0; q < 8; ++q) {
                    float v = 0.f;
                    if (j <= i) v += kf[((i - j) * 16 + h) * 16 + h0 + q];
                    if (j >= i) v += kb[((j - i) * 16 + h) * 16 + h0 + q];
                    vals[q] = v;
                }
            }
            bf16_t* dst = (bf16_t*)(ws + OFF_WCOMB) + ((size_t)g * 512 + m) * KV + kc * 8;
            *(uint4*)dst = make_uint4(pack2(vals[0], vals[1]), pack2(vals[2], vals[3]), pack2(vals[4], vals[5]), pack2(vals[6], vals[7]));
        } else {
            const int cid = (it - N_G - N_WC) * NTHREADS + TIDX;
            const int kc = cid & 63, m = (cid >> 6) & 255, g = cid >> 14;
            const int dr = m >> 7, ri = (m >> 6) & 1, pp = m & 63;
            const int j = kc >> 1, h0 = (kc & 1) * 8;
            const int ldg = (L * 2 + dr) * 16 + g;
            const int e = dr == 0 ? (31 - j) : j;
            const float2 a = ((const float2*)(ws + OFF_POWA))[((size_t)ldg * 33 + e) * 64 + pp];
            const float2* bb = (const float2*)(ws + OFF_BBAR) + ((size_t)ldg * 64 + pp) * 16 + h0;
            float vals[8];
#pragma unroll
            for (int q = 0; q < 8; ++q) { float2 b = bb[q]; vals[q] = ri == 0 ? (a.x * b.x - a.y * b.y) : (a.x * b.y + a.y * b.x); }
            bf16_t* dst = (bf16_t*)(ws + OFF_WST) + ((size_t)g * 256 + m) * 512 + kc * 8;
            *(uint4*)dst = make_uint4(pack2(vals[0], vals[1]), pack2(vals[2], vals[3]), pack2(vals[4], vals[5]), pack2(vals[6], vals[7]));
        }
    }
}

__device__ __forceinline__ void attn_block16(const unsigned (&qp)[32], const bf16_t* kbase, const float* rp, float* sl,
                                             float& mrun, float& lrun, float (&acc)[64]) {
    float bm = -3.0e38f;
#pragma unroll 1
    for (int jj = 0; jj < 16; ++jj) {
        const uint4* kp = (const uint4*)(kbase + (size_t)jj * 2048);
        float d = 0.f;
#pragma unroll
        for (int c = 0; c < 8; ++c) {
            uint4 kv = kp[c];
            d = dot2bf(qp[c * 4 + 0], kv.x, d); d = dot2bf(qp[c * 4 + 1], kv.y, d);
            d = dot2bf(qp[c * 4 + 2], kv.z, d); d = dot2bf(qp[c * 4 + 3], kv.w, d);
        }
        d = d * 0.125f + (rp ? rp[jj] : 0.f);
        sl[jj * NTHREADS] = d;
        bm = fmaxf(bm, d);
    }
    const float mn = fmaxf(mrun, bm);
    const float corr = __expf(mrun - mn);
    mrun = mn; lrun *= corr;
#pragma unroll
    for (int d = 0; d < 64; ++d) acc[d] *= corr;
#pragma unroll 1
    for (int jj = 0; jj < 16; ++jj) {
        const float pw = __expf(sl[jj * NTHREADS] - mn);
        lrun += pw;
        const uint4* vp = (const uint4*)(kbase + (size_t)jj * 2048 + 256);
#pragma unroll
        for (int c = 0; c < 8; ++c) {
            uint4 vv = vp[c];
            acc[c * 8 + 0] += pw * bflo(vv.x); acc[c * 8 + 1] += pw * bfhi(vv.x);
            acc[c * 8 + 2] += pw * bflo(vv.y); acc[c * 8 + 3] += pw * bfhi(vv.y);
            acc[c * 8 + 4] += pw * bflo(vv.z); acc[c * 8 + 5] += pw * bfhi(vv.z);
            acc[c * 8 + 6] += pw * bflo(vv.w); acc[c * 8 + 7] += pw * bfhi(vv.w);
        }
    }
}

__device__ void attn_item(const Params& p, int L, int item, float* sl) {
    const int lane = TIDX & 63;
    const bf16_t* xin = (const bf16_t*)(p.ws + OFF_XIN);
    bf16_t* ymix = (bf16_t*)(p.ws + OFF_YMIX);
    int b, h, r = 0, qtok; bool lat = item < 2048;
    if (lat) { b = item >> 8; r = (item >> 2) & 63; h = item & 3; qtok = b * 4096 + r * 64 + lane; }
    else { int q = item - 2048; b = q >> 4; h = (q >> 2) & 3; qtok = T + b * 256 + (q & 3) * 64 + lane; }
    unsigned qp[32];
    {
        const uint4* qs = (const uint4*)(xin + (size_t)qtok * 2048 + h * 64);
#pragma unroll
        for (int c = 0; c < 8; ++c) { uint4 v = qs[c]; qp[c * 4] = v.x; qp[c * 4 + 1] = v.y; qp[c * 4 + 2] = v.z; qp[c * 4 + 3] = v.w; }
    }
    float acc[64];
#pragma unroll
    for (int d = 0; d < 64; ++d) acc[d] = 0.f;
    float mrun = -3.0e38f, lrun = 0.f;
    const bf16_t* kctx = xin + (size_t)(T + b * 256) * 2048 + 256 + h * 64;
#pragma unroll 1
    for (int blk = 0; blk < 16; ++blk) attn_block16(qp, kctx + (size_t)(blk * 16) * 2048, nullptr, sl, mrun, lrun, acc);
    if (lat) {
        const int rs = min(max(r - 4, 0), 56), cs = min(max(lane - 8, 0), 48);
        const float* rpb = p.in[I_RPB] + (size_t)(L * 4 + h) * 15 * 31;
#pragma unroll 1
        for (int kr = 0; kr < 8; ++kr) {
            const int R = rs + kr;
            const bf16_t* kbase = xin + (size_t)(b * 4096 + R * 64 + cs) * 2048 + 256 + h * 64;
            const float* rp = rpb + (R - r + 7) * 31 + (cs - lane + 15);
            attn_block16(qp, kbase, rp, sl, mrun, lrun, acc);
        }
    }
    const float inv = 1.0f / lrun;
    uint4* dst = (uint4*)(ymix + (size_t)qtok * 1024 + h * 64);
#pragma unroll
    for (int c = 0; c < 8; ++c)
        dst[c] = make_uint4(pack2(acc[c * 8] * inv, acc[c * 8 + 1] * inv), pack2(acc[c * 8 + 2] * inv, acc[c * 8 + 3] * inv),
                            pack2(acc[c * 8 + 4] * inv, acc[c * 8 + 5] * inv), pack2(acc[c * 8 + 6] * inv, acc[c * 8 + 7] * inv));
}

__device__ void phase_C(const Params& p, int L, unsigned char* smem) {
    unsigned char* ws = p.ws;
    const int tid = TIDX, w = tid >> 6;
    const bf16_t* xin = (const bf16_t*)(ws + OFF_XIN);
    bf16_t* ymix = (bf16_t*)(ws + OFF_YMIX);
    const int n_attn_w = (L == 0) ? 2048 + 128 : 2048;
    const int N_ATT = (n_attn_w + 7) / 8;
    const int N_F1 = 1024 + ((L == 0) ? 64 : 0);
    const int N_CONV = TT * 32 / NTHREADS;
    const int N_S1 = TT * 16 / NTHREADS;
    const int O_F1 = N_ATT, O_CONV = O_F1 + N_F1, O_S1 = O_CONV + N_CONV, N_ALL = O_S1 + N_S1;
    for (int it = BIDX; it < N_ALL; it += gridDim.x) {
        if (it < O_F1) {
            const int item = it * 8 + w;
            if (item < n_attn_w) attn_item(p, L, item, (float*)smem + tid);
        } else if (it < O_CONV) {
            int idx = it - O_F1;
            const bf16_t* dd = (const bf16_t*)(ws + OFF_DFTD);
            if (idx < 1024) {
                const int b = idx >> 7, h = (idx >> 5) & 3, nt = idx & 31;
                bf16_t* zt = (bf16_t*)(ws + OFF_ZT);
                gemm128<false>([&](int r) { return dd + r * 64; },
                               [&](int r) { return xin + (size_t)(b * 4096 + nt * 128 + r) * 2048 + 1536 + h * 64; }, 64,
                               [&](int m, int n, float v) { zt[((size_t)(b * 256 + h * 64 + (m & 63)) * 2 + (m >> 6)) * 4096 + nt * 128 + n] = f2bf(v); }, smem);
            } else {
                idx -= 1024;
                const int b = idx >> 3, h = (idx >> 1) & 3, nt = idx & 1;
                bf16_t* zt = (bf16_t*)(ws + OFF_ZTC);
                gemm128<false>([&](int r) { return dd + r * 64; },
                               [&](int r) { return xin + (size_t)(T + b * 256 + nt * 128 + r) * 2048 + 1536 + h * 64; }, 64,
                               [&](int m, int n, float v) { zt[((size_t)(b * 256 + h * 64 + (m & 63)) * 2 + (m >> 6)) * 256 + nt * 128 + n] = f2bf(v); }, smem);
            }
        } else if (it < O_S1) {
            const int gid = (it - O_CONV) * NTHREADS + tid;
            const int tt = gid >> 5, ch0 = (gid & 31) * 8;
            bool first, last;
            if (tt < T) { int l = tt & 4095; first = l == 0; last = l == 4095; } else { int j = (tt - T) & 255; first = j == 0; last = j == 255; }
            const bf16_t* row = xin + (size_t)tt * 2048;
            const uint4 cb = *(const uint4*)(row + 768 + ch0), cc = *(const uint4*)(row + 1024 + ch0), cx = *(const uint4*)(row + 1280 + ch0);
            uint4 ccp = make_uint4(0, 0, 0, 0), cxp = ccp, ccn = ccp, cxn = ccp;
            if (!first) { ccp = *(const uint4*)(row - 2048 + 1024 + ch0); cxp = *(const uint4*)(row - 2048 + 1280 + ch0); }
            if (!last) { ccn = *(const uint4*)(row + 2048 + 1024 + ch0); cxn = *(const uint4*)(row + 2048 + 1280 + ch0); }
            const float* cw = p.in[I_CONVW] + (size_t)L * 3 * 256 + ch0;
            const unsigned cbv[4] = {cb.x, cb.y, cb.z, cb.w}, ccv[4] = {cc.x, cc.y, cc.z, cc.w}, cxv[4] = {cx.x, cx.y, cx.z, cx.w};
            const unsigned cpv[4] = {ccp.x, ccp.y, ccp.z, ccp.w}, xpv[4] = {cxp.x, cxp.y, cxp.z, cxp.w};
            const unsigned cnv[4] = {ccn.x, ccn.y, ccn.z, ccn.w}, xnv[4] = {cxn.x, cxn.y, cxn.z, cxn.w};
            unsigned o[4];
#pragma unroll
            for (int e = 0; e < 4; ++e) {
                float w0a = cw[2 * e], w0b = cw[2 * e + 1], w1a = cw[256 + 2 * e], w1b = cw[256 + 2 * e + 1], w2a = cw[512 + 2 * e], w2b = cw[512 + 2 * e + 1];
                float za = w0a * bflo(cpv[e]) * bflo(xpv[e]) + w1a * bflo(ccv[e]) * bflo(cxv[e]) + w2a * bflo(cnv[e]) * bflo(xnv[e]);
                float zb = w0b * bfhi(cpv[e]) * bfhi(xpv[e]) + w1b * bfhi(ccv[e]) * bfhi(cxv[e]) + w2b * bfhi(cnv[e]) * bfhi(xnv[e]);
                o[e] = pack2(bflo(cbv[e]) * za, bfhi(cbv[e]) * zb);
            }
            *(uint4*)(ymix + (size_t)tt * 1024 + 256 + ch0) = make_uint4(o[0], o[1], o[2], o[3]);
        } else {
            const int gid = (it - O_S1) * NTHREADS + tid;
            const int tt = gid >> 4, g = gid & 15;
            int n, j;
            if (tt < T) { int b = tt >> 12, l = tt & 4095; n = b * NCHB + 8 + (l >> 5); j = l & 31; }
            else { int c = tt - T; int b = c >> 8; n = b * NCHB + ((c & 255) >> 5); j = c & 31; }
            const uint4* src = (const uint4*)(xin + (size_t)tt * 2048 + 1792 + g * 16);
            uint4* dst = (uint4*)((bf16_t*)(ws + OFF_VG) + ((size_t)g * NCHP + n) * KV + 256 + j * 16);
            dst[0] = src[0]; dst[1] = src[1];
        }
    }
}

__device__ void phase_D(const Params& p, int L, unsigned char* smem) {
    unsigned char* ws = p.ws;
    bf16_t* ymix = (bf16_t*)(ws + OFF_YMIX);
    const int N_F2 = 512, N_F2C = (L == 0) ? 32 : 0, N_S2 = 288;
    const int O_F2C = N_F2, O_S2 = O_F2C + N_F2C, N_ALL = O_S2 + N_S2;
    for (int it = BIDX; it < N_ALL; it += gridDim.x) {
        if (it < O_F2C) {
            const int b = it >> 6, mt = (it >> 1) & 31, nt = it & 1;
            const bf16_t* dl = (const bf16_t*)(ws + OFF_DFTL);
            const bf16_t* zt = (const bf16_t*)(ws + OFF_ZT);
            gemm128<false>([&](int r) { return dl + (size_t)(mt * 128 + r) * 8192; },
                           [&](int r) { return zt + (size_t)(b * 256 + nt * 128 + r) * 8192; }, 8192,
                           [&](int m, int n, float v) { ymix[(size_t)(b * 4096 + mt * 128 + m) * 1024 + 512 + nt * 128 + n] = f2bf(v); }, smem);
        } else if (it < O_S2) {
            const int idx = it - O_F2C;
            const int b = idx >> 2, mt = (idx >> 1) & 1, nt = idx & 1;
            const bf16_t* dc = (const bf16_t*)(ws + OFF_DFTC);
            const bf16_t* zt = (const bf16_t*)(ws + OFF_ZTC);
            gemm128<false>([&](int r) { return dc + (size_t)(mt * 128 + r) * 512; },
                           [&](int r) { return zt + (size_t)(b * 256 + nt * 128 + r) * 512; }, 512,
                           [&](int m, int n, float v) { ymix[(size_t)(T + b * 256 + mt * 128 + m) * 1024 + 512 + nt * 128 + n] = f2bf(v); }, smem);
        } else {
            const int idx = it - O_S2;
            const int g = idx / 18, rem = idx % 18, mt = rem / 9, nt = rem % 9;
            const bf16_t* wst = (const bf16_t*)(ws + OFF_WST) + (size_t)g * 256 * 512;
            const bf16_t* vg = (const bf16_t*)(ws + OFF_VG) + (size_t)g * NCHP * KV;
            float* sc = (float*)(ws + OFF_SC) + (size_t)g * NCH * 256;
            gemm128<false>([&](int r) { return wst + (size_t)(mt * 128 + r) * 512; },
                           [&](int r) { return vg + (size_t)(nt * 128 + r) * KV + 256; }, 512,
                           [&](int m, int n, float v) { int nn = nt * 128 + n; if (nn < NCH) sc[(size_t)nn * 256 + mt * 128 + m] = v; }, smem);
        }
    }
}

__device__ void phase_E(const Params& p, int L) {
    unsigned char* ws = p.ws;
    for (int it = BIDX; it < 32; it += gridDim.x) {
        const int gid = it * NTHREADS + TIDX;
        const int b = gid >> 11, g = (gid >> 7) & 15, dr = (gid >> 6) & 1, pp = gid & 63;
        const float2 a32 = ((const float2*)(ws + OFF_POWA))[((size_t)((L * 2 + dr) * 16 + g) * 33 + 32) * 64 + pp];
        bf16_t* vg = (bf16_t*)(ws + OFF_VG) + (size_t)g * NCHP * KV + dr * 128 + pp;
        const float* sc = (const float*)(ws + OFF_SC) + (size_t)g * NCH * 256 + dr * 128 + pp;
        float hr = 0.f, hi = 0.f;
        for (int s0 = 0; s0 < NCHB; s0 += 8) {
            float sr[8], si[8]; int nn[8];
#pragma unroll
            for (int q = 0; q < 8; ++q) {
                const int s = s0 + q;
                const int cidx = dr == 0 ? s : (s < 8 ? 7 - s : NCHB - 1 - (s - 8));
                nn[q] = b * NCHB + cidx;
                sr[q] = sc[(size_t)nn[q] * 256]; si[q] = sc[(size_t)nn[q] * 256 + 64];
            }
#pragma unroll
            for (int q = 0; q < 8; ++q) {
                vg[(size_t)nn[q] * KV] = f2bf(hr); vg[(size_t)nn[q] * KV + 64] = f2bf(hi);
                const float nr = a32.x * hr - a32.y * hi + sr[q], ni = a32.x * hi + a32.y * hr + si[q];
                hr = nr; hi = ni;
            }
        }
    }
}

__device__ void phase_F(const Params& p, int L, unsigned char* smem) {
    unsigned char* ws = p.ws;
    bf16_t* gbuf = (bf16_t*)(ws + OFF_GBUF);
    const float* dsk = p.in[I_S5D] + L * 256;
    for (int it = BIDX; it < 576; it += gridDim.x) {
        const int g = it / 36, rem = it % 36, mt = rem >> 2, nt = rem & 3;
        const bf16_t* vg = (const bf16_t*)(ws + OFF_VG) + (size_t)g * NCHP * KV;
        const bf16_t* wc = (const bf16_t*)(ws + OFF_WCOMB) + (size_t)g * 512 * KV;
        gemm128<false>([&](int r) { return vg + (size_t)(mt * 128 + r) * KV; },
                       [&](int r) { return wc + (size_t)(nt * 128 + r) * KV; }, KV,
                       [&](int m, int n, float v) {
                           const int nn = mt * 128 + m;
                           if (nn < NCH) {
                               const int nc = nt * 128 + n, i = nc >> 4, h = nc & 15;
                               const int b = nn / NCHB, cidx = nn % NCHB;
                               const int tt = cidx < 8 ? (T + b * 256 + cidx * 32 + i) : (b * 4096 + (cidx - 8) * 32 + i);
                               const float u = bf2f(vg[(size_t)nn * KV + 256 + nc]);
                               const float y = v + dsk[g * 16 + h] * u;
                               gbuf[(size_t)tt * 256 + g * 16 + h] = f2bf(gelu_tanh(y));
                           }
                       }, smem);
    }
}

__device__ void phase_G(const Params& p, int L, unsigned char* smem) {
    unsigned char* ws = p.ws;
    const bf16_t* gbuf = (const bf16_t*)(ws + OFF_GBUF);
    const bf16_t* wg = (const bf16_t*)(ws + OFF_WGLUT + L * SZ_WGLUT);
    bf16_t* ymix = (bf16_t*)(ws + OFF_YMIX);
    for (int it = BIDX; it < (TT / 128) * 2; it += gridDim.x) {
        const int mt = it >> 1, nt = it & 1;
        gemm128<false>([&](int r) { return gbuf + (size_t)(mt * 128 + r) * 256; },
                       [&](int r) { return wg + (size_t)(nt * 128 + r) * 256; }, 256,
                       [&](int m, int n, float v) {
                           const size_t tt = mt * 128 + m; const int nn = nt * 128 + n;
                           const float gg = bf2f(gbuf[tt * 256 + nn]);
                           ymix[tt * 1024 + 768 + nn] = f2bf(gg * sigmoidf_(v));
                       }, smem);
    }
}

__device__ void phase_H(const Params& p, int L) {
    const int lane = TIDX & 63, w = TIDX >> 6;
    const bf16_t* ymix = (const bf16_t*)(p.ws + OFF_YMIX);
    bf16_t* dst = (bf16_t*)(p.ws + OFF_ACT);
    const float* gg = p.in[I_GRPG] + (size_t)L * 1024 + lane * 16;
    for (int it = BIDX; it < TT / 8; it += gridDim.x) {
        const int tt = it * 8 + w;
        const uint4* src = (const uint4*)(ymix + (size_t)tt * 1024 + lane * 16);
        const uint4 a = src[0], b = src[1];
        const unsigned u[8] = {a.x, a.y, a.z, a.w, b.x, b.y, b.z, b.w};
        float v[16], ss = 0.f;
#pragma unroll
        for (int e = 0; e < 8; ++e) { v[2 * e] = bflo(u[e]); v[2 * e + 1] = bfhi(u[e]); ss += v[2 * e] * v[2 * e] + v[2 * e + 1] * v[2 * e + 1]; }
        ss += __shfl_xor(ss, 1); ss += __shfl_xor(ss, 2); ss += __shfl_xor(ss, 4); ss += __shfl_xor(ss, 8);
        const float r = rsqrtf(ss * (1.0f / 256.0f) + EPS);
        unsigned o[8];
#pragma unroll
        for (int e = 0; e < 8; ++e) o[e] = pack2(v[2 * e] * r * gg[2 * e], v[2 * e + 1] * r * gg[2 * e + 1]);
        uint4* d = (uint4*)(dst + (size_t)tt * 1024 + lane * 16);
        d[0] = make_uint4(o[0], o[1], o[2], o[3]); d[1] = make_uint4(o[4], o[5], o[6], o[7]);
    }
}

__device__ void phase_I(const Params& p, int L, unsigned char* smem) {
    unsigned char* ws = p.ws;
    const int mtok = (L == 0) ? TT : T;
    const int N_G = (mtok / 128) * 8, N_CV = 4096;
    const bf16_t* A = (const bf16_t*)(ws + OFF_ACT);
    const bf16_t* Bt = (const bf16_t*)(ws + OFF_WOUTT + L * SZ_WOUTT);
    const float* g1 = (const float*)(ws + OFF_MOD) + (size_t)L * 9 * 6144 + 2048;
    float* xctx = (float*)(ws + OFF_XCTX);
    for (int it = BIDX; it < N_G + N_CV; it += gridDim.x) {
        if (it < N_G) {
            const int mt = it >> 3, nt = it & 7;
            gemm128<false>([&](int r) { return A + (size_t)(mt * 128 + r) * 1024; },
                           [&](int r) { return Bt + (size_t)(nt * 128 + r) * 1024; }, 1024,
                           [&](int m, int n, float v) {
                               const int tt = mt * 128 + m, nn = nt * 128 + n;
                               const float gate = g1[(size_t)tok_modrow(tt) * 6144 + nn];
                               if (tt < T) {
                                   const size_t o = (size_t)tt * 1024 + nn;
                                   const float xr = (L == 0) ? p.in[I_X][o] : p.out[o];
                                   p.out[o] = xr + gate * v;
                               } else {
                                   const size_t o = (size_t)(tt - T) * 1024 + nn;
                                   xctx[o] = p.in[I_CTX][o] + gate * v;
                               }
                           }, smem);
        } else {
            const int lane = TIDX & 63, w = TIDX >> 6;
            const int rid = (it - N_G) * 8 + w;
            const int which = rid >> 14, row = rid & 16383;
            const float* src = p.in[which ? I_PV : I_PU] + ((size_t)L * 16384 + row) * 1024 + lane * 16;
            float4 v[4]; float mx = 0.f;
#pragma unroll
            for (int i = 0; i < 4; ++i) {
                v[i] = *(const float4*)(src + i * 4);
                mx = fmaxf(mx, fmaxf(fmaxf(fabsf(v[i].x), fabsf(v[i].y)), fmaxf(fabsf(v[i].z), fabsf(v[i].w))));
            }
#pragma unroll
            for (int o = 32; o >= 1; o >>= 1) mx = fmaxf(mx, __shfl_xor(mx, o));
            mx = fmaxf(mx, 1e-30f);
            const float sc = mx * (1.0f / 448.0f), inv = 448.0f / mx;
            int pk[4];
#pragma unroll
            for (int i = 0; i < 4; ++i) {
                int wd = 0;
                wd = __builtin_amdgcn_cvt_pk_fp8_f32(v[i].x * inv, v[i].y * inv, wd, false);
                wd = __builtin_amdgcn_cvt_pk_fp8_f32(v[i].z * inv, v[i].w * inv, wd, true);
                pk[i] = wd;
            }
            *(int4*)(ws + (which ? OFF_PEERV : OFF_PEERU) + (size_t)row * 1024 + lane * 16) = make_int4(pk[0], pk[1], pk[2], pk[3]);
            if (lane == 0) ((float*)(ws + (which ? OFF_PSCV : OFF_PSCU)))[row] = sc;
        }
    }
}

__device__ void phase_K(const Params& p, int L, unsigned char* smem) {
    unsigned char* ws = p.ws;
    const int tid = TIDX;
    const int mtok = (L == 0) ? TT : T;
    const bf16_t* A = (const bf16_t*)(ws + OFF_ACT);
    const bf16_t* Bt = (const bf16_t*)(ws + OFF_WQKT + L * SZ_WQKT);
    int* cand = (int*)(ws + OFF_CAND);
    const float* tc = (const float*)smem;
    int* cl = (int*)(smem + 66048);
    int* cl2 = (int*)(smem + 66048 + 32768);
    for (int it = BIDX; it < (mtok / 128) * 16; it += gridDim.x) {
        const int mt = it >> 4, hz = it & 15;
        gemm128<true>([&](int r) { return A + (size_t)(mt * 128 + r) * 1024; },
                      [&](int r) { return Bt + (size_t)(hz * 128 + r) * 1024; }, 1024,
                      [&](int, int, float) {}, smem);
        const int row = tid & 127, q = tid >> 7;
        int top[16];
#pragma unroll
        for (int j = 0; j < 16; ++j) top[j] = (int)0x80000000;
        for (int j = 0; j < 32; ++j) {
            const int col = q * 32 + j;
            const int key = (sortable(tc[row * 129 + col]) & ~0x7F) | col;
            top16_insert(top, key);
        }
#pragma unroll
        for (int j = 0; j < 16; ++j) cl[(row * 4 + q) * 16 + j] = top[j];
        __syncthreads();
        if (q < 2) {
#pragma unroll
            for (int j = 0; j < 16; ++j) top[j] = (int)0x80000000;
            for (int j = 0; j < 32; ++j) top16_insert(top, cl[(row * 4 + q * 2) * 16 + j]);
#pragma unroll
            for (int j = 0; j < 16; ++j) cl2[(row * 2 + q) * 16 + j] = top[j];
        }
        __syncthreads();
        if (q == 0) {
#pragma unroll
            for (int j = 0; j < 16; ++j) top[j] = (int)0x80000000;
            for (int j = 0; j < 32; ++j) top16_insert(top, cl2[row * 32 + j]);
            int4* dst = (int4*)(cand + ((size_t)(mt * 128 + row) * 16 + hz) * 16);
            dst[0] = make_int4(top[0], top[1], top[2], top[3]); dst[1] = make_int4(top[4], top[5], top[6], top[7]);
            dst[2] = make_int4(top[8], top[9], top[10], top[11]); dst[3] = make_int4(top[12], top[13], top[14], top[15]);
        }
        __syncthreads();
    }
}

__device__ void phase_L(const Params& p, int L) {
    const int mtok = (L == 0) ? TT : T;
    const int* cand = (const int*)(p.ws + OFF_CAND);
    int* eidx = (int*)(p.ws + OFF_EIDX);
    float* gate = (float*)(p.ws + OFF_GATE);
    const int nit = mtok * 8 / NTHREADS;
    for (int it = BIDX; it < nit; it += gridDim.x) {
        const int gid = it * NTHREADS + TIDX;
        const int tt = gid >> 3, hd = gid & 7;
        const int* c1 = cand + ((size_t)tt * 16 + hd * 2) * 16;
        const int* c2 = c1 + 16;
        float s1[16], s2[16];
        {
            const int4* a = (const int4*)c1; const int4* b = (const int4*)c2;
#pragma unroll
            for (int q = 0; q < 4; ++q) {
                int4 x = a[q], y = b[q];
                s1[q * 4] = unsortable(x.x & ~0x7F); s1[q * 4 + 1] = unsortable(x.y & ~0x7F); s1[q * 4 + 2] = unsortable(x.z & ~0x7F); s1[q * 4 + 3] = unsortable(x.w & ~0x7F);
                s2[q * 4] = unsortable(y.x & ~0x7F); s2[q * 4 + 1] = unsortable(y.y & ~0x7F); s2[q * 4 + 2] = unsortable(y.z & ~0x7F); s2[q * 4 + 3] = unsortable(y.w & ~0x7F);
            }
        }
        int top[16];
#pragma unroll
        for (int j = 0; j < 16; ++j) top[j] = (int)0x80000000;
#pragma unroll
        for (int i = 0; i < 16; ++i)
#pragma unroll
            for (int j = 0; j < 16; ++j)
                if ((i + 1) * (j + 1) <= 16) top16_insert(top, (sortable(s1[i] + s2[j]) & ~0xFF) | (i * 16 + j));
        float vals[16], sum = 0.f;
        const float mx = unsortable(top[0] & ~0xFF);
#pragma unroll
        for (int j = 0; j < 16; ++j) { vals[j] = __expf(unsortable(top[j] & ~0xFF) - mx); sum += vals[j]; }
        const float inv = 1.0f / sum;
        int ei[16];
#pragma unroll
        for (int j = 0; j < 16; ++j) {
            const int pr = top[j] & 0xFF;
            ei[j] = (c1[pr >> 4] & 0x7F) * 128 + (c2[pr & 15] & 0x7F);
            vals[j] *= inv;
        }
        int4* de = (int4*)(eidx + (size_t)tt * 128 + hd * 16);
        float4* dg = (float4*)(gate + (size_t)tt * 128 + hd * 16);
#pragma unroll
        for (int q = 0; q < 4; ++q) {
            de[q] = make_int4(ei[q * 4], ei[q * 4 + 1], ei[q * 4 + 2], ei[q * 4 + 3]);
            dg[q] = make_float4(vals[q * 4], vals[q * 4 + 1], vals[q * 4 + 2], vals[q * 4 + 3]);
        }
    }
}

typedef __attribute__((ext_vector_type(2))) float f32x2;
__device__ __forceinline__ float dot16_fp8(const float (&hf)[16], const uint4& u) {
    f32x2 a0 = __builtin_amdgcn_cvt_pk_f32_fp8((int)u.x, false), a1 = __builtin_amdgcn_cvt_pk_f32_fp8((int)u.x, true);
    f32x2 a2 = __builtin_amdgcn_cvt_pk_f32_fp8((int)u.y, false), a3 = __builtin_amdgcn_cvt_pk_f32_fp8((int)u.y, true);
    f32x2 a4 = __builtin_amdgcn_cvt_pk_f32_fp8((int)u.z, false), a5 = __builtin_amdgcn_cvt_pk_f32_fp8((int)u.z, true);
    f32x2 a6 = __builtin_amdgcn_cvt_pk_f32_fp8((int)u.w, false), a7 = __builtin_amdgcn_cvt_pk_f32_fp8((int)u.w, true);
    float d0 = hf[0] * a0.x, d1 = hf[1] * a0.y;
    d0 += hf[2] * a1.x; d1 += hf[3] * a1.y; d0 += hf[4] * a2.x; d1 += hf[5] * a2.y; d0 += hf[6] * a3.x; d1 += hf[7] * a3.y;
    d0 += hf[8] * a4.x; d1 += hf[9] * a4.y; d0 += hf[10] * a5.x; d1 += hf[11] * a5.y; d0 += hf[12] * a6.x; d1 += hf[13] * a6.y;
    d0 += hf[14] * a7.x; d1 += hf[15] * a7.y;
    return d0 + d1;
}
__device__ __forceinline__ void axpy16_fp8(float (&acc)[16], float a, const uint4& v) {
    f32x2 a0 = __builtin_amdgcn_cvt_pk_f32_fp8((int)v.x, false), a1 = __builtin_amdgcn_cvt_pk_f32_fp8((int)v.x, true);
    f32x2 a2 = __builtin_amdgcn_cvt_pk_f32_fp8((int)v.y, false), a3 = __builtin_amdgcn_cvt_pk_f32_fp8((int)v.y, true);
    f32x2 a4 = __builtin_amdgcn_cvt_pk_f32_fp8((int)v.z, false), a5 = __builtin_amdgcn_cvt_pk_f32_fp8((int)v.z, true);
    f32x2 a6 = __builtin_amdgcn_cvt_pk_f32_fp8((int)v.w, false), a7 = __builtin_amdgcn_cvt_pk_f32_fp8((int)v.w, true);
    acc[0] += a * a0.x; acc[1] += a * a0.y; acc[2] += a * a1.x; acc[3] += a * a1.y; acc[4] += a * a2.x; acc[5] += a * a2.y; acc[6] += a * a3.x; acc[7] += a * a3.y;
    acc[8] += a * a4.x; acc[9] += a * a4.y; acc[10] += a * a5.x; acc[11] += a * a5.y; acc[12] += a * a6.x; acc[13] += a * a6.y; acc[14] += a * a7.x; acc[15] += a * a7.y;
}

__device__ void phase_M(const Params& p, int L) {
    const int lane = TIDX & 63, w = TIDX >> 6;
    const int mtok = (L == 0) ? TT : T;
    const bf16_t* hact = (const bf16_t*)(p.ws + OFF_ACT);
    const unsigned char* pu = p.ws + OFF_PEERU;
    const unsigned char* pv = p.ws + OFF_PEERV;
    const float* scu = (const float*)(p.ws + OFF_PSCU);
    const float* scv = (const float*)(p.ws + OFF_PSCV);
    const int* eidx = (const int*)(p.ws + OFF_EIDX);
    const float* gate = (const float*)(p.ws + OFF_GATE);
    const float* g2 = (const float*)(p.ws + OFF_MOD) + (size_t)L * 9 * 6144 + 5120;
    const bool hi32 = (lane & 32) != 0, hi16 = (lane & 16) != 0, hi8 = (lane & 8) != 0;
    for (int it = BIDX; it < mtok / 8; it += gridDim.x) {
        const int tt = it * 8 + w;
        float hf[16];
        {
            const uint4 a = *(const uint4*)(hact + (size_t)tt * 1024 + lane * 16), b = *(const uint4*)(hact + (size_t)tt * 1024 + lane * 16 + 8);
            hf[0] = bflo(a.x); hf[1] = bfhi(a.x); hf[2] = bflo(a.y); hf[3] = bfhi(a.y); hf[4] = bflo(a.z); hf[5] = bfhi(a.z); hf[6] = bflo(a.w); hf[7] = bfhi(a.w);
            hf[8] = bflo(b.x); hf[9] = bfhi(b.x); hf[10] = bflo(b.y); hf[11] = bfhi(b.y); hf[12] = bflo(b.z); hf[13] = bfhi(b.z); hf[14] = bflo(b.w); hf[15] = bfhi(b.w);
        }
        const int e0 = eidx[(size_t)tt * 128 + lane], e1 = eidx[(size_t)tt * 128 + 64 + lane];
        const float g0 = gate[(size_t)tt * 128 + lane], g1v = gate[(size_t)tt * 128 + 64 + lane];
        float acc[16];
#pragma unroll
        for (int d = 0; d < 16; ++d) acc[d] = 0.f;
#pragma unroll 1
        for (int j0 = 0; j0 < 128; j0 += 8) {
            uint4 ur[8], vr[8]; float gt[8], d[8];
#pragma unroll
            for (int q = 0; q < 8; ++q) {
                const int j = j0 + q;
                const int e = __builtin_amdgcn_readlane(j0 < 64 ? e0 : e1, j & 63);
                const float gg = __builtin_bit_cast(float, __builtin_amdgcn_readlane(__builtin_bit_cast(int, j0 < 64 ? g0 : g1v), j & 63));
                ur[q] = *(const uint4*)(pu + (size_t)e * 1024 + lane * 16);
                vr[q] = *(const uint4*)(pv + (size_t)e * 1024 + lane * 16);
                d[q] = scu[e];
                gt[q] = gg * scv[e];
            }
#pragma unroll
            for (int q = 0; q < 8; ++q) d[q] *= dot16_fp8(hf, ur[q]);
            float r4[4], r2[2], r1;
#pragma unroll
            for (int i = 0; i < 4; ++i) { const float keep = hi32 ? d[2 * i + 1] : d[2 * i], send = hi32 ? d[2 * i] : d[2 * i + 1]; r4[i] = keep + __shfl_xor(send, 32); }
#pragma unroll
            for (int i = 0; i < 2; ++i) { const float keep = hi16 ? r4[2 * i + 1] : r4[2 * i], send = hi16 ? r4[2 * i] : r4[2 * i + 1]; r2[i] = keep + __shfl_xor(send, 16); }
            { const float keep = hi8 ? r2[1] : r2[0], send = hi8 ? r2[0] : r2[1]; r1 = keep + __shfl_xor(send, 8); }
            r1 += __shfl_xor(r1, 4); r1 += __shfl_xor(r1, 2); r1 += __shfl_xor(r1, 1);
            const int gl = __builtin_bit_cast(int, gelu_tanh(r1));
#pragma unroll
            for (int q = 0; q < 8; ++q) {
                const int srcl = (q & 1) * 32 + ((q >> 1) & 1) * 16 + ((q >> 2) & 1) * 8;
                const float a = __builtin_bit_cast(float, __builtin_amdgcn_readlane(gl, srcl)) * gt[q];
                axpy16_fp8(acc, a, vr[q]);
            }
        }
        float* xr = (tt < T) ? (p.out + (size_t)tt * 1024) : ((float*)(p.ws + OFF_XCTX) + (size_t)(tt - T) * 1024);
        const float* gr = g2 + (size_t)tok_modrow(tt) * 6144;
        float xv[16];
#pragma unroll
        for (int i = 0; i < 4; ++i) {
            const int k = lane * 16 + i * 4;
            const float4 x0 = *(const float4*)(xr + k), q0 = *(const float4*)(gr + k);
            xv[i * 4 + 0] = x0.x + q0.x * acc[i * 4 + 0]; xv[i * 4 + 1] = x0.y + q0.y * acc[i * 4 + 1];
            xv[i * 4 + 2] = x0.z + q0.z * acc[i * 4 + 2]; xv[i * 4 + 3] = x0.w + q0.w * acc[i * 4 + 3];
        }
        if (L == 1) {
            float ss = 0.f;
#pragma unroll
            for (int d = 0; d < 16; ++d) ss += xv[d] * xv[d];
            ss = wave_sum(ss);
            const float r = rsqrtf(ss * (1.0f / 1024.0f) + EPS);
#pragma unroll
            for (int i = 0; i < 4; ++i) {
                const float4 f0 = *(const float4*)(p.in[I_FING] + lane * 16 + i * 4);
                xv[i * 4 + 0] *= r * f0.x; xv[i * 4 + 1] *= r * f0.y; xv[i * 4 + 2] *= r * f0.z; xv[i * 4 + 3] *= r * f0.w;
            }
        }
#pragma unroll
        for (int i = 0; i < 4; ++i) *(float4*)(xr + lane * 16 + i * 4) = make_float4(xv[i * 4 + 0], xv[i * 4 + 1], xv[i * 4 + 2], xv[i * 4 + 3]);
    }
}

constexpr int N_PHASES = 1 + 2 * 13;

__device__ __forceinline__ void run_phase(const Params& p, int ph, unsigned char* smem) {
    if (ph == 0) { phase_prep(p, smem); return; }
    const int L = (ph - 1) / 13, s = (ph - 1) % 13;
    switch (s) {
        case 0: phase_A(p, L); break;
        case 1: phase_B(p, L, smem); break;
        case 2: phase_C(p, L, smem); break;
        case 3: phase_D(p, L, smem); break;
        case 4: phase_E(p, L); break;
        case 5: phase_F(p, L, smem); break;
        case 6: phase_G(p, L, smem); break;
        case 7: phase_H(p, L); break;
        case 8: phase_I(p, L, smem); break;
        case 9: norm_tokens(p, L, 1, (L == 0) ? TT : T, false, 0, ((L == 0) ? TT : T) / 8); break;
        case 10: phase_K(p, L, smem); break;
        case 11: phase_L(p, L); break;
        default: phase_M(p, L); break;
    }
}

__global__ void __launch_bounds__(NTHREADS) fwd_megakernel(Params p) {
    extern __shared__ __attribute__((aligned(16))) unsigned char smem[];
    cg::grid_group grid = cg::this_grid();
    for (int ph = p.ph_lo; ph < p.ph_hi; ++ph) {
        run_phase(p, ph, smem);
#if PROBE_MASK
        if (ph > 0 && ((PROBE_MASK >> ((ph - 1) % 13)) & 1) && !(((ph - 1) % 13) == 8 && ph > 13)) { grid.sync(); run_phase(p, ph, smem); }
#endif
        if (ph + 1 < p.ph_hi) grid.sync();
    }
}

extern "C" void kernel_launch(void* const* d_in, const int* in_sizes, int n_in, void* d_out, int out_size, void* d_ws, size_t ws_size,
                              hipStream_t stream) {
    static int grid_blocks = 0;
    if (grid_blocks == 0) {
        if (n_in != 27 || out_size != T * D || ws_size < WS_END) {
            fprintf(stderr, "kernel_launch: unexpected problem (n_in %d, out %d, ws %zu, need %zu)\n", n_in, out_size, ws_size, (size_t)WS_END);
            grid_blocks = -1; return;
        }
        int dev = 0, cus = 0, per_cu = 0;
        hipGetDevice(&dev);
        hipDeviceGetAttribute(&cus, hipDeviceAttributeMultiprocessorCount, dev);
        hipFuncSetAttribute((const void*)fwd_megakernel, hipFuncAttributeMaxDynamicSharedMemorySize, SMEM_BYTES);
        hipOccupancyMaxActiveBlocksPerMultiprocessor(&per_cu, (const void*)fwd_megakernel, NTHREADS, SMEM_BYTES);
        if (per_cu < 1) { fprintf(stderr, "kernel_launch: occupancy query returned %d\n", per_cu); per_cu = 1; }
        if (per_cu > 1) per_cu = 1;
        grid_blocks = cus * per_cu;
    }
    if (grid_blocks < 0) return;
    Params p{};
    for (int i = 0; i < 27; ++i) p.in[i] = (const float*)d_in[i];
    p.out = (float*)d_out; p.ws = (unsigned char*)d_ws;
#if SPLIT_LAUNCH
    for (int ph = 0; ph < N_PHASES; ++ph) {
        p.ph_lo = ph; p.ph_hi = ph + 1;
        void* args[] = {&p};
        hipError_t e = hipLaunchCooperativeKernel((const void*)fwd_megakernel, dim3(grid_blocks), dim3(NTHREADS), args, SMEM_BYTES, stream);
        if (e != hipSuccess) { fprintf(stderr, "launch failed: %s\n", hipGetErrorString(e)); return; }
    }
#else
    p.ph_lo = 0; p.ph_hi = N_PHASES;
    void* args[] = {&p};
    hipError_t e = hipLaunchCooperativeKernel((const void*)fwd_megakernel, dim3(grid_blocks), dim3(NTHREADS), args, SMEM_BYTES, stream);
    if (e != hipSuccess) fprintf(stderr, "cooperative launch failed: %s (grid %d)\n", hipGetErrorString(e), grid_blocks);
#endif
}
```

```cpp
#include <hip/hip_runtime.h>
#include <hip/hip_cooperative_groups.h>
#include <cstdio>
#include <cstdint>
namespace cg = cooperative_groups;

#define NTHREADS 512
#ifndef PROBE_MASK
#define PROBE_MASK 0
#endif
#ifndef SPLIT_LAUNCH
#define SPLIT_LAUNCH 0
#endif

typedef unsigned short bf16_t;
typedef __attribute__((ext_vector_type(8))) short bf16x8;
typedef __attribute__((ext_vector_type(4))) float f32x4;
typedef __attribute__((ext_vector_type(2))) __bf16 bf16x2_t;

constexpr int D = 1024, NB = 8, SEQ = 4096, T = NB * SEQ, CTXL = 256, TC = NB * CTXL, TT = T + TC;
constexpr int INW = 2048;
constexpr int NCHB = 136;
constexpr int NCH = NB * NCHB;
constexpr int NCHP = 1152;
constexpr int KV = 768;
constexpr float EPS = 1e-6f;

constexpr size_t al256(size_t x) { return (x + 255) & ~(size_t)255; }
constexpr size_t OFF_ACT = 0;                                   constexpr size_t SZ_ACT = (size_t)TT * 1024 * 2;
constexpr size_t OFF_XIN = al256(OFF_ACT + SZ_ACT);             constexpr size_t SZ_XIN = (size_t)TT * 2048 * 2;
constexpr size_t OFF_YMIX = al256(OFF_XIN + SZ_XIN);            constexpr size_t SZ_YMIX = (size_t)TT * 1024 * 2;
constexpr size_t OFF_XCTX = al256(OFF_YMIX + SZ_YMIX);          constexpr size_t SZ_XCTX = (size_t)TC * 1024 * 4;
constexpr size_t OFF_ZT = al256(OFF_XCTX + SZ_XCTX);            constexpr size_t SZ_ZT = (size_t)NB * 256 * 8192 * 2;
constexpr size_t OFF_ZTC = al256(OFF_ZT + SZ_ZT);               constexpr size_t SZ_ZTC = (size_t)NB * 256 * 512 * 2;
constexpr size_t OFF_VG = al256(OFF_ZTC + SZ_ZTC);              constexpr size_t SZ_VG = (size_t)16 * NCHP * KV * 2;
constexpr size_t OFF_SC = al256(OFF_VG + SZ_VG);                constexpr size_t SZ_SC = (size_t)16 * NCH * 256 * 4;
constexpr size_t OFF_GBUF = al256(OFF_SC + SZ_SC);              constexpr size_t SZ_GBUF = (size_t)TT * 256 * 2;
constexpr size_t OFF_DFTL = al256(OFF_GBUF + SZ_GBUF);          constexpr size_t SZ_DFTL = (size_t)4096 * 8192 * 2;
constexpr size_t OFF_DFTC = al256(OFF_DFTL + SZ_DFTL);          constexpr size_t SZ_DFTC = (size_t)256 * 512 * 2;
constexpr size_t OFF_DFTD = al256(OFF_DFTC + SZ_DFTC);          constexpr size_t SZ_DFTD = (size_t)128 * 64 * 2;
constexpr size_t SZ_WINT = (size_t)2048 * 1024 * 2, SZ_WOUTT = (size_t)1024 * 1024 * 2, SZ_WQKT = (size_t)2048 * 1024 * 2, SZ_WGLUT = (size_t)256 * 256 * 2;
constexpr size_t OFF_WINT = al256(OFF_DFTD + SZ_DFTD);
constexpr size_t OFF_WOUTT = al256(OFF_WINT + 2 * SZ_WINT);
constexpr size_t OFF_WQKT = al256(OFF_WOUTT + 2 * SZ_WOUTT);
constexpr size_t OFF_WGLUT = al256(OFF_WQKT + 2 * SZ_WQKT);
constexpr size_t OFF_WCOMB = al256(OFF_WGLUT + 2 * SZ_WGLUT);   constexpr size_t SZ_WCOMB = (size_t)16 * 512 * KV * 2;
constexpr size_t OFF_WST = al256(OFF_WCOMB + SZ_WCOMB);         constexpr size_t SZ_WST = (size_t)16 * 256 * 512 * 2;
constexpr size_t OFF_POWA = al256(OFF_WST + SZ_WST);            constexpr size_t SZ_POWA = (size_t)2 * 2 * 16 * 33 * 64 * 8;
constexpr size_t OFF_BBAR = al256(OFF_POWA + SZ_POWA);          constexpr size_t SZ_BBAR = (size_t)2 * 2 * 16 * 64 * 16 * 8;
constexpr size_t OFF_KTAU = al256(OFF_BBAR + SZ_BBAR);          constexpr size_t SZ_KTAU = (size_t)2 * 2 * 16 * 32 * 256 * 4;
constexpr size_t OFF_MOD = al256(OFF_KTAU + SZ_KTAU);           constexpr size_t SZ_MOD = (size_t)2 * 9 * 6144 * 4;
constexpr size_t OFF_VT = al256(OFF_MOD + SZ_MOD);              constexpr size_t SZ_VT = (size_t)NB * 256 * 4096 * 2;
constexpr size_t OFF_VTC = al256(OFF_VT + SZ_VT);               constexpr size_t SZ_VTC = (size_t)NB * 256 * 256 * 2;
constexpr size_t WS_END = al256(OFF_VTC + SZ_VTC);
constexpr size_t OFF_PEERU = OFF_XIN;                            constexpr size_t SZ_PEERT = (size_t)16384 * 1024;
constexpr size_t OFF_PEERV = OFF_PEERU + SZ_PEERT;
constexpr size_t OFF_PSCU = OFF_PEERV + SZ_PEERT;                constexpr size_t SZ_PSC = (size_t)16384 * 4;
constexpr size_t OFF_PSCV = OFF_PSCU + SZ_PSC;
constexpr size_t OFF_CAND = OFF_PSCV + SZ_PSC;                   constexpr size_t SZ_CAND = (size_t)TT * 256 * 4;
constexpr size_t OFF_EIDX = OFF_CAND + SZ_CAND;                  constexpr size_t SZ_EIDX = (size_t)TT * 128 * 4;
constexpr size_t OFF_GATE = OFF_EIDX + SZ_EIDX;
static_assert(OFF_GATE + SZ_EIDX <= OFF_XIN + SZ_XIN, "PEER overlays must fit in the XIN region");

constexpr int SMEM_BYTES = 116736;

struct Params {
    const float* in[27];
    float* out;
    unsigned char* ws;
    int ph_lo, ph_hi;
};
enum { I_X = 0, I_C, I_CTX, I_CCTX, I_ADAW, I_ADAB, I_N1G, I_N2G, I_WIN, I_RPB, I_CONVW, I_ARE, I_AIM, I_BRE, I_BIM, I_CRE, I_CIM,
       I_LOGDT, I_S5D, I_WGLU, I_GRPG, I_WOUT, I_WQ, I_KEYS, I_PU, I_PV, I_FING };


__device__ __forceinline__ int tidx_l() { int t = threadIdx.x; asm volatile("" : "+v"(t)); return t; }
__device__ __forceinline__ int bidx_l() { int t = blockIdx.x; asm volatile("" : "+s"(t)); return t; }
#define TIDX (tidx_l())
#define BIDX (bidx_l())
__device__ __forceinline__ bf16_t f2bf(float f) { unsigned u = __float_as_uint(f); u += 0x7FFFu + ((u >> 16) & 1u); return (bf16_t)(u >> 16); }
__device__ __forceinline__ float bf2f(bf16_t h) { return __uint_as_float(((unsigned)h) << 16); }
__device__ __forceinline__ unsigned pack2(float a, float b) { return (unsigned)f2bf(a) | ((unsigned)f2bf(b) << 16); }
__device__ __forceinline__ float bflo(unsigned u) { return __uint_as_float(u << 16); }
__device__ __forceinline__ float bfhi(unsigned u) { return __uint_as_float(u & 0xffff0000u); }
__device__ __forceinline__ float dot2bf(unsigned a, unsigned b, float c) {
    return __builtin_amdgcn_fdot2_f32_bf16(__builtin_bit_cast(bf16x2_t, a), __builtin_bit_cast(bf16x2_t, b), c, false);
}
__device__ __forceinline__ float gelu_tanh(float x) {
    float z = 0.7978845608028654f * (x + 0.044715f * x * x * x);
    float e = __expf(2.0f * z);
    float th = 1.0f - 2.0f / (e + 1.0f);
    return 0.5f * x * (1.0f + th);
}
__device__ __forceinline__ float sigmoidf_(float x) { return 1.0f / (1.0f + __expf(-x)); }
__device__ __forceinline__ float wave_sum(float v) {
#pragma unroll
    for (int o = 32; o >= 1; o >>= 1) v += __shfl_xor(v, o);
    return v;
}
__device__ __forceinline__ int sortable(float v) { int b = __float_as_int(v); return b ^ ((b >> 31) & 0x7FFFFFFF); }
__device__ __forceinline__ float unsortable(int s) { return __int_as_float(s ^ ((s >> 31) & 0x7FFFFFFF)); }
__device__ __forceinline__ void top16_insert(int (&top)[16], int x) {
#pragma unroll
    for (int j = 0; j < 16; ++j) { int hi = max(top[j], x); x = min(top[j], x); top[j] = hi; }
}
__device__ __forceinline__ int tok_modrow(int tt) { return tt < T ? (tt >> 12) : 8; }

template <bool TO_LDS, typename FA, typename FB, typename FE>
__device__ __forceinline__ void gemm128(FA arow, FB brow, int K, FE epi, unsigned char* smem) {
    const int tid = TIDX, lane = tid & 63, w = tid >> 6;
    const int wm = w >> 2, wn = w & 3;
    const bf16_t* pa[2]; const bf16_t* pb[2]; int soff[2];
#pragma unroll
    for (int i = 0; i < 2; ++i) {
        int c = tid + 512 * i, row = c >> 3, kc = c & 7;
        pa[i] = arow(row) + kc * 8; pb[i] = brow(row) + kc * 8;
        soff[i] = row * 128 + ((kc ^ (row & 7)) << 4);
    }
    __syncthreads();
    f32x4 acc[4][2];
#pragma unroll
    for (int i = 0; i < 4; ++i)
#pragma unroll
        for (int j = 0; j < 2; ++j) acc[i][j] = f32x4{0.f, 0.f, 0.f, 0.f};
    uint4 ra[2], rb[2];
#pragma unroll
    for (int i = 0; i < 2; ++i) { ra[i] = *(const uint4*)pa[i]; rb[i] = *(const uint4*)pb[i]; }
#pragma unroll
    for (int i = 0; i < 2; ++i) { *(uint4*)(smem + soff[i]) = ra[i]; *(uint4*)(smem + 16384 + soff[i]) = rb[i]; }
    __syncthreads();
    const int nk = K >> 6;
    const int lr = lane & 15, lg = lane >> 4, sw = lane & 7;
    for (int kt = 0; kt < nk; ++kt) {
        const int cur = kt & 1;
        if (kt + 1 < nk) {
#pragma unroll
            for (int i = 0; i < 2; ++i) { ra[i] = *(const uint4*)(pa[i] + (kt + 1) * 64); rb[i] = *(const uint4*)(pb[i] + (kt + 1) * 64); }
        }
        const unsigned char* sA = smem + cur * 32768;
        const unsigned char* sB = sA + 16384;
#pragma unroll
        for (int ks = 0; ks < 2; ++ks) {
            bf16x8 af[4], bfv[2];
            const int choff = (((ks * 4 + lg) ^ sw) << 4);
#pragma unroll
            for (int fi = 0; fi < 4; ++fi) af[fi] = *(const bf16x8*)(sA + (wm * 64 + fi * 16 + lr) * 128 + choff);
#pragma unroll
            for (int fj = 0; fj < 2; ++fj) bfv[fj] = *(const bf16x8*)(sB + (wn * 32 + fj * 16 + lr) * 128 + choff);
#pragma unroll
            for (int fi = 0; fi < 4; ++fi)
#pragma unroll
                for (int fj = 0; fj < 2; ++fj) acc[fi][fj] = __builtin_amdgcn_mfma_f32_16x16x32_bf16(af[fi], bfv[fj], acc[fi][fj], 0, 0, 0);
        }
        if (kt + 1 < nk) {
            unsigned char* dA = smem + (cur ^ 1) * 32768;
#pragma unroll
            for (int i = 0; i < 2; ++i) { *(uint4*)(dA + soff[i]) = ra[i]; *(uint4*)(dA + 16384 + soff[i]) = rb[i]; }
        }
        __syncthreads();
    }
    if (TO_LDS) {
        float* tc = (float*)smem;
#pragma unroll
        for (int fi = 0; fi < 4; ++fi)
#pragma unroll
            for (int fj = 0; fj < 2; ++fj)
#pragma unroll
                for (int j = 0; j < 4; ++j) tc[(wm * 64 + fi * 16 + lg * 4 + j) * 129 + wn * 32 + fj * 16 + lr] = acc[fi][fj][j];
        __syncthreads();
    } else {
#pragma unroll
        for (int fi = 0; fi < 4; ++fi)
#pragma unroll
            for (int fj = 0; fj < 2; ++fj)
#pragma unroll
                for (int j = 0; j < 4; ++j) epi(wm * 64 + fi * 16 + lg * 4 + j, wn * 32 + fj * 16 + lr, acc[fi][fj][j]);
    }
}

__device__ void phase_prep(const Params& p, unsigned char* smem) {
    const int tid = TIDX, lane = tid & 63, w = tid >> 6;
    unsigned char* ws = p.ws;
    constexpr int N_MOD = 192, N_TR = 1568, N_WQK = 512, N_DFTL = 4096, N_DFTS = 1, N_S5T = 8;
    constexpr int O_TR = N_MOD, O_WQK = O_TR + N_TR, O_DFTL = O_WQK + N_WQK, O_DFTS = O_DFTL + N_DFTL, O_S5T = O_DFTS + N_DFTS, N_ALL = O_S5T + N_S5T;
    float* tab = (float*)(smem + 98304);
    for (int j = tid; j < 4096; j += NTHREADS) tab[j] = cospif((float)j * (1.0f / 2048.0f));
    __syncthreads();
    for (int it = BIDX; it < N_ALL; it += gridDim.x) {
        if (it < O_TR) {
            const int L = it / 96, c0 = (it % 96) * 64;
            float* sv = (float*)smem;
            float* red = (float*)(smem + 36864);
            for (int idx = tid; idx < 9 * 1024; idx += NTHREADS) {
                int r = idx >> 10, k = idx & 1023;
                float v = (r < 8) ? p.in[I_C][r * 1024 + k] : p.in[I_CCTX][k];
                sv[idx] = v / (1.0f + __expf(-v));
            }
            __syncthreads();
            float acc[9];
#pragma unroll
            for (int r = 0; r < 9; ++r) acc[r] = 0.f;
            const float* aw = p.in[I_ADAW] + (size_t)L * 1024 * 6144 + c0 + lane;
            for (int k = w * 128; k < w * 128 + 128; ++k) {
                float wv = aw[(size_t)k * 6144];
#pragma unroll
                for (int r = 0; r < 9; ++r) acc[r] += sv[r * 1024 + k] * wv;
            }
#pragma unroll
            for (int r = 0; r < 9; ++r) red[(w * 9 + r) * 64 + lane] = acc[r];
            __syncthreads();
            for (int o = tid; o < 576; o += NTHREADS) {
                int r = o >> 6, col = o & 63;
                float s = 0.f;
#pragma unroll
                for (int ww = 0; ww < 8; ++ww) s += red[(ww * 9 + r) * 64 + col];
                ((float*)(ws + OFF_MOD))[(size_t)(L * 9 + r) * 6144 + c0 + col] = s + p.in[I_ADAB][L * 6144 + c0 + col];
            }
            __syncthreads();
        } else if (it < O_WQK) {
            int idx = it - O_TR;
            const int L = idx / 784; int rem = idx % 784;
            const float* src; bf16_t* dst; int Kd, Nd, tk, tn;
            if (rem < 512) { tk = rem >> 5; tn = rem & 31; Kd = 1024; Nd = 2048; src = p.in[I_WIN] + (size_t)L * 1024 * 2048; dst = (bf16_t*)(ws + OFF_WINT + L * SZ_WINT); }
            else if (rem < 768) { rem -= 512; tk = rem >> 4; tn = rem & 15; Kd = 1024; Nd = 1024; src = p.in[I_WOUT] + (size_t)L * 1024 * 1024; dst = (bf16_t*)(ws + OFF_WOUTT + L * SZ_WOUTT); }
            else { rem -= 768; tk = rem >> 2; tn = rem & 3; Kd = 256; Nd = 256; src = p.in[I_WGLU] + (size_t)L * 256 * 256; dst = (bf16_t*)(ws + OFF_WGLUT + L * SZ_WGLUT); }
            float* tl = (float*)smem;
#pragma unroll
            for (int i = 0; i < 8; ++i) { int kk = i * 8 + w, nn = lane; tl[kk * 65 + nn] = src[(size_t)(tk * 64 + kk) * Nd + tn * 64 + nn]; }
            __syncthreads();
#pragma unroll
            for (int i = 0; i < 8; ++i) { int nn = i * 8 + w, kk = lane; dst[(size_t)(tn * 64 + nn) * Kd + tk * 64 + kk] = f2bf(tl[kk * 65 + nn]); }
            __syncthreads();
        } else if (it < O_DFTL) {
            int idx = it - O_WQK;
            const int L = idx >> 8, hz = (idx >> 4) & 15, kb = idx & 15;
            const int kk = kb * 64 + lane;
            const float* wqrow = p.in[I_WQ] + (size_t)L * 1024 * 2048 + (size_t)kk * 2048 + hz * 128;
            const float* keys = p.in[I_KEYS] + ((size_t)(L * 16 + hz) * 128 + w * 16) * 128;
            float acc[16];
#pragma unroll
            for (int j = 0; j < 16; ++j) acc[j] = 0.f;
            for (int d4 = 0; d4 < 32; ++d4) {
                float4 wv = *(const float4*)(wqrow + d4 * 4);
#pragma unroll
                for (int j = 0; j < 16; ++j) {
                    float4 kv = *(const float4*)(keys + j * 128 + d4 * 4);
                    acc[j] += wv.x * kv.x + wv.y * kv.y + wv.z * kv.z + wv.w * kv.w;
                }
            }
            bf16_t* dst = (bf16_t*)(ws + OFF_WQKT + L * SZ_WQKT);
#pragma unroll
            for (int j = 0; j < 16; ++j) dst[(size_t)(hz * 128 + w * 16 + j) * 1024 + kk] = f2bf(acc[j]);
        } else if (it < O_DFTS) {
            const int k = it - O_DFTL;
            bf16_t* dst = (bf16_t*)(ws + OFF_DFTL) + (size_t)k * 8192;
#pragma unroll
            for (int i = 0; i < 2; ++i) {
                int c = tid + 512 * i, part = c >> 9, l0 = (c & 511) * 8;
                unsigned pk[4];
#pragma unroll
                for (int e = 0; e < 4; ++e) {
                    int i0 = ((k * (l0 + 2 * e)) + part * 1024) & 4095, i1 = ((k * (l0 + 2 * e + 1)) + part * 1024) & 4095;
                    pk[e] = pack2(tab[i0] * (1.0f / 512.0f), tab[i1] * (1.0f / 512.0f));
                }
                *(uint4*)(dst + part * 4096 + l0) = make_uint4(pk[0], pk[1], pk[2], pk[3]);
            }
        } else if (it < O_S5T) {
            bf16_t* dc = (bf16_t*)(ws + OFF_DFTC);
            for (int c = tid; c < 16384; c += NTHREADS) {
                int k = c >> 6, cc = c & 63, part = cc >> 5, l0 = (cc & 31) * 8;
                unsigned pk[4];
#pragma unroll
                for (int e = 0; e < 4; ++e) {
                    int i0 = ((((k * (l0 + 2 * e)) & 255) << 4) + part * 1024) & 4095, i1 = ((((k * (l0 + 2 * e + 1)) & 255) << 4) + part * 1024) & 4095;
                    pk[e] = pack2(tab[i0] * (1.0f / 128.0f), tab[i1] * (1.0f / 128.0f));
                }
                *(uint4*)(dc + (size_t)k * 512 + part * 256 + l0) = make_uint4(pk[0], pk[1], pk[2], pk[3]);
            }
            bf16_t* dd = (bf16_t*)(ws + OFF_DFTD);
            for (int c = tid; c < 1024; c += NTHREADS) {
                int m = c >> 3, d0 = (c & 7) * 8, kd = m & 63, sh = (m >= 64) ? 3072 : 0;
                unsigned pk[4];
#pragma unroll
                for (int e = 0; e < 4; ++e) {
                    int i0 = ((((kd * (d0 + 2 * e)) & 63) << 6) + sh) & 4095, i1 = ((((kd * (d0 + 2 * e + 1)) & 63) << 6) + sh) & 4095;
                    pk[e] = pack2(tab[i0], tab[i1]);
                }
                *(uint4*)(dd + m * 64 + d0) = make_uint4(pk[0], pk[1], pk[2], pk[3]);
            }
        } else {
            const int gid = (it - O_S5T) * NTHREADS + tid;
            const int ia = gid;
            const float are = p.in[I_ARE][ia], aim = p.in[I_AIM][ia];
            const float dt = expf(p.in[I_LOGDT][ia >> 6]);
            float2* pw = (float2*)(ws + OFF_POWA) + (size_t)(ia >> 6) * 33 * 64 + (ia & 63);
            float abr = 1.f, abi = 0.f;
            for (int tau = 0; tau <= 32; ++tau) {
                float mag = expf(are * dt * (float)tau), s, c;
                sincosf(aim * dt * (float)tau, &s, &c);
                pw[tau * 64] = make_float2(mag * c, mag * s);
                if (tau == 1) { abr = mag * c; abi = mag * s; }
            }
            const float nr = abr - 1.0f, ni = abi, den = are * are + aim * aim;
            const float qr = (nr * are + ni * aim) / den, qi = (ni * are - nr * aim) / den;
            float2* bb = (float2*)(ws + OFF_BBAR) + (size_t)ia * 16;
#pragma unroll
            for (int h = 0; h < 16; ++h) {
                float br = p.in[I_BRE][(size_t)ia * 16 + h], bi = p.in[I_BIM][(size_t)ia * 16 + h];
                bb[h] = make_float2(qr * br - qi * bi, qr * bi + qi * br);
            }
        }
    }
}

__device__ void norm_tokens(const Params& p, int L, int which, int ntok, bool from_input, int item0, int nitems_total) {
    const int tid = TIDX, lane = tid & 63, w = tid >> 6;
    const float* modL = (const float*)(p.ws + OFF_MOD) + (size_t)L * 9 * 6144;
    const float* gvec = p.in[which ? I_N2G : I_N1G] + L * 1024;
    bf16_t* dst = (bf16_t*)(p.ws + OFF_ACT);
    for (int it = item0 + BIDX; it < nitems_total; it += gridDim.x) {
        if (it < item0) continue;
        const int tt = (it - item0) * 8 + w;
        if (tt >= ntok) continue;
        const float* src;
        if (tt < T) src = (from_input ? p.in[I_X] : p.out) + (size_t)tt * 1024;
        else src = (from_input ? p.in[I_CTX] : (const float*)(p.ws + OFF_XCTX)) + (size_t)(tt - T) * 1024;
        const float* sh = modL + (size_t)tok_modrow(tt) * 6144 + (which ? 3072 : 0);
        const float* sc = sh + 1024;
        float4 v[4]; float ss = 0.f;
#pragma unroll
        for (int i = 0; i < 4; ++i) { v[i] = *(const float4*)(src + (i * 64 + lane) * 4); ss += v[i].x * v[i].x + v[i].y * v[i].y + v[i].z * v[i].z + v[i].w * v[i].w; }
        ss = wave_sum(ss);
        const float r = rsqrtf(ss * (1.0f / 1024.0f) + EPS);
#pragma unroll
        for (int i = 0; i < 4; ++i) {
            const int k = (i * 64 + lane) * 4;
            float4 g = *(const float4*)(gvec + k), a = *(const float4*)(sc + k), b = *(const float4*)(sh + k);
            float o0 = v[i].x * r * g.x * (1.f + a.x) + b.x, o1 = v[i].y * r * g.y * (1.f + a.y) + b.y;
            float o2 = v[i].z * r * g.z * (1.f + a.z) + b.z, o3 = v[i].w * r * g.w * (1.f + a.w) + b.w;
            *(uint2*)(dst + (size_t)tt * 1024 + k) = make_uint2(pack2(o0, o1), pack2(o2, o3));
        }
    }
}

__device__ void phase_A(const Params& p, int L) {
    const int n_norm = TT / 8;
    const int n_kt = (L == 0) ? 1024 : 0;
    for (int it = BIDX; it < n_kt; it += gridDim.x) {
        const int gid = it * NTHREADS + TIDX;
        const int hp = gid & 15, h = (gid >> 4) & 15, tau = (gid >> 8) & 31, ldg = gid >> 13;
        const float* cre = p.in[I_CRE] + ((size_t)ldg * 16 + h) * 64;
        const float* cim = p.in[I_CIM] + ((size_t)ldg * 16 + h) * 64;
        const float2* pw = (const float2*)(p.ws + OFF_POWA) + ((size_t)ldg * 33 + tau) * 64;
        const float2* bb = (const float2*)(p.ws + OFF_BBAR) + (size_t)ldg * 64 * 16 + hp;
        float acc = 0.f;
        for (int q = 0; q < 64; ++q) {
            float2 a = pw[q], b = bb[q * 16];
            float cr = cre[q], ci = cim[q];
            float wr = cr * a.x - ci * a.y, wi = cr * a.y + ci * a.x;
            acc += wr * b.x - wi * b.y;
        }
        ((float*)(p.ws + OFF_KTAU))[gid] = acc;
    }
    norm_tokens(p, L, 0, TT, L == 0, n_kt, n_kt + n_norm);
}

__device__ void phase_B(const Params& p, int L, unsigned char* smem) {
    unsigned char* ws = p.ws;
    constexpr int N_G = (TT / 128) * 16, N_WC = 1536, N_WS = 512;
    const bf16_t* A = (const bf16_t*)(ws + OFF_ACT);
    const bf16_t* Bt = (const bf16_t*)(ws + OFF_WINT + L * SZ_WINT);
    bf16_t* xin = (bf16_t*)(ws + OFF_XIN);
    for (int it = BIDX; it < N_G + N_WC + N_WS; it += gridDim.x) {
        if (it < N_G) {
            const int mt = it >> 4, nt = it & 15;
            if (nt == 4 || nt == 5) {
                bf16_t* vt = (bf16_t*)(ws + OFF_VT); bf16_t* vtc = (bf16_t*)(ws + OFF_VTC);
                const int tok0 = mt * 128;
                bf16_t* base; int stride;
                if (tok0 < T) { base = vt + (size_t)((tok0 >> 12) * 256) * 4096 + (tok0 & 4095); stride = 4096; }
                else { const int c = tok0 - T; base = vtc + (size_t)((c >> 8) * 256) * 256 + (c & 255); stride = 256; }
                gemm128<false>([&](int r) { return Bt + (size_t)(nt * 128 + r) * 1024; },
                               [&](int r) { return A + (size_t)(mt * 128 + r) * 1024; }, 1024,
                               [&](int m, int n, float v) { base[(size_t)((nt - 4) * 128 + m) * stride + n] = f2bf(v); }, smem);
            } else {
                gemm128<false>([&](int r) { return A + (size_t)(mt * 128 + r) * 1024; },
                               [&](int r) { return Bt + (size_t)(nt * 128 + r) * 1024; }, 1024,
                               [&](int m, int n, float v) { xin[(size_t)(mt * 128 + m) * 2048 + nt * 128 + n] = f2bf(v); }, smem);
            }
        } else if (it < N_G + N_WC) {
            const int cid = (it - N_G) * NTHREADS + TIDX;
            const int kc = cid % 96, m = (cid / 96) & 511, g = cid / (96 * 512);
            const int i = m >> 4, h = m & 15;
            float vals[8];
            if (kc < 32) {
                const int dr = kc >> 4, ri = (kc >> 3) & 1, p0 = (kc & 7) * 8;
                const int ldg = (L * 2 + dr) * 16 + g;
                const int e = dr == 0 ? (i + 1) : (32 - i);
                const float2* pw = (const float2*)(ws + OFF_POWA) + ((size_t)ldg * 33 + e) * 64 + p0;
                const float* cre = p.in[I_CRE] + ((size_t)ldg * 16 + h) * 64 + p0;
                const float* cim = p.in[I_CIM] + ((size_t)ldg * 16 + h) * 64 + p0;
#pragma unroll
                for (int q = 0; q < 8; ++q) {
                    float2 a = pw[q]; float cr = cre[q], ci = cim[q];
                    float wr = cr * a.x - ci * a.y, wi = cr * a.y + ci * a.x;
                    vals[q] = ri == 0 ? wr : -wi;
                }
            } else {
                const int kk = (kc - 32) * 8, j = kk >> 4, h0 = kk & 15;
                const float* kf = (const float*)(ws + OFF_KTAU) + (size_t)((L * 2 + 0) * 16 + g) * 32 * 256;
                const float* kb = (const float*)(ws + OFF_KTAU) + (size_t)((L * 2 + 1) * 16 + g) * 32 * 256;
#pragma unroll
                for (int q = 0; q < 8; ++q) {
                    float v = 0.f;
                    if (j <= i) v += kf[((i - j) * 16 + h) * 16 + h0 + q];
                    if (j >= i) v += kb[((j - i) * 16 + h) * 16 + h0 + q];
                    vals[q] = v;
                }
            }
            bf16_t* dst = (bf16_t*)(ws + OFF_WCOMB) + ((size_t)g * 512 + m) * KV + kc * 8;
            *(uint4*)dst = make_uint4(pack2(vals[0], vals[1]), pack2(vals[2], vals[3]), pack2(vals[4], vals[5]), pack2(vals[6], vals[7]));
        } else {
            const int cid = (it - N_G - N_WC) * NTHREADS + TIDX;
            const int kc = cid & 63, m = (cid >> 6) & 255, g = cid >> 14;
            const int dr = m >> 7, ri = (m >> 6) & 1, pp = m & 63;
            const int j = kc >> 1, h0 = (kc & 1) * 8;
            const int ldg = (L * 2 + dr) * 16 + g;
            const int e = dr == 0 ? (31 - j) : j;
            const float2 a = ((const float2*)(ws + OFF_POWA))[((size_t)ldg * 33 + e) * 64 + pp];
            const float2* bb = (const float2*)(ws + OFF_BBAR) + ((size_t)ldg * 64 + pp) * 16 + h0;
            float vals[8];
#pragma unroll
            for (int q = 0; q < 8; ++q) { float2 b = bb[q]; vals[q] = ri == 0 ? (a.x * b.x - a.y * b.y) : (a.x * b.y + a.y * b.x); }
            bf16_t* dst = (bf16_t*)(ws + OFF_WST) + ((size_t)g * 256 + m) * 512 + kc * 8;
            *(uint4*)dst = make_uint4(pack2(vals[0], vals[1]), pack2(vals[2], vals[3]), pack2(vals[4], vals[5]), pack2(vals[6], vals[7]));
        }
    }
}

struct AttnStep { bf16x8 kf[2][2]; uint2 vf[4][2]; };

__device__ __forceinline__ void attn_mfma_item(const Params& p, int L, int item, const float* rpb_lds) {
    const int lane = TIDX & 63, lr = lane & 15, g = lane >> 4;
    const bf16_t* xin = (const bf16_t*)(p.ws + OFF_XIN);
    bf16_t* ymix = (bf16_t*)(p.ws + OFF_YMIX);
    int b, h, r = 0, c0 = 0, qtok, ncb = 0, cb0 = 0;
    const bool lat = item < 8192;
    if (lat) { const int qt = item & 3; h = (item >> 2) & 3; r = (item >> 4) & 63; b = item >> 10; c0 = qt * 16; qtok = b * 4096 + r * 64 + c0 + lr;
               ncb = (qt == 0 || qt == 3) ? 1 : 2; cb0 = (qt == 3) ? 1 : 0; }
    else { const int q = item - 8192; h = (q >> 4) & 3; b = q >> 6; qtok = T + b * 256 + (q & 15) * 16 + lr; }
    const int nsteps = 8 + 8 * ncb;
    bf16x8 qf[2];
#pragma unroll
    for (int ks = 0; ks < 2; ++ks) qf[ks] = *(const bf16x8*)(xin + (size_t)qtok * 2048 + h * 64 + ks * 32 + g * 8);
    const bf16_t* kctx = xin + (size_t)(T + b * 256) * 2048 + 256 + h * 64;
    const bf16_t* klat = xin + (size_t)(b * 4096) * 2048 + 256 + h * 64;
    const bf16_t* vtc = (const bf16_t*)(p.ws + OFF_VTC) + (size_t)((b * 4 + h) * 64) * 256;
    const bf16_t* vtl = (const bf16_t*)(p.ws + OFF_VT) + (size_t)((b * 4 + h) * 64) * 4096;
    const int rs = min(max(r - 4, 0), 56);
    const int cq = c0 + lr, cs = min(max(cq - 8, 0), 48);
    const float* rpbh = rpb_lds + h * 465;
    f32x4 o[4];
#pragma unroll
    for (int dt = 0; dt < 4; ++dt) o[dt] = f32x4{0.f, 0.f, 0.f, 0.f};
    float mrun = -3.0e38f, lsum = 0.f;

    auto load_step = [&](int s, AttnStep& st) {
        const bf16_t* kb; const bf16_t* vb; int vstride;
        if (s < 8) { kb = kctx + (size_t)(s * 32) * 2048; vb = vtc + s * 32; vstride = 256; }
        else {
            const int s2 = s - 8, kr = (ncb == 2) ? (s2 >> 1) : s2, cb = cb0 + ((ncb == 2) ? (s2 & 1) : 0);
            const int key0 = (rs + kr) * 64 + cb * 32;
            kb = klat + (size_t)key0 * 2048; vb = vtl + key0; vstride = 4096;
        }
#pragma unroll
        for (int t = 0; t < 2; ++t)
#pragma unroll
            for (int ks = 0; ks < 2; ++ks) st.kf[t][ks] = *(const bf16x8*)(kb + (size_t)(t * 16 + lr) * 2048 + ks * 32 + g * 8);
#pragma unroll
        for (int dt = 0; dt < 4; ++dt) {
            const bf16_t* vr = vb + (size_t)(dt * 16 + lr) * vstride + 4 * g;
            st.vf[dt][0] = *(const uint2*)vr; st.vf[dt][1] = *(const uint2*)(vr + 16);
        }
    };
    auto compute_step = [&](int s, const AttnStep& st) {
        f32x4 sa[2];
#pragma unroll
        for (int t = 0; t < 2; ++t) {
            sa[t] = f32x4{0.f, 0.f, 0.f, 0.f};
#pragma unroll
            for (int ks = 0; ks < 2; ++ks) sa[t] = __builtin_amdgcn_mfma_f32_16x16x32_bf16(st.kf[t][ks], qf[ks], sa[t], 0, 0, 0);
        }
        float sc[8];
#pragma unroll
        for (int t = 0; t < 2; ++t)
#pragma unroll
            for (int j = 0; j < 4; ++j) sc[t * 4 + j] = sa[t][j] * 0.125f;
        if (s >= 8) {
            const int s2 = s - 8, kr = (ncb == 2) ? (s2 >> 1) : s2, cb = cb0 + ((ncb == 2) ? (s2 & 1) : 0);
            const float* rp = rpbh + (rs + kr - r + 7) * 31 + 15 - cq;
#pragma unroll
            for (int t = 0; t < 2; ++t)
#pragma unroll
                for (int j = 0; j < 4; ++j) {
                    const int kc = cb * 32 + t * 16 + 4 * g + j;
                    const bool valid = (kc >= cs) && (kc < cs + 16);
                    const float bias = rp[valid ? kc : cq];
                    sc[t * 4 + j] = valid ? (sc[t * 4 + j] + bias) : -1.0e30f;
                }
        }
        float bm = fmaxf(fmaxf(fmaxf(sc[0], sc[1]), fmaxf(sc[2], sc[3])), fmaxf(fmaxf(sc[4], sc[5]), fmaxf(sc[6], sc[7])));
        bm = fmaxf(bm, __shfl_xor(bm, 16)); bm = fmaxf(bm, __shfl_xor(bm, 32));
        const float mn = fmaxf(mrun, bm);
        const float corr = __expf(mrun - mn);
        mrun = mn; lsum *= corr;
#pragma unroll
        for (int dt = 0; dt < 4; ++dt) { o[dt][0] *= corr; o[dt][1] *= corr; o[dt][2] *= corr; o[dt][3] *= corr; }
        float pr[8];
#pragma unroll
        for (int i = 0; i < 8; ++i) { pr[i] = __expf(sc[i] - mn); lsum += pr[i]; }
        const uint4 pbu = make_uint4(pack2(pr[0], pr[1]), pack2(pr[2], pr[3]), pack2(pr[4], pr[5]), pack2(pr[6], pr[7]));
        const bf16x8 pb = __builtin_bit_cast(bf16x8, pbu);
#pragma unroll
        for (int dt = 0; dt < 4; ++dt) {
            const uint4 vu = make_uint4(st.vf[dt][0].x, st.vf[dt][0].y, st.vf[dt][1].x, st.vf[dt][1].y);
            o[dt] = __builtin_amdgcn_mfma_f32_16x16x32_bf16(__builtin_bit_cast(bf16x8, vu), pb, o[dt], 0, 0, 0);
        }
    };

    AttnStep sA, sB;
    load_step(0, sA);
#pragma unroll 1
    for (int s = 0; s < nsteps; s += 2) {
        load_step(s + 1, sB);
        compute_step(s, sA);
        if (s + 2 < nsteps) load_step(s + 2, sA);
        compute_step(s + 1, sB);
    }
    lsum += __shfl_xor(lsum, 16); lsum += __shfl_xor(lsum, 32);
    const float inv = 1.0f / lsum;
#pragma unroll
    for (int dt = 0; dt < 4; ++dt)
        *(uint2*)(ymix + (size_t)qtok * 1024 + h * 64 + dt * 16 + 4 * g) = make_uint2(pack2(o[dt][0] * inv, o[dt][1] * inv), pack2(o[dt][2] * inv, o[dt][3] * inv));
}

__device__ void phase_C(const Params& p, int L, unsigned char* smem) {
    unsigned char* ws = p.ws;
    const int tid = TIDX, w = tid >> 6;
    const bf16_t* xin = (const bf16_t*)(ws + OFF_XIN);
    bf16_t* ymix = (bf16_t*)(ws + OFF_YMIX);
    const int n_attn_w = (L == 0) ? 8192 + 512 : 8192;
    float* rpb_lds = (float*)(smem + 70016);
    for (int i = tid; i < 4 * 465; i += NTHREADS) rpb_lds[i] = p.in[I_RPB][(size_t)L * 4 * 465 + i];
    __syncthreads();
    const int N_ATT = (n_attn_w + 7) / 8;
    const int N_F1 = 1024 + ((L == 0) ? 64 : 0);
    const int N_CONV = TT * 32 / NTHREADS;
    const int N_S1 = TT * 16 / NTHREADS;
    const int O_F1 = N_ATT, O_CONV = O_F1 + N_F1, O_S1 = O_CONV + N_CONV, N_ALL = O_S1 + N_S1;
    for (int it = BIDX; it < N_ALL; it += gridDim.x) {
        if (it < O_F1) {
            const int item = it * 8 + w;
            if (item < n_attn_w) attn_mfma_item(p, L, item, rpb_lds);
        } else if (it < O_CONV) {
            int idx = it - O_F1;
            const bf16_t* dd = (const bf16_t*)(ws + OFF_DFTD);
            if (idx < 1024) {
                const int b = idx >> 7, h = (idx >> 5) & 3, nt = idx & 31;
                bf16_t* zt = (bf16_t*)(ws + OFF_ZT);
                gemm128<false>([&](int r) { return dd + r * 64; },
                               [&](int r) { return xin + (size_t)(b * 4096 + nt * 128 + r) * 2048 + 1536 + h * 64; }, 64,
                               [&](int m, int n, float v) { zt[((size_t)(b * 256 + h * 64 + (m & 63)) * 2 + (m >> 6)) * 4096 + nt * 128 + n] = f2bf(v); }, smem);
            } else {
                idx -= 1024;
                const int b = idx >> 3, h = (idx >> 1) & 3, nt = idx & 1;
                bf16_t* zt = (bf16_t*)(ws + OFF_ZTC);
                gemm128<false>([&](int r) { return dd + r * 64; },
                               [&](int r) { return xin + (size_t)(T + b * 256 + nt * 128 + r) * 2048 + 1536 + h * 64; }, 64,
                               [&](int m, int n, float v) { zt[((size_t)(b * 256 + h * 64 + (m & 63)) * 2 + (m >> 6)) * 256 + nt * 128 + n] = f2bf(v); }, smem);
            }
        } else if (it < O_S1) {
            const int gid = (it - O_CONV) * NTHREADS + tid;
            const int tt = gid >> 5, ch0 = (gid & 31) * 8;
            bool first, last;
            if (tt < T) { int l = tt & 4095; first = l == 0; last = l == 4095; } else { int j = (tt - T) & 255; first = j == 0; last = j == 255; }
            const bf16_t* row = xin + (size_t)tt * 2048;
            const uint4 cb = *(const uint4*)(row + 768 + ch0), cc = *(const uint4*)(row + 1024 + ch0), cx = *(const uint4*)(row + 1280 + ch0);
            uint4 ccp = make_uint4(0, 0, 0, 0), cxp = ccp, ccn = ccp, cxn = ccp;
            if (!first) { ccp = *(const uint4*)(row - 2048 + 1024 + ch0); cxp = *(const uint4*)(row - 2048 + 1280 + ch0); }
            if (!last) { ccn = *(const uint4*)(row + 2048 + 1024 + ch0); cxn = *(const uint4*)(row + 2048 + 1280 + ch0); }
            const float* cw = p.in[I_CONVW] + (size_t)L * 3 * 256 + ch0;
            const unsigned cbv[4] = {cb.x, cb.y, cb.z, cb.w}, ccv[4] = {cc.x, cc.y, cc.z, cc.w}, cxv[4] = {cx.x, cx.y, cx.z, cx.w};
            const unsigned cpv[4] = {ccp.x, ccp.y, ccp.z, ccp.w}, xpv[4] = {cxp.x, cxp.y, cxp.z, cxp.w};
            const unsigned cnv[4] = {ccn.x, ccn.y, ccn.z, ccn.w}, xnv[4] = {cxn.x, cxn.y, cxn.z, cxn.w};
            unsigned o[4];
#pragma unroll
            for (int e = 0; e < 4; ++e) {
                float w0a = cw[2 * e], w0b = cw[2 * e + 1], w1a = cw[256 + 2 * e], w1b = cw[256 + 2 * e + 1], w2a = cw[512 + 2 * e], w2b = cw[512 + 2 * e + 1];
                float za = w0a * bflo(cpv[e]) * bflo(xpv[e]) + w1a * bflo(ccv[e]) * bflo(cxv[e]) + w2a * bflo(cnv[e]) * bflo(xnv[e]);
                float zb = w0b * bfhi(cpv[e]) * bfhi(xpv[e]) + w1b * bfhi(ccv[e]) * bfhi(cxv[e]) + w2b * bfhi(cnv[e]) * bfhi(xnv[e]);
                o[e] = pack2(bflo(cbv[e]) * za, bfhi(cbv[e]) * zb);
            }
            *(uint4*)(ymix + (size_t)tt * 1024 + 256 + ch0) = make_uint4(o[0], o[1], o[2], o[3]);
        } else {
            const int gid = (it - O_S1) * NTHREADS + tid;
            const int tt = gid >> 4, g = gid & 15;
            int n, j;
            if (tt < T) { int b = tt >> 12, l = tt & 4095; n = b * NCHB + 8 + (l >> 5); j = l & 31; }
            else { int c = tt - T; int b = c >> 8; n = b * NCHB + ((c & 255) >> 5); j = c & 31; }
            const uint4* src = (const uint4*)(xin + (size_t)tt * 2048 + 1792 + g * 16);
            uint4* dst = (uint4*)((bf16_t*)(ws + OFF_VG) + ((size_t)g * NCHP + n) * KV + 256 + j * 16);
            dst[0] = src[0]; dst[1] = src[1];
        }
    }
}

__device__ void phase_D(const Params& p, int L, unsigned char* smem) {
    unsigned char* ws = p.ws;
    bf16_t* ymix = (bf16_t*)(ws + OFF_YMIX);
    const int N_F2 = 512, N_F2C = (L == 0) ? 32 : 0, N_S2 = 288;
    const int O_F2C = N_F2, O_S2 = O_F2C + N_F2C, N_ALL = O_S2 + N_S2;
    for (int it = BIDX; it < N_ALL; it += gridDim.x) {
        if (it < O_F2C) {
            const int b = it >> 6, mt = (it >> 1) & 31, nt = it & 1;
            const bf16_t* dl = (const bf16_t*)(ws + OFF_DFTL);
            const bf16_t* zt = (const bf16_t*)(ws + OFF_ZT);
            gemm128<false>([&](int r) { return dl + (size_t)(mt * 128 + r) * 8192; },
                           [&](int r) { return zt + (size_t)(b * 256 + nt * 128 + r) * 8192; }, 8192,
                           [&](int m, int n, float v) { ymix[(size_t)(b * 4096 + mt * 128 + m) * 1024 + 512 + nt * 128 + n] = f2bf(v); }, smem);
        } else if (it < O_S2) {
            const int idx = it - O_F2C;
            const int b = idx >> 2, mt = (idx >> 1) & 1, nt = idx & 1;
            const bf16_t* dc = (const bf16_t*)(ws + OFF_DFTC);
            const bf16_t* zt = (const bf16_t*)(ws + OFF_ZTC);
            gemm128<false>([&](int r) { return dc + (size_t)(mt * 128 + r) * 512; },
                           [&](int r) { return zt + (size_t)(b * 256 + nt * 128 + r) * 512; }, 512,
                           [&](int m, int n, float v) { ymix[(size_t)(T + b * 256 + mt * 128 + m) * 1024 + 512 + nt * 128 + n] = f2bf(v); }, smem);
        } else {
            const int idx = it - O_S2;
            const int g = idx / 18, rem = idx % 18, mt = rem / 9, nt = rem % 9;
            const bf16_t* wst = (const bf16_t*)(ws + OFF_WST) + (size_t)g * 256 * 512;
            const bf16_t* vg = (const bf16_t*)(ws + OFF_VG) + (size_t)g * NCHP * KV;
            float* sc = (float*)(ws + OFF_SC) + (size_t)g * NCH * 256;
            gemm128<false>([&](int r) { return wst + (size_t)(mt * 128 + r) * 512; },
                           [&](int r) { return vg + (size_t)(nt * 128 + r) * KV + 256; }, 512,
                           [&](int m, int n, float v) { int nn = nt * 128 + n; if (nn < NCH) sc[(size_t)nn * 256 + mt * 128 + m] = v; }, smem);
        }
    }
}

__device__ void phase_E(const Params& p, int L) {
    unsigned char* ws = p.ws;
    for (int it = BIDX; it < 32; it += gridDim.x) {
        const int gid = it * NTHREADS + TIDX;
        const int b = gid >> 11, g = (gid >> 7) & 15, dr = (gid >> 6) & 1, pp = gid & 63;
        const float2 a32 = ((const float2*)(ws + OFF_POWA))[((size_t)((L * 2 + dr) * 16 + g) * 33 + 32) * 64 + pp];
        bf16_t* vg = (bf16_t*)(ws + OFF_VG) + (size_t)g * NCHP * KV + dr * 128 + pp;
        const float* sc = (const float*)(ws + OFF_SC) + (size_t)g * NCH * 256 + dr * 128 + pp;
        float hr = 0.f, hi = 0.f;
        for (int s0 = 0; s0 < NCHB; s0 += 8) {
            float sr[8], si[8]; int nn[8];
#pragma unroll
            for (int q = 0; q < 8; ++q) {
                const int s = s0 + q;
                const int cidx = dr == 0 ? s : (s < 8 ? 7 - s : NCHB - 1 - (s - 8));
                nn[q] = b * NCHB + cidx;
                sr[q] = sc[(size_t)nn[q] * 256]; si[q] = sc[(size_t)nn[q] * 256 + 64];
            }
#pragma unroll
            for (int q = 0; q < 8; ++q) {
                vg[(size_t)nn[q] * KV] = f2bf(hr); vg[(size_t)nn[q] * KV + 64] = f2bf(hi);
                const float nr = a32.x * hr - a32.y * hi + sr[q], ni = a32.x * hi + a32.y * hr + si[q];
                hr = nr; hi = ni;
            }
        }
    }
}

__device__ void phase_F(const Params& p, int L, unsigned char* smem) {
    unsigned char* ws = p.ws;
    bf16_t* gbuf = (bf16_t*)(ws + OFF_GBUF);
    const float* dsk = p.in[I_S5D] + L * 256;
    for (int it = BIDX; it < 576; it += gridDim.x) {
        const int g = it / 36, rem = it % 36, mt = rem >> 2, nt = rem & 3;
        const bf16_t* vg = (const bf16_t*)(ws + OFF_VG) + (size_t)g * NCHP * KV;
        const bf16_t* wc = (const bf16_t*)(ws + OFF_WCOMB) + (size_t)g * 512 * KV;
        gemm128<false>([&](int r) { return vg + (size_t)(mt * 128 + r) * KV; },
                       [&](int r) { return wc + (size_t)(nt * 128 + r) * KV; }, KV,
                       [&](int m, int n, float v) {
                           const int nn = mt * 128 + m;
                           if (nn < NCH) {
                               const int nc = nt * 128 + n, i = nc >> 4, h = nc & 15;
                               const int b = nn / NCHB, cidx = nn % NCHB;
                               const int tt = cidx < 8 ? (T + b * 256 + cidx * 32 + i) : (b * 4096 + (cidx - 8) * 32 + i);
                               const float u = bf2f(vg[(size_t)nn * KV + 256 + nc]);
                               const float y = v + dsk[g * 16 + h] * u;
                               gbuf[(size_t)tt * 256 + g * 16 + h] = f2bf(gelu_tanh(y));
                           }
                       }, smem);
    }
}

__device__ void phase_G(const Params& p, int L, unsigned char* smem) {
    unsigned char* ws = p.ws;
    const bf16_t* gbuf = (const bf16_t*)(ws + OFF_GBUF);
    const bf16_t* wg = (const bf16_t*)(ws + OFF_WGLUT + L * SZ_WGLUT);
    bf16_t* ymix = (bf16_t*)(ws + OFF_YMIX);
    for (int it = BIDX; it < (TT / 128) * 2; it += gridDim.x) {
        const int mt = it >> 1, nt = it & 1;
        gemm128<false>([&](int r) { return gbuf + (size_t)(mt * 128 + r) * 256; },
                       [&](int r) { return wg + (size_t)(nt * 128 + r) * 256; }, 256,
                       [&](int m, int n, float v) {
                           const size_t tt = mt * 128 + m; const int nn = nt * 128 + n;
                           const float gg = bf2f(gbuf[tt * 256 + nn]);
                           ymix[tt * 1024 + 768 + nn] = f2bf(gg * sigmoidf_(v));
                       }, smem);
    }
}

__device__ void phase_H(const Params& p, int L) {
    const int lane = TIDX & 63, w = TIDX >> 6;
    const bf16_t* ymix = (const bf16_t*)(p.ws + OFF_YMIX);
    bf16_t* dst = (bf16_t*)(p.ws + OFF_ACT);
    const float* gg = p.in[I_GRPG] + (size_t)L * 1024 + lane * 16;
    for (int it = BIDX; it < TT / 8; it += gridDim.x) {
        const int tt = it * 8 + w;
        const uint4* src = (const uint4*)(ymix + (size_t)tt * 1024 + lane * 16);
        const uint4 a = src[0], b = src[1];
        const unsigned u[8] = {a.x, a.y, a.z, a.w, b.x, b.y, b.z, b.w};
        float v[16], ss = 0.f;
#pragma unroll
        for (int e = 0; e < 8; ++e) { v[2 * e] = bflo(u[e]); v[2 * e + 1] = bfhi(u[e]); ss += v[2 * e] * v[2 * e] + v[2 * e + 1] * v[2 * e + 1]; }
        ss += __shfl_xor(ss, 1); ss += __shfl_xor(ss, 2); ss += __shfl_xor(ss, 4); ss += __shfl_xor(ss, 8);
        const float r = rsqrtf(ss * (1.0f / 256.0f) + EPS);
        unsigned o[8];
#pragma unroll
        for (int e = 0; e < 8; ++e) o[e] = pack2(v[2 * e] * r * gg[2 * e], v[2 * e + 1] * r * gg[2 * e + 1]);
        uint4* d = (uint4*)(dst + (size_t)tt * 1024 + lane * 16);
        d[0] = make_uint4(o[0], o[1], o[2], o[3]); d[1] = make_uint4(o[4], o[5], o[6], o[7]);
    }
}

__device__ void phase_I(const Params& p, int L, unsigned char* smem) {
    unsigned char* ws = p.ws;
    const int mtok = (L == 0) ? TT : T;
    const int N_G = (mtok / 128) * 8, N_CV = 4096;
    const bf16_t* A = (const bf16_t*)(ws + OFF_ACT);
    const bf16_t* Bt = (const bf16_t*)(ws + OFF_WOUTT + L * SZ_WOUTT);
    const float* g1 = (const float*)(ws + OFF_MOD) + (size_t)L * 9 * 6144 + 2048;
    float* xctx = (float*)(ws + OFF_XCTX);
    for (int it = BIDX; it < N_G + N_CV; it += gridDim.x) {
        if (it < N_G) {
            const int mt = it >> 3, nt = it & 7;
            gemm128<false>([&](int r) { return A + (size_t)(mt * 128 + r) * 1024; },
                           [&](int r) { return Bt + (size_t)(nt * 128 + r) * 1024; }, 1024,
                           [&](int m, int n, float v) {
                               const int tt = mt * 128 + m, nn = nt * 128 + n;
                               const float gate = g1[(size_t)tok_modrow(tt) * 6144 + nn];
                               if (tt < T) {
                                   const size_t o = (size_t)tt * 1024 + nn;
                                   const float xr = (L == 0) ? p.in[I_X][o] : p.out[o];
                                   p.out[o] = xr + gate * v;
                               } else {
                                   const size_t o = (size_t)(tt - T) * 1024 + nn;
                                   xctx[o] = p.in[I_CTX][o] + gate * v;
                               }
                           }, smem);
        } else {
            const int lane = TIDX & 63, w = TIDX >> 6;
            const int rid = (it - N_G) * 8 + w;
            const int which = rid >> 14, row = rid & 16383;
            const float* src = p.in[which ? I_PV : I_PU] + ((size_t)L * 16384 + row) * 1024 + lane * 16;
            float4 v[4]; float mx = 0.f;
#pragma unroll
            for (int i = 0; i < 4; ++i) {
                v[i] = *(const float4*)(src + i * 4);
                mx = fmaxf(mx, fmaxf(fmaxf(fabsf(v[i].x), fabsf(v[i].y)), fmaxf(fabsf(v[i].z), fabsf(v[i].w))));
            }
#pragma unroll
            for (int o = 32; o >= 1; o >>= 1) mx = fmaxf(mx, __shfl_xor(mx, o));
            mx = fmaxf(mx, 1e-30f);
            const float sc = mx * (1.0f / 448.0f), inv = 448.0f / mx;
            int pk[4];
#pragma unroll
            for (int i = 0; i < 4; ++i) {
                int wd = 0;
                wd = __builtin_amdgcn_cvt_pk_fp8_f32(v[i].x * inv, v[i].y * inv, wd, false);
                wd = __builtin_amdgcn_cvt_pk_fp8_f32(v[i].z * inv, v[i].w * inv, wd, true);
                pk[i] = wd;
            }
            *(int4*)(ws + (which ? OFF_PEERV : OFF_PEERU) + (size_t)row * 1024 + lane * 16) = make_int4(pk[0], pk[1], pk[2], pk[3]);
            if (lane == 0) ((float*)(ws + (which ? OFF_PSCV : OFF_PSCU)))[row] = sc;
        }
    }
}

__device__ void phase_K(const Params& p, int L, unsigned char* smem) {
    unsigned char* ws = p.ws;
    const int tid = TIDX;
    const int mtok = (L == 0) ? TT : T;
    const bf16_t* A = (const bf16_t*)(ws + OFF_ACT);
    const bf16_t* Bt = (const bf16_t*)(ws + OFF_WQKT + L * SZ_WQKT);
    int* cand = (int*)(ws + OFF_CAND);
    const float* tc = (const float*)smem;
    int* cl = (int*)(smem + 66048);
    int* cl2 = (int*)(smem + 66048 + 32768);
    for (int it = BIDX; it < (mtok / 128) * 16; it += gridDim.x) {
        const int mt = it >> 4, hz = it & 15;
        gemm128<true>([&](int r) { return A + (size_t)(mt * 128 + r) * 1024; },
                      [&](int r) { return Bt + (size_t)(hz * 128 + r) * 1024; }, 1024,
                      [&](int, int, float) {}, smem);
        const int row = tid & 127, q = tid >> 7;
        int top[16];
#pragma unroll
        for (int j = 0; j < 16; ++j) top[j] = (int)0x80000000;
        for (int j = 0; j < 32; ++j) {
            const int col = q * 32 + j;
            const int key = (sortable(tc[row * 129 + col]) & ~0x7F) | col;
            top16_insert(top, key);
        }
#pragma unroll
        for (int j = 0; j < 16; ++j) cl[(row * 4 + q) * 16 + j] = top[j];
        __syncthreads();
        if (q < 2) {
#pragma unroll
            for (int j = 0; j < 16; ++j) top[j] = (int)0x80000000;
            for (int j = 0; j < 32; ++j) top16_insert(top, cl[(row * 4 + q * 2) * 16 + j]);
#pragma unroll
            for (int j = 0; j < 16; ++j) cl2[(row * 2 + q) * 16 + j] = top[j];
        }
        __syncthreads();
        if (q == 0) {
#pragma unroll
            for (int j = 0; j < 16; ++j) top[j] = (int)0x80000000;
            for (int j = 0; j < 32; ++j) top16_insert(top, cl2[row * 32 + j]);
            int4* dst = (int4*)(cand + ((size_t)(mt * 128 + row) * 16 + hz) * 16);
            dst[0] = make_int4(top[0], top[1], top[2], top[3]); dst[1] = make_int4(top[4], top[5], top[6], top[7]);
            dst[2] = make_int4(top[8], top[9], top[10], top[11]); dst[3] = make_int4(top[12], top[13], top[14], top[15]);
        }
        __syncthreads();
    }
}

__device__ void phase_L(const Params& p, int L) {
    const int mtok = (L == 0) ? TT : T;
    const int* cand = (const int*)(p.ws + OFF_CAND);
    int* eidx = (int*)(p.ws + OFF_EIDX);
    float* gate = (float*)(p.ws + OFF_GATE);
    const int nit = mtok * 8 / NTHREADS;
    for (int it = BIDX; it < nit; it += gridDim.x) {
        const int gid = it * NTHREADS + TIDX;
        const int tt = gid >> 3, hd = gid & 7;
        const int* c1 = cand + ((size_t)tt * 16 + hd * 2) * 16;
        const int* c2 = c1 + 16;
        float s1[16], s2[16];
        {
            const int4* a = (const int4*)c1; const int4* b = (const int4*)c2;
#pragma unroll
            for (int q = 0; q < 4; ++q) {
                int4 x = a[q], y = b[q];
                s1[q * 4] = unsortable(x.x & ~0x7F); s1[q * 4 + 1] = unsortable(x.y & ~0x7F); s1[q * 4 + 2] = unsortable(x.z & ~0x7F); s1[q * 4 + 3] = unsortable(x.w & ~0x7F);
                s2[q * 4] = unsortable(y.x & ~0x7F); s2[q * 4 + 1] = unsortable(y.y & ~0x7F); s2[q * 4 + 2] = unsortable(y.z & ~0x7F); s2[q * 4 + 3] = unsortable(y.w & ~0x7F);
            }
        }
        int top[16];
#pragma unroll
        for (int j = 0; j < 16; ++j) top[j] = (int)0x80000000;
#pragma unroll
        for (int i = 0; i < 16; ++i)
#pragma unroll
            for (int j = 0; j < 16; ++j)
                if ((i + 1) * (j + 1) <= 16) top16_insert(top, (sortable(s1[i] + s2[j]) & ~0xFF) | (i * 16 + j));
        float vals[16], sum = 0.f;
        const float mx = unsortable(top[0] & ~0xFF);
#pragma unroll
        for (int j = 0; j < 16; ++j) { vals[j] = __expf(unsortable(top[j] & ~0xFF) - mx); sum += vals[j]; }
        const float inv = 1.0f / sum;
        int ei[16];
#pragma unroll
        for (int j = 0; j < 16; ++j) {
            const int pr = top[j] & 0xFF;
            ei[j] = (c1[pr >> 4] & 0x7F) * 128 + (c2[pr & 15] & 0x7F);
            vals[j] *= inv;
        }
        int4* de = (int4*)(eidx + (size_t)tt * 128 + hd * 16);
        float4* dg = (float4*)(gate + (size_t)tt * 128 + hd * 16);
#pragma unroll
        for (int q = 0; q < 4; ++q) {
            de[q] = make_int4(ei[q * 4], ei[q * 4 + 1], ei[q * 4 + 2], ei[q * 4 + 3]);
            dg[q] = make_float4(vals[q * 4], vals[q * 4 + 1], vals[q * 4 + 2], vals[q * 4 + 3]);
        }
    }
}

typedef __attribute__((ext_vector_type(2))) float f32x2;
__device__ __forceinline__ float dot16_fp8(const float (&hf)[16], const uint4& u) {
    f32x2 a0 = __builtin_amdgcn_cvt_pk_f32_fp8((int)u.x, false), a1 = __builtin_amdgcn_cvt_pk_f32_fp8((int)u.x, true);
    f32x2 a2 = __builtin_amdgcn_cvt_pk_f32_fp8((int)u.y, false), a3 = __builtin_amdgcn_cvt_pk_f32_fp8((int)u.y, true);
    f32x2 a4 = __builtin_amdgcn_cvt_pk_f32_fp8((int)u.z, false), a5 = __builtin_amdgcn_cvt_pk_f32_fp8((int)u.z, true);
    f32x2 a6 = __builtin_amdgcn_cvt_pk_f32_fp8((int)u.w, false), a7 = __builtin_amdgcn_cvt_pk_f32_fp8((int)u.w, true);
    float d0 = hf[0] * a0.x, d1 = hf[1] * a0.y;
    d0 += hf[2] * a1.x; d1 += hf[3] * a1.y; d0 += hf[4] * a2.x; d1 += hf[5] * a2.y; d0 += hf[6] * a3.x; d1 += hf[7] * a3.y;
    d0 += hf[8] * a4.x; d1 += hf[9] * a4.y; d0 += hf[10] * a5.x; d1 += hf[11] * a5.y; d0 += hf[12] * a6.x; d1 += hf[13] * a6.y;
    d0 += hf[14] * a7.x; d1 += hf[15] * a7.y;
    return d0 + d1;
}
__device__ __forceinline__ void axpy16_fp8(float (&acc)[16], float a, const uint4& v) {
    f32x2 a0 = __builtin_amdgcn_cvt_pk_f32_fp8((int)v.x, false), a1 = __builtin_amdgcn_cvt_pk_f32_fp8((int)v.x, true);
    f32x2 a2 = __builtin_amdgcn_cvt_pk_f32_fp8((int)v.y, false), a3 = __builtin_amdgcn_cvt_pk_f32_fp8((int)v.y, true);
    f32x2 a4 = __builtin_amdgcn_cvt_pk_f32_fp8((int)v.z, false), a5 = __builtin_amdgcn_cvt_pk_f32_fp8((int)v.z, true);
    f32x2 a6 = __builtin_amdgcn_cvt_pk_f32_fp8((int)v.w, false), a7 = __builtin_amdgcn_cvt_pk_f32_fp8((int)v.w, true);
    acc[0] += a * a0.x; acc[1] += a * a0.y; acc[2] += a * a1.x; acc[3] += a * a1.y; acc[4] += a * a2.x; acc[5] += a * a2.y; acc[6] += a * a3.x; acc[7] += a * a3.y;
    acc[8] += a * a4.x; acc[9] += a * a4.y; acc[10] += a * a5.x; acc[11] += a * a5.y; acc[12] += a * a6.x; acc[13] += a * a6.y; acc[14] += a * a7.x; acc[15] += a * a7.y;
}

__device__ void phase_M(const Params& p, int L) {
    const int lane = TIDX & 63, w = TIDX >> 6;
    const int mtok = (L == 0) ? TT : T;
    const bf16_t* hact = (const bf16_t*)(p.ws + OFF_ACT);
    const unsigned char* pu = p.ws + OFF_PEERU;
    const unsigned char* pv = p.ws + OFF_PEERV;
    const float* scu = (const float*)(p.ws + OFF_PSCU);
    const float* scv = (const float*)(p.ws + OFF_PSCV);
    const int* eidx = (const int*)(p.ws + OFF_EIDX);
    const float* gate = (const float*)(p.ws + OFF_GATE);
    const float* g2 = (const float*)(p.ws + OFF_MOD) + (size_t)L * 9 * 6144 + 5120;
    const bool hi32 = (lane & 32) != 0, hi16 = (lane & 16) != 0, hi8 = (lane & 8) != 0;
    for (int it = BIDX; it < mtok / 8; it += gridDim.x) {
        const int tt = it * 8 + w;
        float hf[16];
        {
            const uint4 a = *(const uint4*)(hact + (size_t)tt * 1024 + lane * 16), b = *(const uint4*)(hact + (size_t)tt * 1024 + lane * 16 + 8);
            hf[0] = bflo(a.x); hf[1] = bfhi(a.x); hf[2] = bflo(a.y); hf[3] = bfhi(a.y); hf[4] = bflo(a.z); hf[5] = bfhi(a.z); hf[6] = bflo(a.w); hf[7] = bfhi(a.w);
            hf[8] = bflo(b.x); hf[9] = bfhi(b.x); hf[10] = bflo(b.y); hf[11] = bfhi(b.y); hf[12] = bflo(b.z); hf[13] = bfhi(b.z); hf[14] = bflo(b.w); hf[15] = bfhi(b.w);
        }
        const int e0 = eidx[(size_t)tt * 128 + lane], e1 = eidx[(size_t)tt * 128 + 64 + lane];
        const float g0 = gate[(size_t)tt * 128 + lane], g1v = gate[(size_t)tt * 128 + 64 + lane];
        float acc[16];
#pragma unroll
        for (int d = 0; d < 16; ++d) acc[d] = 0.f;
#pragma unroll 1
        for (int j0 = 0; j0 < 128; j0 += 8) {
            uint4 ur[8], vr[8]; float gt[8], d[8];
#pragma unroll
            for (int q = 0; q < 8; ++q) {
                const int j = j0 + q;
                const int e = __builtin_amdgcn_readlane(j0 < 64 ? e0 : e1, j & 63);
                const float gg = __builtin_bit_cast(float, __builtin_amdgcn_readlane(__builtin_bit_cast(int, j0 < 64 ? g0 : g1v), j & 63));
                ur[q] = *(const uint4*)(pu + (size_t)e * 1024 + lane * 16);
                vr[q] = *(const uint4*)(pv + (size_t)e * 1024 + lane * 16);
                d[q] = scu[e];
                gt[q] = gg * scv[e];
            }
#pragma unroll
            for (int q = 0; q < 8; ++q) d[q] *= dot16_fp8(hf, ur[q]);
            float r4[4], r2[2], r1;
#pragma unroll
            for (int i = 0; i < 4; ++i) { const float keep = hi32 ? d[2 * i + 1] : d[2 * i], send = hi32 ? d[2 * i] : d[2 * i + 1]; r4[i] = keep + __shfl_xor(send, 32); }
#pragma unroll
            for (int i = 0; i < 2; ++i) { const float keep = hi16 ? r4[2 * i + 1] : r4[2 * i], send = hi16 ? r4[2 * i] : r4[2 * i + 1]; r2[i] = keep + __shfl_xor(send, 16); }
            { const float keep = hi8 ? r2[1] : r2[0], send = hi8 ? r2[0] : r2[1]; r1 = keep + __shfl_xor(send, 8); }
            r1 += __shfl_xor(r1, 4); r1 += __shfl_xor(r1, 2); r1 += __shfl_xor(r1, 1);
            const int gl = __builtin_bit_cast(int, gelu_tanh(r1));
#pragma unroll
            for (int q = 0; q < 8; ++q) {
                const int srcl = (q & 1) * 32 + ((q >> 1) & 1) * 16 + ((q >> 2) & 1) * 8;
                const float a = __builtin_bit_cast(float, __builtin_amdgcn_readlane(gl, srcl)) * gt[q];
                axpy16_fp8(acc, a, vr[q]);
            }
        }
        float* xr = (tt < T) ? (p.out + (size_t)tt * 1024) : ((float*)(p.ws + OFF_XCTX) + (size_t)(tt - T) * 1024);
        const float* gr = g2 + (size_t)tok_modrow(tt) * 6144;
        float xv[16];
#pragma unroll
        for (int i = 0; i < 4; ++i) {
            const int k = lane * 16 + i * 4;
            const float4 x0 = *(const float4*)(xr + k), q0 = *(const float4*)(gr + k);
            xv[i * 4 + 0] = x0.x + q0.x * acc[i * 4 + 0]; xv[i * 4 + 1] = x0.y + q0.y * acc[i * 4 + 1];
            xv[i * 4 + 2] = x0.z + q0.z * acc[i * 4 + 2]; xv[i * 4 + 3] = x0.w + q0.w * acc[i * 4 + 3];
        }
        if (L == 1) {
            float ss = 0.f;
#pragma unroll
            for (int d = 0; d < 16; ++d) ss += xv[d] * xv[d];
            ss = wave_sum(ss);
            const float r = rsqrtf(ss * (1.0f / 1024.0f) + EPS);
#pragma unroll
            for (int i = 0; i < 4; ++i) {
                const float4 f0 = *(const float4*)(p.in[I_FING] + lane * 16 + i * 4);
                xv[i * 4 + 0] *= r * f0.x; xv[i * 4 + 1] *= r * f0.y; xv[i * 4 + 2] *= r * f0.z; xv[i * 4 + 3] *= r * f0.w;
            }
        }
#pragma unroll
        for (int i = 0; i < 4; ++i) *(float4*)(xr + lane * 16 + i * 4) = make_float4(xv[i * 4 + 0], xv[i * 4 + 1], xv[i * 4 + 2], xv[i * 4 + 3]);
    }
}

constexpr int N_PHASES = 1 + 2 * 13;

__device__ __forceinline__ void run_phase(const Params& p, int ph, unsigned char* smem) {
    if (ph == 0) { phase_prep(p, smem); return; }
    const int L = (ph - 1) / 13, s = (ph - 1) % 13;
    switch (s) {
        case 0: phase_A(p, L); break;
        case 1: phase_B(p, L, smem); break;
        case 2: phase_C(p, L, smem); break;
        case 3: phase_D(p, L, smem); break;
        case 4: phase_E(p, L); break;
        case 5: phase_F(p, L, smem); break;
        case 6: phase_G(p, L, smem); break;
        case 7: phase_H(p, L); break;
        case 8: phase_I(p, L, smem); break;
        case 9: norm_tokens(p, L, 1, (L == 0) ? TT : T, false, 0, ((L == 0) ? TT : T) / 8); break;
        case 10: phase_K(p, L, smem); break;
        case 11: phase_L(p, L); break;
        default: phase_M(p, L); break;
    }
}

__global__ void __launch_bounds__(NTHREADS) fwd_megakernel(Params p) {
    extern __shared__ __attribute__((aligned(16))) unsigned char smem[];
    cg::grid_group grid = cg::this_grid();
    for (int ph = p.ph_lo; ph < p.ph_hi; ++ph) {
        run_phase(p, ph, smem);
#if PROBE_MASK
        if (ph > 0 && ((PROBE_MASK >> ((ph - 1) % 13)) & 1) && !(((ph - 1) % 13) == 8 && ph > 13)) { grid.sync(); run_phase(p, ph, smem); }
#endif
        if (ph + 1 < p.ph_hi) grid.sync();
    }
}

extern "C" void kernel_launch(void* const* d_in, const int* in_sizes, int n_in, void* d_out, int out_size, void* d_ws, size_t ws_size,
                              hipStream_t stream) {
    static int grid_blocks = 0;
    if (grid_blocks == 0) {
        if (n_in != 27 || out_size != T * D || ws_size < WS_END) {
            fprintf(stderr, "kernel_launch: unexpected problem (n_in %d, out %d, ws %zu, need %zu)\n", n_in, out_size, ws_size, (size_t)WS_END);
            grid_blocks = -1; return;
        }
        int dev = 0, cus = 0, per_cu = 0;
        hipGetDevice(&dev);
        hipDeviceGetAttribute(&cus, hipDeviceAttributeMultiprocessorCount, dev);
        hipFuncSetAttribute((const void*)fwd_megakernel, hipFuncAttributeMaxDynamicSharedMemorySize, SMEM_BYTES);
        hipOccupancyMaxActiveBlocksPerMultiprocessor(&per_cu, (const void*)fwd_megakernel, NTHREADS, SMEM_BYTES);
        if (per_cu < 1) { fprintf(stderr, "kernel_launch: occupancy query returned %d\n", per_cu); per_cu = 1; }
        if (per_cu > 1) per_cu = 1;
        grid_blocks = cus * per_cu;
    }
    if (grid_blocks < 0) return;
    Params p{};
    for (int i = 0; i < 27; ++i) p.in[i] = (const float*)d_in[i];
    p.out = (float*)d_out; p.ws = (unsigned char*)d_ws;
#if SPLIT_LAUNCH
    for (int ph = 0; ph < N_PHASES; ++ph) {
        p.ph_lo = ph; p.ph_hi = ph + 1;
        void* args[] = {&p};
        hipError_t e = hipLaunchCooperativeKernel((const void*)fwd_megakernel, dim3(grid_blocks), dim3(NTHREADS), args, SMEM_BYTES, stream);
        if (e != hipSuccess) { fprintf(stderr, "launch failed: %s\n", hipGetErrorString(e)); return; }
    }
#else
    p.ph_lo = 0; p.ph_hi = N_PHASES;
    void* args[] = {&p};
    hipError_t e = hipLaunchCooperativeKernel((const void*)fwd_megakernel, dim3(grid_blocks), dim3(NTHREADS), args, SMEM_BYTES, stream);
    if (e != hipSuccess) fprintf(stderr, "cooperative launch failed: %s (grid %d)\n", hipGetErrorString(e), grid_blocks);
#endif
}
```

```cpp
#include <hip/hip_runtime.h>
#include <hip/hip_cooperative_groups.h>
#include <cstdio>
#include <cstdint>
namespace cg = cooperative_groups;

#define NTHREADS 512
#ifndef PROBE_MASK
#define PROBE_MASK 0
#endif
#ifndef SPLIT_LAUNCH
#define SPLIT_LAUNCH 0
#endif

typedef unsigned short bf16_t;
typedef __attribute__((ext_vector_type(8))) short bf16x8;
typedef __attribute__((ext_vector_type(4))) float f32x4;
typedef __attribute__((ext_vector_type(2))) __bf16 bf16x2_t;

constexpr int D = 1024, NB = 8, SEQ = 4096, T = NB * SEQ, CTXL = 256, TC = NB * CTXL, TT = T + TC;
constexpr int INW = 2048;
constexpr int NCHB = 136;
constexpr int NCH = NB * NCHB;
constexpr int NCHP = 1152;
constexpr int KV = 768;
constexpr float EPS = 1e-6f;

constexpr size_t al256(size_t x) { return (x + 255) & ~(size_t)255; }
constexpr size_t OFF_ACT = 0;                                   constexpr size_t SZ_ACT = (size_t)TT * 1024 * 2;
constexpr size_t OFF_XIN = al256(OFF_ACT + SZ_ACT);             constexpr size_t SZ_XIN = (size_t)TT * 2048 * 2;
constexpr size_t OFF_YMIX = al256(OFF_XIN + SZ_XIN);            constexpr size_t SZ_YMIX = (size_t)TT * 1024 * 2;
constexpr size_t OFF_XCTX = al256(OFF_YMIX + SZ_YMIX);          constexpr size_t SZ_XCTX = (size_t)TC * 1024 * 4;
constexpr size_t OFF_ZT = al256(OFF_XCTX + SZ_XCTX);            constexpr size_t SZ_ZT = (size_t)NB * 256 * 8192 * 2;
constexpr size_t OFF_ZTC = al256(OFF_ZT + SZ_ZT);               constexpr size_t SZ_ZTC = (size_t)NB * 256 * 512 * 2;
constexpr size_t OFF_VG = al256(OFF_ZTC + SZ_ZTC);              constexpr size_t SZ_VG = (size_t)16 * NCHP * KV * 2;
constexpr size_t OFF_SC = al256(OFF_VG + SZ_VG);                constexpr size_t SZ_SC = (size_t)16 * NCH * 256 * 4;
constexpr size_t OFF_GBUF = al256(OFF_SC + SZ_SC);              constexpr size_t SZ_GBUF = (size_t)TT * 256 * 2;
constexpr size_t OFF_DFTL = al256(OFF_GBUF + SZ_GBUF);          constexpr size_t SZ_DFTL = (size_t)4096 * 8192 * 2;
constexpr size_t OFF_DFTC = al256(OFF_DFTL + SZ_DFTL);          constexpr size_t SZ_DFTC = (size_t)256 * 512 * 2;
constexpr size_t OFF_DFTD = al256(OFF_DFTC + SZ_DFTC);          constexpr size_t SZ_DFTD = (size_t)128 * 64 * 2;
constexpr size_t SZ_WINT = (size_t)2048 * 1024 * 2, SZ_WOUTT = (size_t)1024 * 1024 * 2, SZ_WQKT = (size_t)2048 * 1024 * 2, SZ_WGLUT = (size_t)256 * 256 * 2;
constexpr size_t OFF_WINT = al256(OFF_DFTD + SZ_DFTD);
constexpr size_t OFF_WOUTT = al256(OFF_WINT + 2 * SZ_WINT);
constexpr size_t OFF_WQKT = al256(OFF_WOUTT + 2 * SZ_WOUTT);
constexpr size_t OFF_WGLUT = al256(OFF_WQKT + 2 * SZ_WQKT);
constexpr size_t OFF_WCOMB = al256(OFF_WGLUT + 2 * SZ_WGLUT);   constexpr size_t SZ_WCOMB = (size_t)16 * 512 * KV * 2;
constexpr size_t OFF_WST = al256(OFF_WCOMB + SZ_WCOMB);         constexpr size_t SZ_WST = (size_t)16 * 256 * 512 * 2;
constexpr size_t OFF_POWA = al256(OFF_WST + SZ_WST);            constexpr size_t SZ_POWA = (size_t)2 * 2 * 16 * 33 * 64 * 8;
constexpr size_t OFF_BBAR = al256(OFF_POWA + SZ_POWA);          constexpr size_t SZ_BBAR = (size_t)2 * 2 * 16 * 64 * 16 * 8;
constexpr size_t OFF_KTAU = al256(OFF_BBAR + SZ_BBAR);          constexpr size_t SZ_KTAU = (size_t)2 * 2 * 16 * 32 * 256 * 4;
constexpr size_t OFF_MOD = al256(OFF_KTAU + SZ_KTAU);           constexpr size_t SZ_MOD = (size_t)2 * 9 * 6144 * 4;
constexpr size_t OFF_VT = al256(OFF_MOD + SZ_MOD);              constexpr size_t SZ_VT = (size_t)NB * 256 * 4096 * 2;
constexpr size_t OFF_VTC = al256(OFF_VT + SZ_VT);               constexpr size_t SZ_VTC = (size_t)NB * 256 * 256 * 2;
constexpr size_t OFF_BAR = al256(OFF_VTC + SZ_VTC);              constexpr size_t SZ_BAR = (size_t)3456 * 4;
constexpr size_t WS_END = al256(OFF_BAR + SZ_BAR);
constexpr size_t OFF_PEERU = OFF_XIN;                            constexpr size_t SZ_PEERT = (size_t)16384 * 1024;
constexpr size_t OFF_PEERV = OFF_PEERU + SZ_PEERT;
constexpr size_t OFF_PSCU = OFF_PEERV + SZ_PEERT;                constexpr size_t SZ_PSC = (size_t)16384 * 4;
constexpr size_t OFF_PSCV = OFF_PSCU + SZ_PSC;
constexpr size_t OFF_CAND = OFF_PSCV + SZ_PSC;                   constexpr size_t SZ_CAND = (size_t)TT * 256 * 4;
constexpr size_t OFF_EIDX = OFF_CAND + SZ_CAND;                  constexpr size_t SZ_EIDX = (size_t)TT * 128 * 4;
constexpr size_t OFF_GATE = OFF_EIDX + SZ_EIDX;
static_assert(OFF_GATE + SZ_EIDX <= OFF_XIN + SZ_XIN, "PEER overlays must fit in the XIN region");

constexpr int SMEM_BYTES = 116736;

struct Params {
    const float* in[27];
    float* out;
    unsigned char* ws;
    int ph_lo, ph_hi;
};
enum { I_X = 0, I_C, I_CTX, I_CCTX, I_ADAW, I_ADAB, I_N1G, I_N2G, I_WIN, I_RPB, I_CONVW, I_ARE, I_AIM, I_BRE, I_BIM, I_CRE, I_CIM,
       I_LOGDT, I_S5D, I_WGLU, I_GRPG, I_WOUT, I_WQ, I_KEYS, I_PU, I_PV, I_FING };


__device__ __forceinline__ int tidx_l() { int t = threadIdx.x; asm volatile("" : "+v"(t)); return t; }
__device__ __forceinline__ int bidx_l() { int t = blockIdx.x; asm volatile("" : "+s"(t)); return t; }
#define TIDX (tidx_l())
#define BIDX (bidx_l())
__device__ __forceinline__ bf16_t f2bf(float f) { unsigned u = __float_as_uint(f); u += 0x7FFFu + ((u >> 16) & 1u); return (bf16_t)(u >> 16); }
__device__ __forceinline__ float bf2f(bf16_t h) { return __uint_as_float(((unsigned)h) << 16); }
__device__ __forceinline__ unsigned pack2(float a, float b) { return (unsigned)f2bf(a) | ((unsigned)f2bf(b) << 16); }
__device__ __forceinline__ float bflo(unsigned u) { return __uint_as_float(u << 16); }
__device__ __forceinline__ float bfhi(unsigned u) { return __uint_as_float(u & 0xffff0000u); }
__device__ __forceinline__ float dot2bf(unsigned a, unsigned b, float c) {
    return __builtin_amdgcn_fdot2_f32_bf16(__builtin_bit_cast(bf16x2_t, a), __builtin_bit_cast(bf16x2_t, b), c, false);
}
__device__ __forceinline__ float gelu_tanh(float x) {
    float z = 0.7978845608028654f * (x + 0.044715f * x * x * x);
    float e = __expf(2.0f * z);
    float th = 1.0f - 2.0f / (e + 1.0f);
    return 0.5f * x * (1.0f + th);
}
__device__ __forceinline__ float sigmoidf_(float x) { return 1.0f / (1.0f + __expf(-x)); }
__device__ __forceinline__ float wave_sum(float v) {
#pragma unroll
    for (int o = 32; o >= 1; o >>= 1) v += __shfl_xor(v, o);
    return v;
}
__device__ __forceinline__ int sortable(float v) { int b = __float_as_int(v); return b ^ ((b >> 31) & 0x7FFFFFFF); }
__device__ __forceinline__ float unsortable(int s) { return __int_as_float(s ^ ((s >> 31) & 0x7FFFFFFF)); }
__device__ __forceinline__ void top16_insert(int (&top)[16], int x) {
#pragma unroll
    for (int j = 0; j < 16; ++j) { int hi = max(top[j], x); x = min(top[j], x); top[j] = hi; }
}
__device__ __forceinline__ int tok_modrow(int tt) { return tt < T ? (tt >> 12) : 8; }

template <bool TO_LDS, typename FA, typename FB, typename FE>
__device__ __forceinline__ void gemm128(FA arow, FB brow, int K, FE epi, unsigned char* smem) {
    const int tid = TIDX, lane = tid & 63, w = tid >> 6;
    const int wm = w >> 2, wn = w & 3;
    const bf16_t* pa[2]; const bf16_t* pb[2]; int soff[2];
#pragma unroll
    for (int i = 0; i < 2; ++i) {
        int c = tid + 512 * i, row = c >> 3, kc = c & 7;
        pa[i] = arow(row) + kc * 8; pb[i] = brow(row) + kc * 8;
        soff[i] = row * 128 + ((kc ^ (row & 7)) << 4);
    }
    __syncthreads();
    f32x4 acc[4][2];
#pragma unroll
    for (int i = 0; i < 4; ++i)
#pragma unroll
        for (int j = 0; j < 2; ++j) acc[i][j] = f32x4{0.f, 0.f, 0.f, 0.f};
    uint4 ra[2], rb[2];
#pragma unroll
    for (int i = 0; i < 2; ++i) { ra[i] = *(const uint4*)pa[i]; rb[i] = *(const uint4*)pb[i]; }
#pragma unroll
    for (int i = 0; i < 2; ++i) { *(uint4*)(smem + soff[i]) = ra[i]; *(uint4*)(smem + 16384 + soff[i]) = rb[i]; }
    __syncthreads();
    const int nk = K >> 6;
    const int lr = lane & 15, lg = lane >> 4, sw = lane & 7;
    for (int kt = 0; kt < nk; ++kt) {
        const int cur = kt & 1;
        if (kt + 1 < nk) {
#pragma unroll
            for (int i = 0; i < 2; ++i) { ra[i] = *(const uint4*)(pa[i] + (kt + 1) * 64); rb[i] = *(const uint4*)(pb[i] + (kt + 1) * 64); }
        }
        const unsigned char* sA = smem + cur * 32768;
        const unsigned char* sB = sA + 16384;
#pragma unroll
        for (int ks = 0; ks < 2; ++ks) {
            bf16x8 af[4], bfv[2];
            const int choff = (((ks * 4 + lg) ^ sw) << 4);
#pragma unroll
            for (int fi = 0; fi < 4; ++fi) af[fi] = *(const bf16x8*)(sA + (wm * 64 + fi * 16 + lr) * 128 + choff);
#pragma unroll
            for (int fj = 0; fj < 2; ++fj) bfv[fj] = *(const bf16x8*)(sB + (wn * 32 + fj * 16 + lr) * 128 + choff);
#pragma unroll
            for (int fi = 0; fi < 4; ++fi)
#pragma unroll
                for (int fj = 0; fj < 2; ++fj) acc[fi][fj] = __builtin_amdgcn_mfma_f32_16x16x32_bf16(af[fi], bfv[fj], acc[fi][fj], 0, 0, 0);
        }
        if (kt + 1 < nk) {
            unsigned char* dA = smem + (cur ^ 1) * 32768;
#pragma unroll
            for (int i = 0; i < 2; ++i) { *(uint4*)(dA + soff[i]) = ra[i]; *(uint4*)(dA + 16384 + soff[i]) = rb[i]; }
        }
        __syncthreads();
    }
    if (TO_LDS) {
        float* tc = (float*)smem;
#pragma unroll
        for (int fi = 0; fi < 4; ++fi)
#pragma unroll
            for (int fj = 0; fj < 2; ++fj)
#pragma unroll
                for (int j = 0; j < 4; ++j) tc[(wm * 64 + fi * 16 + lg * 4 + j) * 129 + wn * 32 + fj * 16 + lr] = acc[fi][fj][j];
        __syncthreads();
    } else {
#pragma unroll
        for (int fi = 0; fi < 4; ++fi)
#pragma unroll
            for (int fj = 0; fj < 2; ++fj)
#pragma unroll
                for (int j = 0; j < 4; ++j) epi(wm * 64 + fi * 16 + lg * 4 + j, wn * 32 + fj * 16 + lr, acc[fi][fj][j]);
    }
}

__device__ void phase_prep(const Params& p, unsigned char* smem) {
    const int tid = TIDX, lane = tid & 63, w = tid >> 6;
    unsigned char* ws = p.ws;
    constexpr int N_MOD = 192, N_TR = 1568, N_WQK = 512, N_DFTL = 4096, N_DFTS = 1, N_S5T = 8;
    constexpr int O_TR = N_MOD, O_WQK = O_TR + N_TR, O_DFTL = O_WQK + N_WQK, O_DFTS = O_DFTL + N_DFTL, O_S5T = O_DFTS + N_DFTS, N_ALL = O_S5T + N_S5T;
    float* tab = (float*)(smem + 98304);
    for (int j = tid; j < 4096; j += NTHREADS) tab[j] = cospif((float)j * (1.0f / 2048.0f));
    __syncthreads();
    for (int it = BIDX; it < N_ALL; it += gridDim.x) {
        if (it < O_TR) {
            const int L = it / 96, c0 = (it % 96) * 64;
            float* sv = (float*)smem;
            float* red = (float*)(smem + 36864);
            for (int idx = tid; idx < 9 * 1024; idx += NTHREADS) {
                int r = idx >> 10, k = idx & 1023;
                float v = (r < 8) ? p.in[I_C][r * 1024 + k] : p.in[I_CCTX][k];
                sv[idx] = v / (1.0f + __expf(-v));
            }
            __syncthreads();
            float acc[9];
#pragma unroll
            for (int r = 0; r < 9; ++r) acc[r] = 0.f;
            const float* aw = p.in[I_ADAW] + (size_t)L * 1024 * 6144 + c0 + lane;
            for (int k = w * 128; k < w * 128 + 128; ++k) {
                float wv = aw[(size_t)k * 6144];
#pragma unroll
                for (int r = 0; r < 9; ++r) acc[r] += sv[r * 1024 + k] * wv;
            }
#pragma unroll
            for (int r = 0; r < 9; ++r) red[(w * 9 + r) * 64 + lane] = acc[r];
            __syncthreads();
            for (int o = tid; o < 576; o += NTHREADS) {
                int r = o >> 6, col = o & 63;
                float s = 0.f;
#pragma unroll
                for (int ww = 0; ww < 8; ++ww) s += red[(ww * 9 + r) * 64 + col];
                ((float*)(ws + OFF_MOD))[(size_t)(L * 9 + r) * 6144 + c0 + col] = s + p.in[I_ADAB][L * 6144 + c0 + col];
            }
            __syncthreads();
        } else if (it < O_WQK) {
            int idx = it - O_TR;
            const int L = idx / 784; int rem = idx % 784;
            const float* src; bf16_t* dst; int Kd, Nd, tk, tn;
            if (rem < 512) { tk = rem >> 5; tn = rem & 31; Kd = 1024; Nd = 2048; src = p.in[I_WIN] + (size_t)L * 1024 * 2048; dst = (bf16_t*)(ws + OFF_WINT + L * SZ_WINT); }
            else if (rem < 768) { rem -= 512; tk = rem >> 4; tn = rem & 15; Kd = 1024; Nd = 1024; src = p.in[I_WOUT] + (size_t)L * 1024 * 1024; dst = (bf16_t*)(ws + OFF_WOUTT + L * SZ_WOUTT); }
            else { rem -= 768; tk = rem >> 2; tn = rem & 3; Kd = 256; Nd = 256; src = p.in[I_WGLU] + (size_t)L * 256 * 256; dst = (bf16_t*)(ws + OFF_WGLUT + L * SZ_WGLUT); }
            float* tl = (float*)smem;
#pragma unroll
            for (int i = 0; i < 8; ++i) { int kk = i * 8 + w, nn = lane; tl[kk * 65 + nn] = src[(size_t)(tk * 64 + kk) * Nd + tn * 64 + nn]; }
            __syncthreads();
#pragma unroll
            for (int i = 0; i < 8; ++i) { int nn = i * 8 + w, kk = lane; dst[(size_t)(tn * 64 + nn) * Kd + tk * 64 + kk] = f2bf(tl[kk * 65 + nn]); }
            __syncthreads();
        } else if (it < O_DFTL) {
            int idx = it - O_WQK;
            const int L = idx >> 8, hz = (idx >> 4) & 15, kb = idx & 15;
            const int kk = kb * 64 + lane;
            const float* wqrow = p.in[I_WQ] + (size_t)L * 1024 * 2048 + (size_t)kk * 2048 + hz * 128;
            const float* keys = p.in[I_KEYS] + ((size_t)(L * 16 + hz) * 128 + w * 16) * 128;
            float acc[16];
#pragma unroll
            for (int j = 0; j < 16; ++j) acc[j] = 0.f;
            for (int d4 = 0; d4 < 32; ++d4) {
                float4 wv = *(const float4*)(wqrow + d4 * 4);
#pragma unroll
                for (int j = 0; j < 16; ++j) {
                    float4 kv = *(const float4*)(keys + j * 128 + d4 * 4);
                    acc[j] += wv.x * kv.x + wv.y * kv.y + wv.z * kv.z + wv.w * kv.w;
                }
            }
            bf16_t* dst = (bf16_t*)(ws + OFF_WQKT + L * SZ_WQKT);
#pragma unroll
            for (int j = 0; j < 16; ++j) dst[(size_t)(hz * 128 + w * 16 + j) * 1024 + kk] = f2bf(acc[j]);
        } else if (it < O_DFTS) {
            const int k = it - O_DFTL;
            bf16_t* dst = (bf16_t*)(ws + OFF_DFTL) + (size_t)k * 8192;
#pragma unroll
            for (int i = 0; i < 2; ++i) {
                int c = tid + 512 * i, part = c >> 9, l0 = (c & 511) * 8;
                unsigned pk[4];
#pragma unroll
                for (int e = 0; e < 4; ++e) {
                    int i0 = ((k * (l0 + 2 * e)) + part * 1024) & 4095, i1 = ((k * (l0 + 2 * e + 1)) + part * 1024) & 4095;
                    pk[e] = pack2(tab[i0] * (1.0f / 512.0f), tab[i1] * (1.0f / 512.0f));
                }
                *(uint4*)(dst + part * 4096 + l0) = make_uint4(pk[0], pk[1], pk[2], pk[3]);
            }
        } else if (it < O_S5T) {
            bf16_t* dc = (bf16_t*)(ws + OFF_DFTC);
            for (int c = tid; c < 16384; c += NTHREADS) {
                int k = c >> 6, cc = c & 63, part = cc >> 5, l0 = (cc & 31) * 8;
                unsigned pk[4];
#pragma unroll
                for (int e = 0; e < 4; ++e) {
                    int i0 = ((((k * (l0 + 2 * e)) & 255) << 4) + part * 1024) & 4095, i1 = ((((k * (l0 + 2 * e + 1)) & 255) << 4) + part * 1024) & 4095;
                    pk[e] = pack2(tab[i0] * (1.0f / 128.0f), tab[i1] * (1.0f / 128.0f));
                }
                *(uint4*)(dc + (size_t)k * 512 + part * 256 + l0) = make_uint4(pk[0], pk[1], pk[2], pk[3]);
            }
            bf16_t* dd = (bf16_t*)(ws + OFF_DFTD);
            for (int c = tid; c < 1024; c += NTHREADS) {
                int m = c >> 3, d0 = (c & 7) * 8, kd = m & 63, sh = (m >= 64) ? 3072 : 0;
                unsigned pk[4];
#pragma unroll
                for (int e = 0; e < 4; ++e) {
                    int i0 = ((((kd * (d0 + 2 * e)) & 63) << 6) + sh) & 4095, i1 = ((((kd * (d0 + 2 * e + 1)) & 63) << 6) + sh) & 4095;
                    pk[e] = pack2(tab[i0], tab[i1]);
                }
                *(uint4*)(dd + m * 64 + d0) = make_uint4(pk[0], pk[1], pk[2], pk[3]);
            }
        } else {
            const int gid = (it - O_S5T) * NTHREADS + tid;
            const int ia = gid;
            const float are = p.in[I_ARE][ia], aim = p.in[I_AIM][ia];
            const float dt = expf(p.in[I_LOGDT][ia >> 6]);
            float2* pw = (float2*)(ws + OFF_POWA) + (size_t)(ia >> 6) * 33 * 64 + (ia & 63);
            float abr = 1.f, abi = 0.f;
            for (int tau = 0; tau <= 32; ++tau) {
                float mag = expf(are * dt * (float)tau), s, c;
                sincosf(aim * dt * (float)tau, &s, &c);
                pw[tau * 64] = make_float2(mag * c, mag * s);
                if (tau == 1) { abr = mag * c; abi = mag * s; }
            }
            const float nr = abr - 1.0f, ni = abi, den = are * are + aim * aim;
            const float qr = (nr * are + ni * aim) / den, qi = (ni * are - nr * aim) / den;
            float2* bb = (float2*)(ws + OFF_BBAR) + (size_t)ia * 16;
#pragma unroll
            for (int h = 0; h < 16; ++h) {
                float br = p.in[I_BRE][(size_t)ia * 16 + h], bi = p.in[I_BIM][(size_t)ia * 16 + h];
                bb[h] = make_float2(qr * br - qi * bi, qr * bi + qi * br);
            }
        }
    }
}

__device__ void norm_tokens(const Params& p, int L, int which, int ntok, bool from_input, int item0, int nitems_total) {
    const int tid = TIDX, lane = tid & 63, w = tid >> 6;
    const float* modL = (const float*)(p.ws + OFF_MOD) + (size_t)L * 9 * 6144;
    const float* gvec = p.in[which ? I_N2G : I_N1G] + L * 1024;
    bf16_t* dst = (bf16_t*)(p.ws + OFF_ACT);
    for (int it = item0 + BIDX; it < nitems_total; it += gridDim.x) {
        if (it < item0) continue;
        const int tt = (it - item0) * 8 + w;
        if (tt >= ntok) continue;
        const float* src;
        if (tt < T) src = (from_input ? p.in[I_X] : p.out) + (size_t)tt * 1024;
        else src = (from_input ? p.in[I_CTX] : (const float*)(p.ws + OFF_XCTX)) + (size_t)(tt - T) * 1024;
        const float* sh = modL + (size_t)tok_modrow(tt) * 6144 + (which ? 3072 : 0);
        const float* sc = sh + 1024;
        float4 v[4]; float ss = 0.f;
#pragma unroll
        for (int i = 0; i < 4; ++i) { v[i] = *(const float4*)(src + (i * 64 + lane) * 4); ss += v[i].x * v[i].x + v[i].y * v[i].y + v[i].z * v[i].z + v[i].w * v[i].w; }
        ss = wave_sum(ss);
        const float r = rsqrtf(ss * (1.0f / 1024.0f) + EPS);
#pragma unroll
        for (int i = 0; i < 4; ++i) {
            const int k = (i * 64 + lane) * 4;
            float4 g = *(const float4*)(gvec + k), a = *(const float4*)(sc + k), b = *(const float4*)(sh + k);
            float o0 = v[i].x * r * g.x * (1.f + a.x) + b.x, o1 = v[i].y * r * g.y * (1.f + a.y) + b.y;
            float o2 = v[i].z * r * g.z * (1.f + a.z) + b.z, o3 = v[i].w * r * g.w * (1.f + a.w) + b.w;
            *(uint2*)(dst + (size_t)tt * 1024 + k) = make_uint2(pack2(o0, o1), pack2(o2, o3));
        }
    }
}

__device__ void phase_A(const Params& p, int L) {
    const int n_norm = TT / 8;
    const int n_kt = (L == 0) ? 1024 : 0;
    for (int it = BIDX; it < n_kt; it += gridDim.x) {
        const int gid = it * NTHREADS + TIDX;
        const int hp = gid & 15, h = (gid >> 4) & 15, tau = (gid >> 8) & 31, ldg = gid >> 13;
        const float* cre = p.in[I_CRE] + ((size_t)ldg * 16 + h) * 64;
        const float* cim = p.in[I_CIM] + ((size_t)ldg * 16 + h) * 64;
        const float2* pw = (const float2*)(p.ws + OFF_POWA) + ((size_t)ldg * 33 + tau) * 64;
        const float2* bb = (const float2*)(p.ws + OFF_BBAR) + (size_t)ldg * 64 * 16 + hp;
        float acc = 0.f;
        for (int q = 0; q < 64; ++q) {
            float2 a = pw[q], b = bb[q * 16];
            float cr = cre[q], ci = cim[q];
            float wr = cr * a.x - ci * a.y, wi = cr * a.y + ci * a.x;
            acc += wr * b.x - wi * b.y;
        }
        ((float*)(p.ws + OFF_KTAU))[gid] = acc;
    }
    norm_tokens(p, L, 0, TT, L == 0, n_kt, n_kt + n_norm);
}

__device__ void phase_B(const Params& p, int L, unsigned char* smem) {
    unsigned char* ws = p.ws;
    constexpr int N_G = (TT / 128) * 16, N_WC = 1536, N_WS = 512;
    const bf16_t* A = (const bf16_t*)(ws + OFF_ACT);
    const bf16_t* Bt = (const bf16_t*)(ws + OFF_WINT + L * SZ_WINT);
    bf16_t* xin = (bf16_t*)(ws + OFF_XIN);
    for (int it = BIDX; it < N_G + N_WC + N_WS; it += gridDim.x) {
        if (it < N_G) {
            const int mt = it >> 4, nt = it & 15;
            if (nt == 4 || nt == 5) {
                bf16_t* vt = (bf16_t*)(ws + OFF_VT); bf16_t* vtc = (bf16_t*)(ws + OFF_VTC);
                const int tok0 = mt * 128;
                bf16_t* base; int stride;
                if (tok0 < T) { base = vt + (size_t)((tok0 >> 12) * 256) * 4096 + (tok0 & 4095); stride = 4096; }
                else { const int c = tok0 - T; base = vtc + (size_t)((c >> 8) * 256) * 256 + (c & 255); stride = 256; }
                gemm128<false>([&](int r) { return Bt + (size_t)(nt * 128 + r) * 1024; },
                               [&](int r) { return A + (size_t)(mt * 128 + r) * 1024; }, 1024,
                               [&](int m, int n, float v) { base[(size_t)((nt - 4) * 128 + m) * stride + n] = f2bf(v); }, smem);
            } else {
                gemm128<false>([&](int r) { return A + (size_t)(mt * 128 + r) * 1024; },
                               [&](int r) { return Bt + (size_t)(nt * 128 + r) * 1024; }, 1024,
                               [&](int m, int n, float v) { xin[(size_t)(mt * 128 + m) * 2048 + nt * 128 + n] = f2bf(v); }, smem);
            }
        } else if (it < N_G + N_WC) {
            const int cid = (it - N_G) * NTHREADS + TIDX;
            const int kc = cid % 96, m = (cid / 96) & 511, g = cid / (96 * 512);
            const int i = m >> 4, h = m & 15;
            float vals[8];
            if (kc < 32) {
                const int dr = kc >> 4, ri = (kc >> 3) & 1, p0 = (kc & 7) * 8;
                const int ldg = (L * 2 + dr) * 16 + g;
                const int e = dr == 0 ? (i + 1) : (32 - i);
                const float2* pw = (const float2*)(ws + OFF_POWA) + ((size_t)ldg * 33 + e) * 64 + p0;
                const float* cre = p.in[I_CRE] + ((size_t)ldg * 16 + h) * 64 + p0;
                const float* cim = p.in[I_CIM] + ((size_t)ldg * 16 + h) * 64 + p0;
#pragma unroll
                for (int q = 0; q < 8; ++q) {
                    float2 a = pw[q]; float cr = cre[q], ci = cim[q];
                    float wr = cr * a.x - ci * a.y, wi = cr * a.y + ci * a.x;
                    vals[q] = ri == 0 ? wr : -wi;
                }
            } else {
                const int kk = (kc - 32) * 8, j = kk >> 4, h0 = kk & 15;
                const float* kf = (const float*)(ws + OFF_KTAU) + (size_t)((L * 2 + 0) * 16 + g) * 32 * 256;
                const float* kb = (const float*)(ws + OFF_KTAU) + (size_t)((L * 2 + 1) * 16 + g) * 32 * 256;
#pragma unroll
                for (int q = 0; q < 8; ++q) {
                    float v = 0.f;
                    if (j <= i) v += kf[((i - j) * 16 + h) * 16 + h0 + q];
                    if (j >= i) v += kb[((j - i) * 16 + h) * 16 + h0 + q];
                    vals[q] = v;
                }
            }
            bf16_t* dst = (bf16_t*)(ws + OFF_WCOMB) + ((size_t)g * 512 + m) * KV + kc * 8;
            *(uint4*)dst = make_uint4(pack2(vals[0], vals[1]), pack2(vals[2], vals[3]), pack2(vals[4], vals[5]), pack2(vals[6], vals[7]));
        } else {
            const int cid = (it - N_G - N_WC) * NTHREADS + TIDX;
            const int kc = cid & 63, m = (cid >> 6) & 255, g = cid >> 14;
            const int dr = m >> 7, ri = (m >> 6) & 1, pp = m & 63;
            const int j = kc >> 1, h0 = (kc & 1) * 8;
            const int ldg = (L * 2 + dr) * 16 + g;
            const int e = dr == 0 ? (31 - j) : j;
            const float2 a = ((const float2*)(ws + OFF_POWA))[((size_t)ldg * 33 + e) * 64 + pp];
            const float2* bb = (const float2*)(ws + OFF_BBAR) + ((size_t)ldg * 64 + pp) * 16 + h0;
            float vals[8];
#pragma unroll
            for (int q = 0; q < 8; ++q) { float2 b = bb[q]; vals[q] = ri == 0 ? (a.x * b.x - a.y * b.y) : (a.x * b.y + a.y * b.x); }
            bf16_t* dst = (bf16_t*)(ws + OFF_WST) + ((size_t)g * 256 + m) * 512 + kc * 8;
            *(uint4*)dst = make_uint4(pack2(vals[0], vals[1]), pack2(vals[2], vals[3]), pack2(vals[4], vals[5]), pack2(vals[6], vals[7]));
        }
    }
}

struct AttnStep { bf16x8 kf[2][2]; uint2 vf[4][2]; };

__device__ __forceinline__ void attn_mfma_item(const Params& p, int L, int item, const float* rpb_lds) {
    const int lane = TIDX & 63, lr = lane & 15, g = lane >> 4;
    const bf16_t* xin = (const bf16_t*)(p.ws + OFF_XIN);
    bf16_t* ymix = (bf16_t*)(p.ws + OFF_YMIX);
    int b, h, r = 0, c0 = 0, qtok, ncb = 0, cb0 = 0;
    const bool lat = item < 8192;
    if (lat) { const int qt = item & 3; h = (item >> 2) & 3; r = (item >> 4) & 63; b = item >> 10; c0 = qt * 16; qtok = b * 4096 + r * 64 + c0 + lr;
               ncb = (qt == 0 || qt == 3) ? 1 : 2; cb0 = (qt == 3) ? 1 : 0; }
    else { const int q = item - 8192; h = (q >> 4) & 3; b = q >> 6; qtok = T + b * 256 + (q & 15) * 16 + lr; }
    const int nsteps = 8 + 8 * ncb;
    bf16x8 qf[2];
#pragma unroll
    for (int ks = 0; ks < 2; ++ks) qf[ks] = *(const bf16x8*)(xin + (size_t)qtok * 2048 + h * 64 + ks * 32 + g * 8);
    const bf16_t* kctx = xin + (size_t)(T + b * 256) * 2048 + 256 + h * 64;
    const bf16_t* klat = xin + (size_t)(b * 4096) * 2048 + 256 + h * 64;
    const bf16_t* vtc = (const bf16_t*)(p.ws + OFF_VTC) + (size_t)((b * 4 + h) * 64) * 256;
    const bf16_t* vtl = (const bf16_t*)(p.ws + OFF_VT) + (size_t)((b * 4 + h) * 64) * 4096;
    const int rs = min(max(r - 4, 0), 56);
    const int cq = c0 + lr, cs = min(max(cq - 8, 0), 48);
    const float* rpbh = rpb_lds + h * 465;
    f32x4 o[4];
#pragma unroll
    for (int dt = 0; dt < 4; ++dt) o[dt] = f32x4{0.f, 0.f, 0.f, 0.f};
    float mrun = -3.0e38f, lsum = 0.f;

    auto load_step = [&](int s, AttnStep& st) {
        const bf16_t* kb; const bf16_t* vb; int vstride;
        if (s < 8) { kb = kctx + (size_t)(s * 32) * 2048; vb = vtc + s * 32; vstride = 256; }
        else {
            const int s2 = s - 8, kr = (ncb == 2) ? (s2 >> 1) : s2, cb = cb0 + ((ncb == 2) ? (s2 & 1) : 0);
            const int key0 = (rs + kr) * 64 + cb * 32;
            kb = klat + (size_t)key0 * 2048; vb = vtl + key0; vstride = 4096;
        }
#pragma unroll
        for (int t = 0; t < 2; ++t)
#pragma unroll
            for (int ks = 0; ks < 2; ++ks) st.kf[t][ks] = *(const bf16x8*)(kb + (size_t)(t * 16 + lr) * 2048 + ks * 32 + g * 8);
#pragma unroll
        for (int dt = 0; dt < 4; ++dt) {
            const bf16_t* vr = vb + (size_t)(dt * 16 + lr) * vstride + 4 * g;
            st.vf[dt][0] = *(const uint2*)vr; st.vf[dt][1] = *(const uint2*)(vr + 16);
        }
    };
    auto compute_step = [&](int s, const AttnStep& st) {
        f32x4 sa[2];
#pragma unroll
        for (int t = 0; t < 2; ++t) {
            sa[t] = f32x4{0.f, 0.f, 0.f, 0.f};
#pragma unroll
            for (int ks = 0; ks < 2; ++ks) sa[t] = __builtin_amdgcn_mfma_f32_16x16x32_bf16(st.kf[t][ks], qf[ks], sa[t], 0, 0, 0);
        }
        float sc[8];
#pragma unroll
        for (int t = 0; t < 2; ++t)
#pragma unroll
            for (int j = 0; j < 4; ++j) sc[t * 4 + j] = sa[t][j] * 0.125f;
        if (s >= 8) {
            const int s2 = s - 8, kr = (ncb == 2) ? (s2 >> 1) : s2, cb = cb0 + ((ncb == 2) ? (s2 & 1) : 0);
            const float* rp = rpbh + (rs + kr - r + 7) * 31 + 15 - cq;
#pragma unroll
            for (int t = 0; t < 2; ++t)
#pragma unroll
                for (int j = 0; j < 4; ++j) {
                    const int kc = cb * 32 + t * 16 + 4 * g + j;
                    const bool valid = (kc >= cs) && (kc < cs + 16);
                    const float bias = rp[valid ? kc : cq];
                    sc[t * 4 + j] = valid ? (sc[t * 4 + j] + bias) : -1.0e30f;
                }
        }
        float bm = fmaxf(fmaxf(fmaxf(sc[0], sc[1]), fmaxf(sc[2], sc[3])), fmaxf(fmaxf(sc[4], sc[5]), fmaxf(sc[6], sc[7])));
        bm = fmaxf(bm, __shfl_xor(bm, 16)); bm = fmaxf(bm, __shfl_xor(bm, 32));
        const float mn = fmaxf(mrun, bm);
        const float corr = __expf(mrun - mn);
        mrun = mn; lsum *= corr;
#pragma unroll
        for (int dt = 0; dt < 4; ++dt) { o[dt][0] *= corr; o[dt][1] *= corr; o[dt][2] *= corr; o[dt][3] *= corr; }
        float pr[8];
#pragma unroll
        for (int i = 0; i < 8; ++i) { pr[i] = __expf(sc[i] - mn); lsum += pr[i]; }
        const uint4 pbu = make_uint4(pack2(pr[0], pr[1]), pack2(pr[2], pr[3]), pack2(pr[4], pr[5]), pack2(pr[6], pr[7]));
        const bf16x8 pb = __builtin_bit_cast(bf16x8, pbu);
#pragma unroll
        for (int dt = 0; dt < 4; ++dt) {
            const uint4 vu = make_uint4(st.vf[dt][0].x, st.vf[dt][0].y, st.vf[dt][1].x, st.vf[dt][1].y);
            o[dt] = __builtin_amdgcn_mfma_f32_16x16x32_bf16(__builtin_bit_cast(bf16x8, vu), pb, o[dt], 0, 0, 0);
        }
    };

    AttnStep sA, sB;
    load_step(0, sA);
#pragma unroll 1
    for (int s = 0; s < nsteps; s += 2) {
        load_step(s + 1, sB);
        compute_step(s, sA);
        if (s + 2 < nsteps) load_step(s + 2, sA);
        compute_step(s + 1, sB);
    }
    lsum += __shfl_xor(lsum, 16); lsum += __shfl_xor(lsum, 32);
    const float inv = 1.0f / lsum;
#pragma unroll
    for (int dt = 0; dt < 4; ++dt)
        *(uint2*)(ymix + (size_t)qtok * 1024 + h * 64 + dt * 16 + 4 * g) = make_uint2(pack2(o[dt][0] * inv, o[dt][1] * inv), pack2(o[dt][2] * inv, o[dt][3] * inv));
}

__device__ void phase_C(const Params& p, int L, unsigned char* smem) {
    unsigned char* ws = p.ws;
    const int tid = TIDX, w = tid >> 6;
    const bf16_t* xin = (const bf16_t*)(ws + OFF_XIN);
    bf16_t* ymix = (bf16_t*)(ws + OFF_YMIX);
    const int n_attn_w = (L == 0) ? 8192 + 512 : 8192;
    float* rpb_lds = (float*)(smem + 70016);
    for (int i = tid; i < 4 * 465; i += NTHREADS) rpb_lds[i] = p.in[I_RPB][(size_t)L * 4 * 465 + i];
    __syncthreads();
    const int N_ATT = (n_attn_w + 7) / 8;
    const int N_F1 = 1024 + ((L == 0) ? 64 : 0);
    const int N_CONV = TT * 32 / NTHREADS;
    const int N_S1 = TT * 16 / NTHREADS;
    const int O_F1 = N_ATT, O_CONV = O_F1 + N_F1, O_S1 = O_CONV + N_CONV, N_ALL = O_S1 + N_S1;
    for (int it = BIDX; it < N_ALL; it += gridDim.x) {
        if (it < O_F1) {
            const int item = it * 8 + w;
            if (item < n_attn_w) attn_mfma_item(p, L, item, rpb_lds);
        } else if (it < O_CONV) {
            int idx = it - O_F1;
            const bf16_t* dd = (const bf16_t*)(ws + OFF_DFTD);
            if (idx < 1024) {
                const int b = idx >> 7, h = (idx >> 5) & 3, nt = idx & 31;
                bf16_t* zt = (bf16_t*)(ws + OFF_ZT);
                gemm128<false>([&](int r) { return dd + r * 64; },
                               [&](int r) { return xin + (size_t)(b * 4096 + nt * 128 + r) * 2048 + 1536 + h * 64; }, 64,
                               [&](int m, int n, float v) { zt[((size_t)(b * 256 + h * 64 + (m & 63)) * 2 + (m >> 6)) * 4096 + nt * 128 + n] = f2bf(v); }, smem);
            } else {
                idx -= 1024;
                const int b = idx >> 3, h = (idx >> 1) & 3, nt = idx & 1;
                bf16_t* zt = (bf16_t*)(ws + OFF_ZTC);
                gemm128<false>([&](int r) { return dd + r * 64; },
                               [&](int r) { return xin + (size_t)(T + b * 256 + nt * 128 + r) * 2048 + 1536 + h * 64; }, 64,
                               [&](int m, int n, float v) { zt[((size_t)(b * 256 + h * 64 + (m & 63)) * 2 + (m >> 6)) * 256 + nt * 128 + n] = f2bf(v); }, smem);
            }
        } else if (it < O_S1) {
            const int gid = (it - O_CONV) * NTHREADS + tid;
            const int tt = gid >> 5, ch0 = (gid & 31) * 8;
            bool first, last;
            if (tt < T) { int l = tt & 4095; first = l == 0; last = l == 4095; } else { int j = (tt - T) & 255; first = j == 0; last = j == 255; }
            const bf16_t* row = xin + (size_t)tt * 2048;
            const uint4 cb = *(const uint4*)(row + 768 + ch0), cc = *(const uint4*)(row + 1024 + ch0), cx = *(const uint4*)(row + 1280 + ch0);
            uint4 ccp = make_uint4(0, 0, 0, 0), cxp = ccp, ccn = ccp, cxn = ccp;
            if (!first) { ccp = *(const uint4*)(row - 2048 + 1024 + ch0); cxp = *(const uint4*)(row - 2048 + 1280 + ch0); }
            if (!last) { ccn = *(const uint4*)(row + 2048 + 1024 + ch0); cxn = *(const uint4*)(row + 2048 + 1280 + ch0); }
            const float* cw = p.in[I_CONVW] + (size_t)L * 3 * 256 + ch0;
            const unsigned cbv[4] = {cb.x, cb.y, cb.z, cb.w}, ccv[4] = {cc.x, cc.y, cc.z, cc.w}, cxv[4] = {cx.x, cx.y, cx.z, cx.w};
            const unsigned cpv[4] = {ccp.x, ccp.y, ccp.z, ccp.w}, xpv[4] = {cxp.x, cxp.y, cxp.z, cxp.w};
            const unsigned cnv[4] = {ccn.x, ccn.y, ccn.z, ccn.w}, xnv[4] = {cxn.x, cxn.y, cxn.z, cxn.w};
            unsigned o[4];
#pragma unroll
            for (int e = 0; e < 4; ++e) {
                float w0a = cw[2 * e], w0b = cw[2 * e + 1], w1a = cw[256 + 2 * e], w1b = cw[256 + 2 * e + 1], w2a = cw[512 + 2 * e], w2b = cw[512 + 2 * e + 1];
                float za = w0a * bflo(cpv[e]) * bflo(xpv[e]) + w1a * bflo(ccv[e]) * bflo(cxv[e]) + w2a * bflo(cnv[e]) * bflo(xnv[e]);
                float zb = w0b * bfhi(cpv[e]) * bfhi(xpv[e]) + w1b * bfhi(ccv[e]) * bfhi(cxv[e]) + w2b * bfhi(cnv[e]) * bfhi(xnv[e]);
                o[e] = pack2(bflo(cbv[e]) * za, bfhi(cbv[e]) * zb);
            }
            *(uint4*)(ymix + (size_t)tt * 1024 + 256 + ch0) = make_uint4(o[0], o[1], o[2], o[3]);
        } else {
            const int gid = (it - O_S1) * NTHREADS + tid;
            const int tt = gid >> 4, g = gid & 15;
            int n, j;
            if (tt < T) { int b = tt >> 12, l = tt & 4095; n = b * NCHB + 8 + (l >> 5); j = l & 31; }
            else { int c = tt - T; int b = c >> 8; n = b * NCHB + ((c & 255) >> 5); j = c & 31; }
            const uint4* src = (const uint4*)(xin + (size_t)tt * 2048 + 1792 + g * 16);
            uint4* dst = (uint4*)((bf16_t*)(ws + OFF_VG) + ((size_t)g * NCHP + n) * KV + 256 + j * 16);
            dst[0] = src[0]; dst[1] = src[1];
        }
    }
}

__device__ void phase_D(const Params& p, int L, unsigned char* smem) {
    unsigned char* ws = p.ws;
    bf16_t* ymix = (bf16_t*)(ws + OFF_YMIX);
    const int N_F2 = 512, N_F2C = (L == 0) ? 32 : 0, N_S2 = 288;
    const int O_F2C = N_F2, O_S2 = O_F2C + N_F2C, N_ALL = O_S2 + N_S2;
    for (int it = BIDX; it < N_ALL; it += gridDim.x) {
        if (it < O_F2C) {
            const int b = it >> 6, mt = (it >> 1) & 31, nt = it & 1;
            const bf16_t* dl = (const bf16_t*)(ws + OFF_DFTL);
            const bf16_t* zt = (const bf16_t*)(ws + OFF_ZT);
            gemm128<false>([&](int r) { return dl + (size_t)(mt * 128 + r) * 8192; },
                           [&](int r) { return zt + (size_t)(b * 256 + nt * 128 + r) * 8192; }, 8192,
                           [&](int m, int n, float v) { ymix[(size_t)(b * 4096 + mt * 128 + m) * 1024 + 512 + nt * 128 + n] = f2bf(v); }, smem);
        } else if (it < O_S2) {
            const int idx = it - O_F2C;
            const int b = idx >> 2, mt = (idx >> 1) & 1, nt = idx & 1;
            const bf16_t* dc = (const bf16_t*)(ws + OFF_DFTC);
            const bf16_t* zt = (const bf16_t*)(ws + OFF_ZTC);
            gemm128<false>([&](int r) { return dc + (size_t)(mt * 128 + r) * 512; },
                           [&](int r) { return zt + (size_t)(b * 256 + nt * 128 + r) * 512; }, 512,
                           [&](int m, int n, float v) { ymix[(size_t)(T + b * 256 + mt * 128 + m) * 1024 + 512 + nt * 128 + n] = f2bf(v); }, smem);
        } else {
            const int idx = it - O_S2;
            const int g = idx / 18, rem = idx % 18, mt = rem / 9, nt = rem % 9;
            const bf16_t* wst = (const bf16_t*)(ws + OFF_WST) + (size_t)g * 256 * 512;
            const bf16_t* vg = (const bf16_t*)(ws + OFF_VG) + (size_t)g * NCHP * KV;
            float* sc = (float*)(ws + OFF_SC) + (size_t)g * NCH * 256;
            gemm128<false>([&](int r) { return wst + (size_t)(mt * 128 + r) * 512; },
                           [&](int r) { return vg + (size_t)(nt * 128 + r) * KV + 256; }, 512,
                           [&](int m, int n, float v) { int nn = nt * 128 + n; if (nn < NCH) sc[(size_t)nn * 256 + mt * 128 + m] = v; }, smem);
        }
    }
}

__device__ void phase_E(const Params& p, int L) {
    unsigned char* ws = p.ws;
    for (int it = BIDX; it < 32; it += gridDim.x) {
        const int gid = it * NTHREADS + TIDX;
        const int b = gid >> 11, g = (gid >> 7) & 15, dr = (gid >> 6) & 1, pp = gid & 63;
        const float2 a32 = ((const float2*)(ws + OFF_POWA))[((size_t)((L * 2 + dr) * 16 + g) * 33 + 32) * 64 + pp];
        bf16_t* vg = (bf16_t*)(ws + OFF_VG) + (size_t)g * NCHP * KV + dr * 128 + pp;
        const float* sc = (const float*)(ws + OFF_SC) + (size_t)g * NCH * 256 + dr * 128 + pp;
        float hr = 0.f, hi = 0.f;
        for (int s0 = 0; s0 < NCHB; s0 += 8) {
            float sr[8], si[8]; int nn[8];
#pragma unroll
            for (int q = 0; q < 8; ++q) {
                const int s = s0 + q;
                const int cidx = dr == 0 ? s : (s < 8 ? 7 - s : NCHB - 1 - (s - 8));
                nn[q] = b * NCHB + cidx;
                sr[q] = sc[(size_t)nn[q] * 256]; si[q] = sc[(size_t)nn[q] * 256 + 64];
            }
#pragma unroll
            for (int q = 0; q < 8; ++q) {
                vg[(size_t)nn[q] * KV] = f2bf(hr); vg[(size_t)nn[q] * KV + 64] = f2bf(hi);
                const float nr = a32.x * hr - a32.y * hi + sr[q], ni = a32.x * hi + a32.y * hr + si[q];
                hr = nr; hi = ni;
            }
        }
    }
}

__device__ void phase_F(const Params& p, int L, unsigned char* smem) {
    unsigned char* ws = p.ws;
    bf16_t* gbuf = (bf16_t*)(ws + OFF_GBUF);
    const float* dsk = p.in[I_S5D] + L * 256;
    for (int it = BIDX; it < 576; it += gridDim.x) {
        const int g = it / 36, rem = it % 36, mt = rem >> 2, nt = rem & 3;
        const bf16_t* vg = (const bf16_t*)(ws + OFF_VG) + (size_t)g * NCHP * KV;
        const bf16_t* wc = (const bf16_t*)(ws + OFF_WCOMB) + (size_t)g * 512 * KV;
        gemm128<false>([&](int r) { return vg + (size_t)(mt * 128 + r) * KV; },
                       [&](int r) { return wc + (size_t)(nt * 128 + r) * KV; }, KV,
                       [&](int m, int n, float v) {
                           const int nn = mt * 128 + m;
                           if (nn < NCH) {
                               const int nc = nt * 128 + n, i = nc >> 4, h = nc & 15;
                               const int b = nn / NCHB, cidx = nn % NCHB;
                               const int tt = cidx < 8 ? (T + b * 256 + cidx * 32 + i) : (b * 4096 + (cidx - 8) * 32 + i);
                               const float u = bf2f(vg[(size_t)nn * KV + 256 + nc]);
                               const float y = v + dsk[g * 16 + h] * u;
                               gbuf[(size_t)tt * 256 + g * 16 + h] = f2bf(gelu_tanh(y));
                           }
                       }, smem);
    }
}

__device__ void phase_G(const Params& p, int L, unsigned char* smem) {
    unsigned char* ws = p.ws;
    const bf16_t* gbuf = (const bf16_t*)(ws + OFF_GBUF);
    const bf16_t* wg = (const bf16_t*)(ws + OFF_WGLUT + L * SZ_WGLUT);
    bf16_t* ymix = (bf16_t*)(ws + OFF_YMIX);
    for (int it = BIDX; it < (TT / 128) * 2; it += gridDim.x) {
        const int mt = it >> 1, nt = it & 1;
        gemm128<false>([&](int r) { return gbuf + (size_t)(mt * 128 + r) * 256; },
                       [&](int r) { return wg + (size_t)(nt * 128 + r) * 256; }, 256,
                       [&](int m, int n, float v) {
                           const size_t tt = mt * 128 + m; const int nn = nt * 128 + n;
                           const float gg = bf2f(gbuf[tt * 256 + nn]);
                           ymix[tt * 1024 + 768 + nn] = f2bf(gg * sigmoidf_(v));
                       }, smem);
    }
}

__device__ void phase_H(const Params& p, int L) {
    const int lane = TIDX & 63, w = TIDX >> 6;
    const bf16_t* ymix = (const bf16_t*)(p.ws + OFF_YMIX);
    bf16_t* dst = (bf16_t*)(p.ws + OFF_ACT);
    const float* gg = p.in[I_GRPG] + (size_t)L * 1024 + lane * 16;
    for (int it = BIDX; it < TT / 8; it += gridDim.x) {
        const int tt = it * 8 + w;
        const uint4* src = (const uint4*)(ymix + (size_t)tt * 1024 + lane * 16);
        const uint4 a = src[0], b = src[1];
        const unsigned u[8] = {a.x, a.y, a.z, a.w, b.x, b.y, b.z, b.w};
        float v[16], ss = 0.f;
#pragma unroll
        for (int e = 0; e < 8; ++e) { v[2 * e] = bflo(u[e]); v[2 * e + 1] = bfhi(u[e]); ss += v[2 * e] * v[2 * e] + v[2 * e + 1] * v[2 * e + 1]; }
        ss += __shfl_xor(ss, 1); ss += __shfl_xor(ss, 2); ss += __shfl_xor(ss, 4); ss += __shfl_xor(ss, 8);
        const float r = rsqrtf(ss * (1.0f / 256.0f) + EPS);
        unsigned o[8];
#pragma unroll
        for (int e = 0; e < 8; ++e) o[e] = pack2(v[2 * e] * r * gg[2 * e], v[2 * e + 1] * r * gg[2 * e + 1]);
        uint4* d = (uint4*)(dst + (size_t)tt * 1024 + lane * 16);
        d[0] = make_uint4(o[0], o[1], o[2], o[3]); d[1] = make_uint4(o[4], o[5], o[6], o[7]);
    }
}

__device__ void phase_I(const Params& p, int L, unsigned char* smem) {
    unsigned char* ws = p.ws;
    const int mtok = (L == 0) ? TT : T;
    const int N_G = (mtok / 128) * 8, N_CV = 4096;
    const bf16_t* A = (const bf16_t*)(ws + OFF_ACT);
    const bf16_t* Bt = (const bf16_t*)(ws + OFF_WOUTT + L * SZ_WOUTT);
    const float* g1 = (const float*)(ws + OFF_MOD) + (size_t)L * 9 * 6144 + 2048;
    float* xctx = (float*)(ws + OFF_XCTX);
    for (int it = BIDX; it < N_G + N_CV; it += gridDim.x) {
        if (it < N_G) {
            const int mt = it >> 3, nt = it & 7;
            gemm128<false>([&](int r) { return A + (size_t)(mt * 128 + r) * 1024; },
                           [&](int r) { return Bt + (size_t)(nt * 128 + r) * 1024; }, 1024,
                           [&](int m, int n, float v) {
                               const int tt = mt * 128 + m, nn = nt * 128 + n;
                               const float gate = g1[(size_t)tok_modrow(tt) * 6144 + nn];
                               if (tt < T) {
                                   const size_t o = (size_t)tt * 1024 + nn;
                                   const float xr = (L == 0) ? p.in[I_X][o] : p.out[o];
                                   p.out[o] = xr + gate * v;
                               } else {
                                   const size_t o = (size_t)(tt - T) * 1024 + nn;
                                   xctx[o] = p.in[I_CTX][o] + gate * v;
                               }
                           }, smem);
        } else {
            const int lane = TIDX & 63, w = TIDX >> 6;
            const int rid = (it - N_G) * 8 + w;
            const int which = rid >> 14, row = rid & 16383;
            const float* src = p.in[which ? I_PV : I_PU] + ((size_t)L * 16384 + row) * 1024 + lane * 16;
            float4 v[4]; float mx = 0.f;
#pragma unroll
            for (int i = 0; i < 4; ++i) {
                v[i] = *(const float4*)(src + i * 4);
                mx = fmaxf(mx, fmaxf(fmaxf(fabsf(v[i].x), fabsf(v[i].y)), fmaxf(fabsf(v[i].z), fabsf(v[i].w))));
            }
#pragma unroll
            for (int o = 32; o >= 1; o >>= 1) mx = fmaxf(mx, __shfl_xor(mx, o));
            mx = fmaxf(mx, 1e-30f);
            const float sc = mx * (1.0f / 448.0f), inv = 448.0f / mx;
            int pk[4];
#pragma unroll
            for (int i = 0; i < 4; ++i) {
                int wd = 0;
                wd = __builtin_amdgcn_cvt_pk_fp8_f32(v[i].x * inv, v[i].y * inv, wd, false);
                wd = __builtin_amdgcn_cvt_pk_fp8_f32(v[i].z * inv, v[i].w * inv, wd, true);
                pk[i] = wd;
            }
            *(int4*)(ws + (which ? OFF_PEERV : OFF_PEERU) + (size_t)row * 1024 + lane * 16) = make_int4(pk[0], pk[1], pk[2], pk[3]);
            if (lane == 0) ((float*)(ws + (which ? OFF_PSCV : OFF_PSCU)))[row] = sc;
        }
    }
}

__device__ void phase_K(const Params& p, int L, unsigned char* smem) {
    unsigned char* ws = p.ws;
    const int tid = TIDX;
    const int mtok = (L == 0) ? TT : T;
    const bf16_t* A = (const bf16_t*)(ws + OFF_ACT);
    const bf16_t* Bt = (const bf16_t*)(ws + OFF_WQKT + L * SZ_WQKT);
    int* cand = (int*)(ws + OFF_CAND);
    const float* tc = (const float*)smem;
    int* cl = (int*)(smem + 66048);
    int* cl2 = (int*)(smem + 66048 + 32768);
    for (int it = BIDX; it < (mtok / 128) * 16; it += gridDim.x) {
        const int mt = it >> 4, hz = it & 15;
        gemm128<true>([&](int r) { return A + (size_t)(mt * 128 + r) * 1024; },
                      [&](int r) { return Bt + (size_t)(hz * 128 + r) * 1024; }, 1024,
                      [&](int, int, float) {}, smem);
        const int row = tid & 127, q = tid >> 7;
        int top[16];
#pragma unroll
        for (int j = 0; j < 16; ++j) top[j] = (int)0x80000000;
        for (int j = 0; j < 32; ++j) {
            const int col = q * 32 + j;
            const int key = (sortable(tc[row * 129 + col]) & ~0x7F) | col;
            top16_insert(top, key);
        }
#pragma unroll
        for (int j = 0; j < 16; ++j) cl[(row * 4 + q) * 16 + j] = top[j];
        __syncthreads();
        if (q < 2) {
#pragma unroll
            for (int j = 0; j < 16; ++j) top[j] = (int)0x80000000;
            for (int j = 0; j < 32; ++j) top16_insert(top, cl[(row * 4 + q * 2) * 16 + j]);
#pragma unroll
            for (int j = 0; j < 16; ++j) cl2[(row * 2 + q) * 16 + j] = top[j];
        }
        __syncthreads();
        if (q == 0) {
#pragma unroll
            for (int j = 0; j < 16; ++j) top[j] = (int)0x80000000;
            for (int j = 0; j < 32; ++j) top16_insert(top, cl2[row * 32 + j]);
            int4* dst = (int4*)(cand + ((size_t)(mt * 128 + row) * 16 + hz) * 16);
            dst[0] = make_int4(top[0], top[1], top[2], top[3]); dst[1] = make_int4(top[4], top[5], top[6], top[7]);
            dst[2] = make_int4(top[8], top[9], top[10], top[11]); dst[3] = make_int4(top[12], top[13], top[14], top[15]);
        }
        __syncthreads();
    }
}

__device__ void phase_L(const Params& p, int L) {
    const int mtok = (L == 0) ? TT : T;
    const int* cand = (const int*)(p.ws + OFF_CAND);
    int* eidx = (int*)(p.ws + OFF_EIDX);
    float* gate = (float*)(p.ws + OFF_GATE);
    const int nit = mtok * 8 / NTHREADS;
    for (int it = BIDX; it < nit; it += gridDim.x) {
        const int gid = it * NTHREADS + TIDX;
        const int tt = gid >> 3, hd = gid & 7;
        const int* c1 = cand + ((size_t)tt * 16 + hd * 2) * 16;
        const int* c2 = c1 + 16;
        float s1[16], s2[16];
        {
            const int4* a = (const int4*)c1; const int4* b = (const int4*)c2;
#pragma unroll
            for (int q = 0; q < 4; ++q) {
                int4 x = a[q], y = b[q];
                s1[q * 4] = unsortable(x.x & ~0x7F); s1[q * 4 + 1] = unsortable(x.y & ~0x7F); s1[q * 4 + 2] = unsortable(x.z & ~0x7F); s1[q * 4 + 3] = unsortable(x.w & ~0x7F);
                s2[q * 4] = unsortable(y.x & ~0x7F); s2[q * 4 + 1] = unsortable(y.y & ~0x7F); s2[q * 4 + 2] = unsortable(y.z & ~0x7F); s2[q * 4 + 3] = unsortable(y.w & ~0x7F);
            }
        }
        int top[16];
#pragma unroll
        for (int j = 0; j < 16; ++j) top[j] = (int)0x80000000;
#pragma unroll
        for (int i = 0; i < 16; ++i)
#pragma unroll
            for (int j = 0; j < 16; ++j)
                if ((i + 1) * (j + 1) <= 16) top16_insert(top, (sortable(s1[i] + s2[j]) & ~0xFF) | (i * 16 + j));
        float vals[16], sum = 0.f;
        const float mx = unsortable(top[0] & ~0xFF);
#pragma unroll
        for (int j = 0; j < 16; ++j) { vals[j] = __expf(unsortable(top[j] & ~0xFF) - mx); sum += vals[j]; }
        const float inv = 1.0f / sum;
        int ei[16];
#pragma unroll
        for (int j = 0; j < 16; ++j) {
            const int pr = top[j] & 0xFF;
            ei[j] = (c1[pr >> 4] & 0x7F) * 128 + (c2[pr & 15] & 0x7F);
            vals[j] *= inv;
        }
        int4* de = (int4*)(eidx + (size_t)tt * 128 + hd * 16);
        float4* dg = (float4*)(gate + (size_t)tt * 128 + hd * 16);
#pragma unroll
        for (int q = 0; q < 4; ++q) {
            de[q] = make_int4(ei[q * 4], ei[q * 4 + 1], ei[q * 4 + 2], ei[q * 4 + 3]);
            dg[q] = make_float4(vals[q * 4], vals[q * 4 + 1], vals[q * 4 + 2], vals[q * 4 + 3]);
        }
    }
}

typedef __attribute__((ext_vector_type(2))) float f32x2;
__device__ __forceinline__ float dot16_fp8(const float (&hf)[16], const uint4& u) {
    f32x2 a0 = __builtin_amdgcn_cvt_pk_f32_fp8((int)u.x, false), a1 = __builtin_amdgcn_cvt_pk_f32_fp8((int)u.x, true);
    f32x2 a2 = __builtin_amdgcn_cvt_pk_f32_fp8((int)u.y, false), a3 = __builtin_amdgcn_cvt_pk_f32_fp8((int)u.y, true);
    f32x2 a4 = __builtin_amdgcn_cvt_pk_f32_fp8((int)u.z, false), a5 = __builtin_amdgcn_cvt_pk_f32_fp8((int)u.z, true);
    f32x2 a6 = __builtin_amdgcn_cvt_pk_f32_fp8((int)u.w, false), a7 = __builtin_amdgcn_cvt_pk_f32_fp8((int)u.w, true);
    float d0 = hf[0] * a0.x, d1 = hf[1] * a0.y;
    d0 += hf[2] * a1.x; d1 += hf[3] * a1.y; d0 += hf[4] * a2.x; d1 += hf[5] * a2.y; d0 += hf[6] * a3.x; d1 += hf[7] * a3.y;
    d0 += hf[8] * a4.x; d1 += hf[9] * a4.y; d0 += hf[10] * a5.x; d1 += hf[11] * a5.y; d0 += hf[12] * a6.x; d1 += hf[13] * a6.y;
    d0 += hf[14] * a7.x; d1 += hf[15] * a7.y;
    return d0 + d1;
}
__device__ __forceinline__ void axpy16_fp8(float (&acc)[16], float a, const uint4& v) {
    f32x2 a0 = __builtin_amdgcn_cvt_pk_f32_fp8((int)v.x, false), a1 = __builtin_amdgcn_cvt_pk_f32_fp8((int)v.x, true);
    f32x2 a2 = __builtin_amdgcn_cvt_pk_f32_fp8((int)v.y, false), a3 = __builtin_amdgcn_cvt_pk_f32_fp8((int)v.y, true);
    f32x2 a4 = __builtin_amdgcn_cvt_pk_f32_fp8((int)v.z, false), a5 = __builtin_amdgcn_cvt_pk_f32_fp8((int)v.z, true);
    f32x2 a6 = __builtin_amdgcn_cvt_pk_f32_fp8((int)v.w, false), a7 = __builtin_amdgcn_cvt_pk_f32_fp8((int)v.w, true);
    acc[0] += a * a0.x; acc[1] += a * a0.y; acc[2] += a * a1.x; acc[3] += a * a1.y; acc[4] += a * a2.x; acc[5] += a * a2.y; acc[6] += a * a3.x; acc[7] += a * a3.y;
    acc[8] += a * a4.x; acc[9] += a * a4.y; acc[10] += a * a5.x; acc[11] += a * a5.y; acc[12] += a * a6.x; acc[13] += a * a6.y; acc[14] += a * a7.x; acc[15] += a * a7.y;
}

__device__ void phase_M(const Params& p, int L) {
    const int lane = TIDX & 63, w = TIDX >> 6;
    const int mtok = (L == 0) ? TT : T;
    const bf16_t* hact = (const bf16_t*)(p.ws + OFF_ACT);
    const unsigned char* pu = p.ws + OFF_PEERU;
    const unsigned char* pv = p.ws + OFF_PEERV;
    const float* scu = (const float*)(p.ws + OFF_PSCU);
    const float* scv = (const float*)(p.ws + OFF_PSCV);
    const int* eidx = (const int*)(p.ws + OFF_EIDX);
    const float* gate = (const float*)(p.ws + OFF_GATE);
    const float* g2 = (const float*)(p.ws + OFF_MOD) + (size_t)L * 9 * 6144 + 5120;
    const bool hi32 = (lane & 32) != 0, hi16 = (lane & 16) != 0, hi8 = (lane & 8) != 0;
    for (int it = BIDX; it < mtok / 8; it += gridDim.x) {
        const int tt = it * 8 + w;
        float hf[16];
        {
            const uint4 a = *(const uint4*)(hact + (size_t)tt * 1024 + lane * 16), b = *(const uint4*)(hact + (size_t)tt * 1024 + lane * 16 + 8);
            hf[0] = bflo(a.x); hf[1] = bfhi(a.x); hf[2] = bflo(a.y); hf[3] = bfhi(a.y); hf[4] = bflo(a.z); hf[5] = bfhi(a.z); hf[6] = bflo(a.w); hf[7] = bfhi(a.w);
            hf[8] = bflo(b.x); hf[9] = bfhi(b.x); hf[10] = bflo(b.y); hf[11] = bfhi(b.y); hf[12] = bflo(b.z); hf[13] = bfhi(b.z); hf[14] = bflo(b.w); hf[15] = bfhi(b.w);
        }
        const int e0 = eidx[(size_t)tt * 128 + lane], e1 = eidx[(size_t)tt * 128 + 64 + lane];
        const float g0 = gate[(size_t)tt * 128 + lane], g1v = gate[(size_t)tt * 128 + 64 + lane];
        float acc[16];
#pragma unroll
        for (int d = 0; d < 16; ++d) acc[d] = 0.f;
#pragma unroll 1
        for (int j0 = 0; j0 < 128; j0 += 8) {
            uint4 ur[8], vr[8]; float gt[8], d[8];
#pragma unroll
            for (int q = 0; q < 8; ++q) {
                const int j = j0 + q;
                const int e = __builtin_amdgcn_readlane(j0 < 64 ? e0 : e1, j & 63);
                const float gg = __builtin_bit_cast(float, __builtin_amdgcn_readlane(__builtin_bit_cast(int, j0 < 64 ? g0 : g1v), j & 63));
                ur[q] = *(const uint4*)(pu + (size_t)e * 1024 + lane * 16);
                vr[q] = *(const uint4*)(pv + (size_t)e * 1024 + lane * 16);
                d[q] = scu[e];
                gt[q] = gg * scv[e];
            }
#pragma unroll
            for (int q = 0; q < 8; ++q) d[q] *= dot16_fp8(hf, ur[q]);
            float r4[4], r2[2], r1;
#pragma unroll
            for (int i = 0; i < 4; ++i) { const float keep = hi32 ? d[2 * i + 1] : d[2 * i], send = hi32 ? d[2 * i] : d[2 * i + 1]; r4[i] = keep + __shfl_xor(send, 32); }
#pragma unroll
            for (int i = 0; i < 2; ++i) { const float keep = hi16 ? r4[2 * i + 1] : r4[2 * i], send = hi16 ? r4[2 * i] : r4[2 * i + 1]; r2[i] = keep + __shfl_xor(send, 16); }
            { const float keep = hi8 ? r2[1] : r2[0], send = hi8 ? r2[0] : r2[1]; r1 = keep + __shfl_xor(send, 8); }
            r1 += __shfl_xor(r1, 4); r1 += __shfl_xor(r1, 2); r1 += __shfl_xor(r1, 1);
            const int gl = __builtin_bit_cast(int, gelu_tanh(r1));
#pragma unroll
            for (int q = 0; q < 8; ++q) {
                const int srcl = (q & 1) * 32 + ((q >> 1) & 1) * 16 + ((q >> 2) & 1) * 8;
                const float a = __builtin_bit_cast(float, __builtin_amdgcn_readlane(gl, srcl)) * gt[q];
                axpy16_fp8(acc, a, vr[q]);
            }
        }
        float* xr = (tt < T) ? (p.out + (size_t)tt * 1024) : ((float*)(p.ws + OFF_XCTX) + (size_t)(tt - T) * 1024);
        const float* gr = g2 + (size_t)tok_modrow(tt) * 6144;
        float xv[16];
#pragma unroll
        for (int i = 0; i < 4; ++i) {
            const int k = lane * 16 + i * 4;
            const float4 x0 = *(const float4*)(xr + k), q0 = *(const float4*)(gr + k);
            xv[i * 4 + 0] = x0.x + q0.x * acc[i * 4 + 0]; xv[i * 4 + 1] = x0.y + q0.y * acc[i * 4 + 1];
            xv[i * 4 + 2] = x0.z + q0.z * acc[i * 4 + 2]; xv[i * 4 + 3] = x0.w + q0.w * acc[i * 4 + 3];
        }
        if (L == 1) {
            float ss = 0.f;
#pragma unroll
            for (int d = 0; d < 16; ++d) ss += xv[d] * xv[d];
            ss = wave_sum(ss);
            const float r = rsqrtf(ss * (1.0f / 1024.0f) + EPS);
#pragma unroll
            for (int i = 0; i < 4; ++i) {
                const float4 f0 = *(const float4*)(p.in[I_FING] + lane * 16 + i * 4);
                xv[i * 4 + 0] *= r * f0.x; xv[i * 4 + 1] *= r * f0.y; xv[i * 4 + 2] *= r * f0.z; xv[i * 4 + 3] *= r * f0.w;
            }
        }
#pragma unroll
        for (int i = 0; i < 4; ++i) *(float4*)(xr + lane * 16 + i * 4) = make_float4(xv[i * 4 + 0], xv[i * 4 + 1], xv[i * 4 + 2], xv[i * 4 + 3]);
    }
}

#define XB_TMO      128
#define XB_XCNT(j)  (256  + 64 * (j))
#define XB_XSUB(j)  (1280 + 64 * (j))
#define XB_XGEN(j)  (2304 + 64 * (j))
#define XB_TOP      3328
#define XB_TOPGEN   3392
#define XCD_BAR_WORDS 3456
#define XB_SPIN_CAP (1u << 22)
#define LAS __attribute__((address_space(3)))
__device__ __forceinline__ unsigned xb_ld(unsigned* p)              { return __hip_atomic_load(p, __ATOMIC_RELAXED, __HIP_MEMORY_SCOPE_AGENT); }
__device__ __forceinline__ unsigned xb_add(unsigned* p, unsigned v) { return __hip_atomic_fetch_add(p, v, __ATOMIC_RELAXED, __HIP_MEMORY_SCOPE_AGENT); }
__device__ __forceinline__ unsigned xb_xcc_id() { return (unsigned)__builtin_amdgcn_s_getreg((3 << 11) | 20) & 0xFu; }
#define XB_SPIN(cond, bar) do { unsigned _sp = 0; while (cond) { __builtin_amdgcn_s_sleep(1); \
    if ((++_sp & 255u) == 0u) { if (xb_ld(&(bar)[XB_TMO])) break; if (_sp > XB_SPIN_CAP) { atomicAdd(&(bar)[XB_TMO], 1u); break; } } } } while (0)
struct XcdBarrier { unsigned* bar; unsigned x; volatile LAS unsigned* st; };
__device__ __forceinline__ XcdBarrier xcd_barrier_post(unsigned* bar, volatile LAS unsigned* st) {
    XcdBarrier b; b.bar = bar; b.x = xb_xcc_id(); b.st = st;
    if (threadIdx.x == 0) (void)xb_add(&bar[XB_XCNT(b.x)], 1u);
    return b;
}
__device__ __forceinline__ void xcd_barrier_complete(unsigned* bar, unsigned x, unsigned& nloc, unsigned& nx) {
    const unsigned G = gridDim.x * gridDim.y * gridDim.z;
    unsigned sum, cnt, mine, sp = 0u;
    for (;;) {
        sum = 0u; cnt = 0u; mine = 0u;
#pragma unroll
        for (unsigned j = 0; j < 16; ++j) { const unsigned c = xb_ld(&bar[XB_XCNT(j)]); sum += c; cnt += (c > 0u) ? 1u : 0u; mine = (j == x) ? c : mine; }
        if (sum == G) break;
        __builtin_amdgcn_s_sleep(1);
        if ((++sp & 255u) == 0u) { if (xb_ld(&bar[XB_TMO])) break; if (sp > XB_SPIN_CAP) { atomicAdd(&bar[XB_TMO], 1u); break; } }
    }
    nloc = mine > 0u ? mine : 1u; nx = cnt > 0u ? cnt : 1u;
}
__device__ __forceinline__ void xcd_barrier(const XcdBarrier& b) {
    asm volatile("s_waitcnt vmcnt(0)" ::: "memory");
    __syncthreads();
    if (threadIdx.x == 0) {
        unsigned* bar = b.bar;
        __builtin_amdgcn_s_waitcnt(0);
        unsigned nloc = b.st[0], nx = b.st[1];
        if (nloc == 0u) { xcd_barrier_complete(bar, b.x, nloc, nx); b.st[0] = nloc; b.st[1] = nx; }
        const unsigned old = xb_add(&bar[XB_XSUB(b.x)], 1u);
        const unsigned gen = old / nloc;
        if (old + 1u == (gen + 1u) * nloc) {
            __builtin_amdgcn_fence(__ATOMIC_RELEASE, "agent");
            asm volatile("s_waitcnt vmcnt(0)" ::: "memory");
            const unsigned og = xb_add(&bar[XB_TOP], 1u);
            const unsigned tg = og / nx;
            if (og + 1u == (tg + 1u) * nx) xb_add(&bar[XB_TOPGEN], 1u);
            else XB_SPIN(xb_ld(&bar[XB_TOPGEN]) == tg, bar);
            __builtin_amdgcn_fence(__ATOMIC_ACQUIRE, "agent");
            xb_add(&bar[XB_XGEN(b.x)], 1u);
            asm volatile("s_waitcnt vmcnt(0)" ::: "memory");
        } else {
            XB_SPIN(xb_ld(&bar[XB_XGEN(b.x)]) == gen, bar);
            __builtin_amdgcn_fence(__ATOMIC_ACQUIRE, "agent");
            asm volatile("s_waitcnt vmcnt(0)" ::: "memory");
        }
    }
    __syncthreads();
}

constexpr int N_PHASES = 1 + 2 * 13;

__device__ __forceinline__ void run_phase(const Params& p, int ph, unsigned char* smem) {
    if (ph == 0) { phase_prep(p, smem); return; }
    const int L = (ph - 1) / 13, s = (ph - 1) % 13;
    switch (s) {
        case 0: phase_A(p, L); break;
        case 1: phase_B(p, L, smem); break;
        case 2: phase_C(p, L, smem); break;
        case 3: phase_D(p, L, smem); break;
        case 4: phase_E(p, L); break;
        case 5: phase_F(p, L, smem); break;
        case 6: phase_G(p, L, smem); break;
        case 7: phase_H(p, L); break;
        case 8: phase_I(p, L, smem); break;
        case 9: norm_tokens(p, L, 1, (L == 0) ? TT : T, false, 0, ((L == 0) ? TT : T) / 8); break;
        case 10: phase_K(p, L, smem); break;
        case 11: phase_L(p, L); break;
        default: phase_M(p, L); break;
    }
}

__global__ void __launch_bounds__(NTHREADS) fwd_megakernel(Params p) {
    extern __shared__ __attribute__((aligned(16))) unsigned char smem[];
    cg::grid_group grid = cg::this_grid();
    volatile LAS unsigned* xst = (volatile LAS unsigned*)(smem + SMEM_BYTES - 16);
    if (threadIdx.x == 0) { xst[0] = 0u; xst[1] = 0u; }
    __syncthreads();
    const XcdBarrier xb = xcd_barrier_post((unsigned*)(p.ws + OFF_BAR), xst);
    for (int ph = p.ph_lo; ph < p.ph_hi; ++ph) {
        run_phase(p, ph, smem);
#if PROBE_MASK
        if (ph > 0 && ((PROBE_MASK >> ((ph - 1) % 13)) & 1) && !(((ph - 1) % 13) == 8 && ph > 13)) { xcd_barrier(xb); run_phase(p, ph, smem); }
#endif
        if (ph + 1 < p.ph_hi) {
            if (ph == p.ph_lo) grid.sync();
            else xcd_barrier(xb);
        }
    }
}

extern "C" void kernel_launch(void* const* d_in, const int* in_sizes, int n_in, void* d_out, int out_size, void* d_ws, size_t ws_size,
                              hipStream_t stream) {
    static int grid_blocks = 0;
    if (grid_blocks == 0) {
        if (n_in != 27 || out_size != T * D || ws_size < WS_END) {
            fprintf(stderr, "kernel_launch: unexpected problem (n_in %d, out %d, ws %zu, need %zu)\n", n_in, out_size, ws_size, (size_t)WS_END);
            grid_blocks = -1; return;
        }
        int dev = 0, cus = 0, per_cu = 0;
        hipGetDevice(&dev);
        hipDeviceGetAttribute(&cus, hipDeviceAttributeMultiprocessorCount, dev);
        hipFuncSetAttribute((const void*)fwd_megakernel, hipFuncAttributeMaxDynamicSharedMemorySize, SMEM_BYTES);
        hipOccupancyMaxActiveBlocksPerMultiprocessor(&per_cu, (const void*)fwd_megakernel, NTHREADS, SMEM_BYTES);
        if (per_cu < 1) { fprintf(stderr, "kernel_launch: occupancy query returned %d\n", per_cu); per_cu = 1; }
        if (per_cu > 1) per_cu = 1;
        grid_blocks = cus * per_cu;
    }
    if (grid_blocks < 0) return;
    if (hipMemsetAsync((char*)d_ws + OFF_BAR, 0, SZ_BAR, stream) != hipSuccess) { fprintf(stderr, "kernel_launch: memset of the barrier words failed\n"); return; }
    Params p{};
    for (int i = 0; i < 27; ++i) p.in[i] = (const float*)d_in[i];
    p.out = (float*)d_out; p.ws = (unsigned char*)d_ws;
#if SPLIT_LAUNCH
    for (int ph = 0; ph < N_PHASES; ++ph) {
        p.ph_lo = ph; p.ph_hi = ph + 1;
        void* args[] = {&p};
        hipError_t e = hipLaunchCooperativeKernel((const void*)fwd_megakernel, dim3(grid_blocks), dim3(NTHREADS), args, SMEM_BYTES, stream);
        if (e != hipSuccess) { fprintf(stderr, "launch failed: %s\n", hipGetErrorString(e)); return; }
    }
#else
    p.ph_lo = 0; p.ph_hi = N_PHASES;
    void* args[] = {&p};
    hipError_t e = hipLaunchCooperativeKernel((const void*)fwd_megakernel, dim3(grid_blocks), dim3(NTHREADS), args, SMEM_BYTES, stream);
    if (e != hipSuccess) fprintf(stderr, "cooperative launch failed: %s (grid %d)\n", hipGetErrorString(e), grid_blocks);
#endif
}
```

```cpp
#include <hip/hip_runtime.h>
#include <hip/hip_cooperative_groups.h>
#include <cstdio>
#include <cstdint>
namespace cg = cooperative_groups;

#define NTHREADS 512
#ifndef PROBE_MASK
#define PROBE_MASK 0
#endif
#ifndef SPLIT_LAUNCH
#define SPLIT_LAUNCH 0
#endif

typedef unsigned short bf16_t;
typedef __attribute__((ext_vector_type(8))) short bf16x8;
typedef __attribute__((ext_vector_type(4))) float f32x4;
typedef __attribute__((ext_vector_type(2))) __bf16 bf16x2_t;
typedef __attribute__((ext_vector_type(4))) unsigned u32x4_t;

constexpr int D = 1024, NB = 8, SEQ = 4096, T = NB * SEQ, CTXL = 256, TC = NB * CTXL, TT = T + TC;
constexpr int INW = 2048;
constexpr int NCHB = 136;
constexpr int NCH = NB * NCHB;
constexpr int NCHP = 1152;
constexpr int KV = 768;
constexpr float EPS = 1e-6f;

constexpr size_t al256(size_t x) { return (x + 255) & ~(size_t)255; }
constexpr size_t OFF_ACT = 0;                                   constexpr size_t SZ_ACT = (size_t)TT * 1024 * 2;
constexpr size_t OFF_XIN = al256(OFF_ACT + SZ_ACT);             constexpr size_t SZ_XIN = (size_t)TT * 2048 * 2;
constexpr size_t OFF_YMIX = al256(OFF_XIN + SZ_XIN);            constexpr size_t SZ_YMIX = (size_t)TT * 1024 * 2;
constexpr size_t OFF_XCTX = al256(OFF_YMIX + SZ_YMIX);          constexpr size_t SZ_XCTX = (size_t)TC * 1024 * 4;
constexpr size_t OFF_ZT = al256(OFF_XCTX + SZ_XCTX);            constexpr size_t SZ_ZT = (size_t)NB * 256 * 8192 * 2;
constexpr size_t OFF_ZTC = al256(OFF_ZT + SZ_ZT);               constexpr size_t SZ_ZTC = (size_t)NB * 256 * 512 * 2;
constexpr size_t OFF_VG = al256(OFF_ZTC + SZ_ZTC);              constexpr size_t SZ_VG = (size_t)16 * NCHP * KV * 2;
constexpr size_t OFF_SC = al256(OFF_VG + SZ_VG);                constexpr size_t SZ_SC = (size_t)16 * NCH * 256 * 4;
constexpr size_t OFF_GBUF = al256(OFF_SC + SZ_SC);              constexpr size_t SZ_GBUF = (size_t)TT * 256 * 2;
constexpr size_t OFF_DFTL = al256(OFF_GBUF + SZ_GBUF);          constexpr size_t SZ_DFTL = (size_t)4096 * 8192 * 2;
constexpr size_t OFF_DFTC = al256(OFF_DFTL + SZ_DFTL);          constexpr size_t SZ_DFTC = (size_t)256 * 512 * 2;
constexpr size_t OFF_DFTD = al256(OFF_DFTC + SZ_DFTC);          constexpr size_t SZ_DFTD = (size_t)128 * 64 * 2;
constexpr size_t SZ_WINT = (size_t)2048 * 1024 * 2, SZ_WOUTT = (size_t)1024 * 1024 * 2, SZ_WQKT = (size_t)2048 * 1024 * 2, SZ_WGLUT = (size_t)256 * 256 * 2;
constexpr size_t OFF_WINT = al256(OFF_DFTD + SZ_DFTD);
constexpr size_t OFF_WOUTT = al256(OFF_WINT + 2 * SZ_WINT);
constexpr size_t OFF_WQKT = al256(OFF_WOUTT + 2 * SZ_WOUTT);
constexpr size_t OFF_WGLUT = al256(OFF_WQKT + 2 * SZ_WQKT);
constexpr size_t OFF_WCOMB = al256(OFF_WGLUT + 2 * SZ_WGLUT);   constexpr size_t SZ_WCOMB = (size_t)16 * 512 * KV * 2;
constexpr size_t OFF_WST = al256(OFF_WCOMB + SZ_WCOMB);         constexpr size_t SZ_WST = (size_t)16 * 256 * 512 * 2;
constexpr size_t OFF_POWA = al256(OFF_WST + SZ_WST);            constexpr size_t SZ_POWA = (size_t)2 * 2 * 16 * 33 * 64 * 8;
constexpr size_t OFF_BBAR = al256(OFF_POWA + SZ_POWA);          constexpr size_t SZ_BBAR = (size_t)2 * 2 * 16 * 64 * 16 * 8;
constexpr size_t OFF_KTAU = al256(OFF_BBAR + SZ_BBAR);          constexpr size_t SZ_KTAU = (size_t)2 * 2 * 16 * 32 * 256 * 4;
constexpr size_t OFF_MOD = al256(OFF_KTAU + SZ_KTAU);           constexpr size_t SZ_MOD = (size_t)2 * 9 * 6144 * 4;
constexpr size_t OFF_VT = al256(OFF_MOD + SZ_MOD);              constexpr size_t SZ_VT = (size_t)NB * 256 * 4096 * 2;
constexpr size_t OFF_VTC = al256(OFF_VT + SZ_VT);               constexpr size_t SZ_VTC = (size_t)NB * 256 * 256 * 2;
constexpr size_t OFF_BAR = al256(OFF_VTC + SZ_VTC);              constexpr size_t SZ_BAR = (size_t)(3456 + 32 * 64) * 4;
#define QC_WORD(L, kind, sl) (3456 + ((((L) * 2 + (kind)) * 8 + (sl)) * 64))
constexpr size_t OFF_MATAB = al256(OFF_BAR + SZ_BAR);            constexpr size_t SZ_MAT = (size_t)128 * 128 * 2;
constexpr size_t OFF_MATAD = al256(OFF_MATAB + SZ_MAT);
constexpr size_t OFF_TW = al256(OFF_MATAD + SZ_MAT);             constexpr size_t SZ_TW = (size_t)64 * 64 * 8;
constexpr size_t WS_END = al256(OFF_TW + SZ_TW);
constexpr size_t OFF_SCORES = OFF_ZT;
static_assert(OFF_SCORES + (size_t)TT * 2048 * 2 <= OFF_DFTL + SZ_DFTL, "scores overlay");
constexpr size_t OFF_YP = OFF_DFTL;
constexpr size_t OFF_PEERU = OFF_XIN;                            constexpr size_t SZ_PEERT = (size_t)16384 * 1024;
constexpr size_t OFF_PEERV = OFF_PEERU + SZ_PEERT;
constexpr size_t OFF_PSCU = OFF_PEERV + SZ_PEERT;                constexpr size_t SZ_PSC = (size_t)16384 * 4;
constexpr size_t OFF_PSCV = OFF_PSCU + SZ_PSC;
constexpr size_t OFF_CAND = OFF_PSCV + SZ_PSC;                   constexpr size_t SZ_CAND = (size_t)TT * 256 * 4;
constexpr size_t OFF_EIDX = OFF_CAND + SZ_CAND;                  constexpr size_t SZ_EIDX = (size_t)TT * 128 * 4;
constexpr size_t OFF_GATE = OFF_EIDX + SZ_EIDX;
constexpr size_t OFF_H8 = OFF_YMIX;
constexpr size_t OFF_SU = OFF_GATE + SZ_EIDX;
static_assert(OFF_SU + SZ_EIDX <= OFF_XIN + SZ_XIN, "PEER overlays must fit in the XIN region");

constexpr int SMEM_BYTES = 163840;

struct Params {
    const float* in[27];
    float* out;
    unsigned char* ws;
    int ph_lo, ph_hi;
};
enum { I_X = 0, I_C, I_CTX, I_CCTX, I_ADAW, I_ADAB, I_N1G, I_N2G, I_WIN, I_RPB, I_CONVW, I_ARE, I_AIM, I_BRE, I_BIM, I_CRE, I_CIM,
       I_LOGDT, I_S5D, I_WGLU, I_GRPG, I_WOUT, I_WQ, I_KEYS, I_PU, I_PV, I_FING };


__device__ __forceinline__ int tidx_l() { int t = threadIdx.x; asm volatile("" : "+v"(t)); return t; }
__device__ __forceinline__ int bidx_l() { int t = blockIdx.x; asm volatile("" : "+s"(t)); return t; }
#define TIDX (tidx_l())
#define BIDX (bidx_l())
#define LAS_ __attribute__((address_space(3)))
__device__ __forceinline__ bf16_t f2bf(float f) { unsigned u = __float_as_uint(f); u += 0x7FFFu + ((u >> 16) & 1u); return (bf16_t)(u >> 16); }
__device__ __forceinline__ float bf2f(bf16_t h) { return __uint_as_float(((unsigned)h) << 16); }
__device__ __forceinline__ unsigned pack2(float a, float b) { unsigned r; asm("v_cvt_pk_bf16_f32 %0, %1, %2" : "=v"(r) : "v"(a), "v"(b)); return r; }
__device__ __forceinline__ float bflo(unsigned u) { return __uint_as_float(u << 16); }
__device__ __forceinline__ float bfhi(unsigned u) { return __uint_as_float(u & 0xffff0000u); }
__device__ __forceinline__ float dot2bf(unsigned a, unsigned b, float c) {
    return __builtin_amdgcn_fdot2_f32_bf16(__builtin_bit_cast(bf16x2_t, a), __builtin_bit_cast(bf16x2_t, b), c, false);
}
__device__ __forceinline__ float gelu_tanh(float x) {
    float z = 0.7978845608028654f * (x + 0.044715f * x * x * x);
    float e = __expf(2.0f * z);
    float th = 1.0f - 2.0f / (e + 1.0f);
    return 0.5f * x * (1.0f + th);
}
__device__ __forceinline__ float sigmoidf_(float x) { return 1.0f / (1.0f + __expf(-x)); }
template <int K> __device__ __forceinline__ float xor_swz(float v) { return __int_as_float(__builtin_amdgcn_ds_swizzle(__float_as_int(v), (K << 10) | 0x1F)); }
__device__ __forceinline__ float bfly32(float a, float b) { auto r = __builtin_amdgcn_permlane32_swap(__float_as_uint(a), __float_as_uint(b), false, false); return __uint_as_float(r[0]) + __uint_as_float(r[1]); }
__device__ __forceinline__ float bfly16(float a, float b) { auto r = __builtin_amdgcn_permlane16_swap(__float_as_uint(a), __float_as_uint(b), false, false); return __uint_as_float(r[0]) + __uint_as_float(r[1]); }
__device__ __forceinline__ float max32(float a) { auto r = __builtin_amdgcn_permlane32_swap(__float_as_uint(a), __float_as_uint(a), false, false); return fmaxf(__uint_as_float(r[0]), __uint_as_float(r[1])); }
__device__ __forceinline__ float max16(float a) { auto r = __builtin_amdgcn_permlane16_swap(__float_as_uint(a), __float_as_uint(a), false, false); return fmaxf(__uint_as_float(r[0]), __uint_as_float(r[1])); }
__device__ __forceinline__ float wave_sum(float v) {
    v = bfly32(v, v); v = bfly16(v, v);
    v += xor_swz<8>(v); v += xor_swz<4>(v); v += xor_swz<2>(v); v += xor_swz<1>(v);
    return v;
}
__device__ __forceinline__ float wave_max(float v) {
    v = max32(v); v = max16(v);
    v = fmaxf(v, xor_swz<8>(v)); v = fmaxf(v, xor_swz<4>(v)); v = fmaxf(v, xor_swz<2>(v)); v = fmaxf(v, xor_swz<1>(v));
    return v;
}
__device__ __forceinline__ int sortable(float v) { int b = __float_as_int(v); return b ^ ((b >> 31) & 0x7FFFFFFF); }
__device__ __forceinline__ float unsortable(int s) { return __int_as_float(s ^ ((s >> 31) & 0x7FFFFFFF)); }
__device__ __forceinline__ void top16_insert(int (&top)[16], int x) {
#pragma unroll
    for (int j = 0; j < 16; ++j) { int hi = max(top[j], x); x = min(top[j], x); top[j] = hi; }
}
__device__ __forceinline__ int tok_modrow(int tt) { return tt < T ? (tt >> 12) : 8; }

namespace pg8 {
#define PG8_LAS __attribute__((address_space(3)))
typedef unsigned short bf16_t;
typedef short bf16x8 __attribute__((ext_vector_type(8)));
typedef float f32x4 __attribute__((ext_vector_type(4)));
typedef unsigned u32x4 __attribute__((ext_vector_type(4)));
constexpr int BM = 256, BK = 64, HALF = 128, HTB = HALF * BK * 2  , STAGE_BYTES = 8 * HTB, NXCD = 8, WGM = 8;

__host__ __device__ __forceinline__ int lds_byte(int r, int c) { const int st = (r >> 4) * 2 + (c >> 5), rr = r & 15, cc = c & 31, ob = rr * 64 + cc * 2; return st * 1024 + (ob ^ (((ob >> 9) & 1) << 5)); }
__host__ __device__ __forceinline__ void stage_rc(int b, int& R, int& C) { const int st = b / 1024, sb = b % 1024, swz = sb ^ (((sb >> 9) & 1) << 5); R = (st >> 1) * 16 + swz / 64; C = (st & 1) * 32 + (swz % 64) / 2; }
__host__ __device__ __forceinline__ int perm32(int rho) { const int n = rho >> 4, i = rho & 15; return 8 * (i >> 2) + 4 * n + (i & 3); }

struct Unit { int pm, pn; };
struct Gemm { const bf16_t* A; const bf16_t* Bt; int M, N, K; };

struct StaticOrder {
    int nM, nN, nwg, G, c;
    __host__ __device__ void init(int M, int N, int G_, int c_) { nM = M / BM; nN = N / BM; nwg = nM * nN; G = G_; c = c_; }
    __host__ __device__ bool next(int i, Unit& u) const {
        const long L = (long)i * G + c; if (L >= nwg) return false;
        int wgid = (int)L; { const int q = nwg / NXCD, r = nwg % NXCD, xcd = wgid % NXCD, off = wgid / NXCD; wgid = (xcd < r ? xcd * (q + 1) : r * (q + 1) + (xcd - r) * q) + off; }
        const int nig = WGM * nN, gid = wgid / nig, fm = gid * WGM, gsz = (nM - fm) < WGM ? (nM - fm) : WGM;
        u.pm = fm + ((wgid % nig) % gsz); u.pn = (wgid % nig) / gsz; return true;
    }
    __device__ __forceinline__ void a_ready(const Unit&) const {}
    __device__ __forceinline__ void done(const Unit&) const {}
};
__device__ __forceinline__ unsigned cvt_pk_bf16(float lo, float hi) { unsigned r; asm volatile("v_cvt_pk_bf16_f32 %0, %1, %2" : "=v"(r) : "v"(lo), "v"(hi)); return r; }
typedef float f32x2 __attribute__((ext_vector_type(2)));
__device__ __forceinline__ f32x2 gelu_pk(f32x2 v) {
    const f32x2 av = __builtin_elementwise_abs(v), d = av * 0.2316418882f + 1.0f;
    f32x2 t; t.x = __builtin_amdgcn_rcpf(d.x); t.y = __builtin_amdgcn_rcpf(d.y);
    f32x2 q = t * 0.5307027145f + (-0.7265760135f); q = q * t + 0.7107068705f; q = q * t + (-0.142248368f); q = q * t + 0.127414796f; q = q * t;
    const f32x2 s = (v * v) * (-0.72134752044f);
    f32x2 e; e.x = __builtin_amdgcn_exp2f(s.x); e.y = __builtin_amdgcn_exp2f(s.y);
    const f32x2 m = v * (q * e), r = v - m;
    f32x2 o; o.x = v.x < 0.f ? m.x : r.x; o.y = v.y < 0.f ? m.y : r.y; return o;
}

struct EpiF32 {
    static constexpr bool PERM = false, AFTER_DRAIN = false;
    float* C; int ldc; const float* bias;
    __device__ __forceinline__ void operator()(const f32x4 (&acc)[2][2][4][2], const Unit& u, int wr, int wc, int fr, int fq) const {
        const int row0 = u.pm * BM + wr * 64 + fr, col0 = u.pn * BM + wc * 32 + 4 * fq;
        f32x4 bv[2][2];
#pragma unroll
        for (int bj = 0; bj < 2; ++bj)
#pragma unroll
            for (int n = 0; n < 2; ++n) bv[bj][n] = bias ? *(const f32x4*)(bias + col0 + bj * HALF + n * 16) : (f32x4){0.f, 0.f, 0.f, 0.f};
#pragma unroll
        for (int ai = 0; ai < 2; ++ai)
#pragma unroll
            for (int m = 0; m < 4; ++m) { float* rowp = C + (size_t)(row0 + ai * HALF + m * 16) * ldc + col0;
#pragma unroll
                for (int bj = 0; bj < 2; ++bj)
#pragma unroll
                    for (int n = 0; n < 2; ++n) *(f32x4*)(rowp + bj * HALF + n * 16) = acc[ai][bj][m][n] + bv[bj][n]; }
    }
};
template <int ACT  > struct EpiBf16 {
    static constexpr bool PERM = true, AFTER_DRAIN = false;
    bf16_t* O; int ldc; const float* bias; int split_cols; size_t split_stride;
    __device__ __forceinline__ void operator()(const f32x4 (&acc)[2][2][4][2], const Unit& u, int wr, int wc, int fr, int fq) const {
        const int row0 = u.pm * BM + wr * 64 + fr; int colt = u.pn * BM; bf16_t* base = O;
        if (split_cols) { const int t = colt / split_cols; base += (size_t)t * split_stride; colt -= t * split_cols; }
        const int col0 = colt + wc * 32 + 8 * fq, bcol0 = u.pn * BM + wc * 32 + 8 * fq;
        f32x4 bv[2][2];
#pragma unroll
        for (int bj = 0; bj < 2; ++bj)
#pragma unroll
            for (int n = 0; n < 2; ++n) bv[bj][n] = bias ? *(const f32x4*)(bias + bcol0 + bj * HALF + 4 * n) : (f32x4){0.f, 0.f, 0.f, 0.f};
#pragma unroll
        for (int ai = 0; ai < 2; ++ai)
#pragma unroll
            for (int m = 0; m < 4; ++m) { bf16_t* rowp = base + (size_t)(row0 + ai * HALF + m * 16) * ldc + col0;
#pragma unroll
                for (int bj = 0; bj < 2; ++bj) { f32x4 v0 = acc[ai][bj][m][0] + bv[bj][0], v1 = acc[ai][bj][m][1] + bv[bj][1];
                    if (ACT == 1) { f32x2 a = gelu_pk((f32x2){v0[0], v0[1]}), b = gelu_pk((f32x2){v0[2], v0[3]}), c = gelu_pk((f32x2){v1[0], v1[1]}), d = gelu_pk((f32x2){v1[2], v1[3]});
                        v0 = (f32x4){a.x, a.y, b.x, b.y}; v1 = (f32x4){c.x, c.y, d.x, d.y}; }
                    if (ACT == 2) {
#pragma unroll
                        for (int j = 0; j < 4; ++j) { v0[j] = 0.5f * v0[j] * (1.0f + erff(v0[j] * 0.70710678f)); v1[j] = 0.5f * v1[j] * (1.0f + erff(v1[j] * 0.70710678f)); } }
                    u32x4 w; w.x = cvt_pk_bf16(v0[0], v0[1]); w.y = cvt_pk_bf16(v0[2], v0[3]); w.z = cvt_pk_bf16(v1[0], v1[1]); w.w = cvt_pk_bf16(v1[2], v1[3]);
                    *(u32x4*)(rowp + bj * HALF) = w; } }
    }
};

template <class Epi, class Sched, bool STAMP = false>
__device__ __forceinline__ void gemm_phase(PG8_LAS unsigned char* lds, const Gemm g, const Sched& S, const Epi& E, unsigned long long* stamps) {
    const int tid = TIDX, wid = __builtin_amdgcn_readfirstlane(tid >> 6), lane = tid & 63, wr = wid >> 2, wc = wid & 3, fr = lane & 15, fq = lane >> 4;
    const int K = g.K, nt = K / BK;
    int ts_lo = 0, ts_hi = 0, nts = 0; const unsigned long long rt_entry = STAMP ? (unsigned long long)wall_clock64() : 0ull;
#define PG8_STAMP() do { if (STAMP && wid == 0 && nts < 64) { const unsigned long long _c = (unsigned long long)clock64(); \
        ts_lo = (lane == nts) ? (int)(unsigned)_c : ts_lo; ts_hi = (lane == nts) ? (int)(unsigned)(_c >> 32) : ts_hi; ++nts; } } while (0)
    PG8_STAMP();
    unsigned voffA[2], voffB[2];
#pragma unroll
    for (int i = 0; i < 2; ++i) { int R, C; stage_rc(tid * 16 + i * 8192, R, C); const int Rb = Epi::PERM ? ((R & ~31) + perm32(R & 31)) : R;
        voffA[i] = (unsigned)(R * K + C) * 2u; voffB[i] = (unsigned)(Rb * K + C) * 2u; }
    const size_t kstep = (size_t)(BK * 2);
    const size_t hstep = (size_t)HALF * K * 2;
    const size_t tstep = 2 * hstep;
    const unsigned ldsw = (unsigned)wid * 1024u;
    const int aoff = lds_byte(wr * 64 + fr, fq * 8), boff = lds_byte(wc * 32 + fr, fq * 8);
#define PG8_SA(b, h) (((b) * 2 + (h)) * HTB)
#define PG8_SB(b, h) ((4 + (b) * 2 + (h)) * HTB)
#define PG8_STAGE(bufoff, gbase, voff) do { _Pragma("unroll") for (int _i = 0; _i < 2; ++_i) \
        __builtin_amdgcn_global_load_lds((const unsigned*)((const char*)(gbase) + (voff)[_i]), (PG8_LAS unsigned*)(lds + (bufoff) + ldsw + _i * 8192), 16, 0, 0); } while (0)
#define PG8_LDA(dst, b, h) do { _Pragma("unroll") for (int m = 0; m < 4; ++m) _Pragma("unroll") for (int k = 0; k < 2; ++k) dst[m][k] = *(const PG8_LAS bf16x8*)(lds + PG8_SA(b, h) + aoff + m * 2048 + k * 1024); } while (0)
#define PG8_LDB(dst, b, h) do { _Pragma("unroll") for (int n = 0; n < 2; ++n) _Pragma("unroll") for (int k = 0; k < 2; ++k) dst[n][k] = *(const PG8_LAS bf16x8*)(lds + PG8_SB(b, h) + boff + n * 2048 + k * 1024); } while (0)
#define PG8_MMA(ai, bj, At, Bt) do { __builtin_amdgcn_s_setprio(1); _Pragma("unroll") for (int m = 0; m < 4; ++m) _Pragma("unroll") for (int n = 0; n < 2; ++n) _Pragma("unroll") for (int k = 0; k < 2; ++k) \
        acc[ai][bj][m][n] = __builtin_amdgcn_mfma_f32_16x16x32_bf16(Bt[n][k], At[m][k], acc[ai][bj][m][n], 0, 0, 0); __builtin_amdgcn_s_setprio(0); } while (0)
#define PG8_WAIT_V(n) asm volatile("s_waitcnt vmcnt(" #n ")" ::: "memory")
#define PG8_WAIT_L(n) asm volatile("s_waitcnt lgkmcnt(" #n ")" ::: "memory")
#define PG8_BAR __builtin_amdgcn_s_barrier()
#define PG8_SCHED __builtin_amdgcn_sched_barrier(0)
    Unit cur, nxt; int ui = 0;
    if (!S.next(0, cur)) return;
    f32x4 acc[2][2][4][2];
#pragma unroll
    for (int a = 0; a < 2; ++a)
#pragma unroll
        for (int b = 0; b < 2; ++b)
#pragma unroll
            for (int m = 0; m < 4; ++m)
#pragma unroll
                for (int n = 0; n < 2; ++n) acc[a][b][m][n] = (f32x4){0.f, 0.f, 0.f, 0.f};
    bf16x8 At[4][2], B0[2][2], B1[2][2];
    const char* cA = (const char*)g.A + (size_t)cur.pm * tstep; const char* cB = (const char*)g.Bt + (size_t)cur.pn * tstep;
    S.a_ready(cur);
    PG8_STAGE(PG8_SB(0, 0), cB, voffB); PG8_STAGE(PG8_SA(0, 0), cA, voffA); PG8_STAGE(PG8_SB(0, 1), cB + hstep, voffB); PG8_STAGE(PG8_SA(0, 1), cA + hstep, voffA);
    if (wr == 1) PG8_BAR;
    PG8_WAIT_V(4); PG8_BAR;
    PG8_STAGE(PG8_SB(1, 0), cB + kstep, voffB); PG8_STAGE(PG8_SA(1, 0), cA + kstep, voffA); PG8_STAGE(PG8_SB(1, 1), cB + hstep + kstep, voffB);
    PG8_WAIT_V(6); PG8_BAR;
    PG8_STAMP();
    for (;;) {
        const bool has_next = S.next(ui + 1, nxt);
        const char* nA = has_next ? (const char*)g.A + (size_t)nxt.pm * tstep : cA; const char* nB = has_next ? (const char*)g.Bt + (size_t)nxt.pn * tstep : cB;
        for (int t = 0; t < nt; t += 2) {
            const bool last = (t == nt - 2);
            const char* a1 = cA + (size_t)(t + 1) * kstep;
            const char* a2 = last ? nA : cA + (size_t)(t + 2) * kstep; const char* b2 = last ? nB : cB + (size_t)(t + 2) * kstep;
            const char* a3 = a2 + kstep; const char* b3 = b2 + kstep;
            if (last && has_next) S.a_ready(nxt);
            PG8_LDB(B0, 0, 0); PG8_SCHED; PG8_LDA(At, 0, 0); PG8_STAGE(PG8_SA(1, 1), a1 + hstep, voffA);
            PG8_WAIT_L(8); PG8_BAR; PG8_WAIT_L(0); PG8_MMA(0, 0, At, B0); PG8_BAR; PG8_SCHED;
            PG8_LDB(B1, 0, 1); PG8_STAGE(PG8_SB(0, 0), b2, voffB);
            PG8_BAR; PG8_WAIT_L(0); PG8_MMA(0, 1, At, B1); PG8_BAR;
            PG8_LDA(At, 0, 1); PG8_STAGE(PG8_SA(0, 0), a2, voffA);
            PG8_BAR; PG8_WAIT_L(0); PG8_MMA(1, 0, At, B0); PG8_BAR; PG8_SCHED;
            PG8_STAGE(PG8_SB(0, 1), b2 + hstep, voffB);
            PG8_WAIT_V(6); PG8_BAR; PG8_MMA(1, 1, At, B1); PG8_BAR;
            PG8_LDB(B0, 1, 0); PG8_SCHED; PG8_LDA(At, 1, 0); PG8_STAGE(PG8_SA(0, 1), a2 + hstep, voffA);
            PG8_WAIT_L(8); PG8_BAR; PG8_WAIT_L(0); PG8_MMA(0, 0, At, B0); PG8_BAR; PG8_SCHED;
            PG8_LDB(B1, 1, 1); PG8_STAGE(PG8_SB(1, 0), b3, voffB);
            PG8_BAR; PG8_WAIT_L(0); PG8_MMA(0, 1, At, B1); PG8_BAR;
            PG8_LDA(At, 1, 1); PG8_STAGE(PG8_SA(1, 0), a3, voffA);
            PG8_BAR; PG8_WAIT_L(0); PG8_MMA(1, 0, At, B0); PG8_BAR; PG8_SCHED;
            PG8_STAGE(PG8_SB(1, 1), b3 + hstep, voffB);
            PG8_WAIT_V(6); PG8_BAR; PG8_MMA(1, 1, At, B1); PG8_BAR;
        }
        PG8_STAMP();
        if constexpr (!Epi::AFTER_DRAIN) { E(acc, cur, wr, wc, fr, fq); S.done(cur); }
        PG8_STAMP();
        if (!has_next) break;
#pragma unroll
        for (int a = 0; a < 2; ++a)
#pragma unroll
            for (int b = 0; b < 2; ++b)
#pragma unroll
                for (int m = 0; m < 4; ++m)
#pragma unroll
                    for (int n = 0; n < 2; ++n) acc[a][b][m][n] = (f32x4){0.f, 0.f, 0.f, 0.f};
        cur = nxt; cA = nA; cB = nB; ++ui;
    }
    PG8_WAIT_V(0);
    if (wr == 0) PG8_BAR;
    PG8_BAR;
    if constexpr (Epi::AFTER_DRAIN) { E.fused(acc, cur, wr, wc, fr, fq, lds, wid, lane); S.done(cur); }
    PG8_STAMP();
    if (STAMP && wid == 0) { stamps[lane] = lane < nts ? (((unsigned long long)(unsigned)ts_hi << 32) | (unsigned)ts_lo) : 0ull;
        if (lane == 62) stamps[62] = rt_entry; if (lane == 63) stamps[63] = (unsigned long long)wall_clock64(); }
#undef PG8_STAMP
#undef PG8_SA
#undef PG8_SB
#undef PG8_STAGE
#undef PG8_LDA
#undef PG8_LDB
#undef PG8_MMA
#undef PG8_WAIT_V
#undef PG8_WAIT_L
#undef PG8_BAR
#undef PG8_SCHED
}
}

namespace pg8 {
struct OrderSkipV : StaticOrder {
    __device__ __forceinline__ bool next(int i, Unit& u) const { if (!StaticOrder::next(i, u)) return false; u.pn += (u.pn >= 2) ? 1 : 0; return true; }
};
struct EpiVT {
    static constexpr bool PERM = true, AFTER_DRAIN = false;
    bf16_t* vt; bf16_t* vtc;
    __device__ __forceinline__ void operator()(const f32x4 (&acc)[2][2][4][2], const Unit& u, int wr, int wc, int fr, int fq) const {
        bf16_t* base; int ldc;
        if (u.pn < 128) { base = vt + (size_t)((u.pn >> 4) * 256) * 4096 + (u.pn & 15) * 256; ldc = 4096; }
        else { base = vtc + (size_t)((u.pn - 128) * 256) * 256; ldc = 256; }
        const int row0 = wr * 64 + fr, col0 = wc * 32 + 8 * fq;
#pragma unroll
        for (int ai = 0; ai < 2; ++ai)
#pragma unroll
            for (int m = 0; m < 4; ++m) { bf16_t* rowp = base + (size_t)(row0 + ai * HALF + m * 16) * ldc + col0;
#pragma unroll
                for (int bj = 0; bj < 2; ++bj) { const f32x4 v0 = acc[ai][bj][m][0], v1 = acc[ai][bj][m][1];
                    u32x4 w; w.x = cvt_pk_bf16(v0[0], v0[1]); w.y = cvt_pk_bf16(v0[2], v0[3]); w.z = cvt_pk_bf16(v1[0], v1[1]); w.w = cvt_pk_bf16(v1[2], v1[3]);
                    *(u32x4*)(rowp + bj * HALF) = w; } }
    }
};
struct EpiXinS {
    static constexpr bool PERM = true, AFTER_DRAIN = false;
    bf16_t* O; bf16_t* vg;
    __device__ __forceinline__ void operator()(const f32x4 (&acc)[2][2][4][2], const Unit& u, int wr, int wc, int fr, int fq) const {
        const int row0 = u.pm * BM + wr * 64 + fr;
        const bool su = u.pn == 7;
        const int col0 = u.pn * BM + wc * 32 + 8 * fq;
#pragma unroll
        for (int ai = 0; ai < 2; ++ai)
#pragma unroll
            for (int m = 0; m < 4; ++m) {
                const int tt = row0 + ai * HALF + m * 16;
                bf16_t* rowp = O + (size_t)tt * 2048 + col0;
                const int l = tt & 4095, nch = (tt >> 12) * NCHB + 8 + (l >> 5), j = l & 31;
#pragma unroll
                for (int bj = 0; bj < 2; ++bj) { const f32x4 v0 = acc[ai][bj][m][0], v1 = acc[ai][bj][m][1];
                    u32x4 w; w.x = cvt_pk_bf16(v0[0], v0[1]); w.y = cvt_pk_bf16(v0[2], v0[3]); w.z = cvt_pk_bf16(v1[0], v1[1]); w.w = cvt_pk_bf16(v1[2], v1[3]);
                    if (su) { const int c = wc * 32 + 8 * fq + bj * HALF;
                        *(u32x4*)(vg + ((size_t)(c >> 4) * NCHP + nch) * KV + 256 + j * 16 + (c & 15)) = w; }
                    else *(u32x4*)(rowp + bj * HALF) = w; }
            }
    }
};
struct EpiRes {
    static constexpr bool PERM = false, AFTER_DRAIN = false;
    const float* xl; const float* xc; float* ol; float* oc; const float* g1;
    __device__ __forceinline__ void operator()(const f32x4 (&acc)[2][2][4][2], const Unit& u, int wr, int wc, int fr, int fq) const {
        const int row0 = u.pm * BM + wr * 64 + fr, col0 = u.pn * BM + wc * 32 + 4 * fq;
        const bool lat = u.pm < 128;
        const float* gp = g1 + (size_t)(lat ? (u.pm >> 4) : 8) * 6144 + col0;
        const float* __restrict__ src = lat ? xl : xc - (size_t)32768 * 1024; float* __restrict__ dst = lat ? ol : oc - (size_t)32768 * 1024;
        f32x4 gv[2][2];
#pragma unroll
        for (int bj = 0; bj < 2; ++bj)
#pragma unroll
            for (int n = 0; n < 2; ++n) gv[bj][n] = *(const f32x4*)(gp + bj * HALF + n * 16);
#pragma unroll
        for (int ai = 0; ai < 2; ++ai)
#pragma unroll
            for (int m = 0; m < 4; m += 2) { const size_t off = (size_t)(row0 + ai * HALF + m * 16) * 1024 + col0;
                f32x4 x[2][2][2];
#pragma unroll
                for (int mm = 0; mm < 2; ++mm)
#pragma unroll
                    for (int bj = 0; bj < 2; ++bj)
#pragma unroll
                        for (int n = 0; n < 2; ++n) x[mm][bj][n] = *(const f32x4*)(src + off + (size_t)mm * 16 * 1024 + bj * HALF + n * 16);
#pragma unroll
                for (int mm = 0; mm < 2; ++mm)
#pragma unroll
                    for (int bj = 0; bj < 2; ++bj)
#pragma unroll
                        for (int n = 0; n < 2; ++n) *(f32x4*)(dst + off + (size_t)mm * 16 * 1024 + bj * HALF + n * 16) = x[mm][bj][n] + gv[bj][n] * acc[ai][bj][m + mm][n]; }
    }
};
}

template <int MODE, typename FA, typename FB, typename FE>
__device__ __forceinline__ void gemm128(FA arow, FB brow, int K, FE epi, unsigned char* smem) {
    const int tid = TIDX, lane = tid & 63, w = tid >> 6;
    const int wm = w >> 2, wn = w & 3;
    const bf16_t* pa[2]; const bf16_t* pb[2]; int soff[2];
#pragma unroll
    for (int i = 0; i < 2; ++i) {
        int c = tid + 512 * i, row = c >> 3, kc = c & 7;
        pa[i] = arow(row) + kc * 8; pb[i] = brow(row) + kc * 8;
        soff[i] = row * 128 + ((kc ^ (row & 7)) << 4);
    }
    __syncthreads();
    f32x4 acc[4][2];
#pragma unroll
    for (int i = 0; i < 4; ++i)
#pragma unroll
        for (int j = 0; j < 2; ++j) acc[i][j] = f32x4{0.f, 0.f, 0.f, 0.f};
    uint4 ra[2], rb[2];
#pragma unroll
    for (int i = 0; i < 2; ++i) { ra[i] = *(const uint4*)pa[i]; rb[i] = *(const uint4*)pb[i]; }
#pragma unroll
    for (int i = 0; i < 2; ++i) { *(uint4*)(smem + soff[i]) = ra[i]; *(uint4*)(smem + 16384 + soff[i]) = rb[i]; }
    __syncthreads();
    const int nk = K >> 6;
    const int lr = lane & 15, lg = lane >> 4, sw = lane & 7;
    for (int kt = 0; kt < nk; ++kt) {
        const int cur = kt & 1;
        if (kt + 1 < nk) {
#pragma unroll
            for (int i = 0; i < 2; ++i) { ra[i] = *(const uint4*)(pa[i] + (kt + 1) * 64); rb[i] = *(const uint4*)(pb[i] + (kt + 1) * 64); }
        }
        const unsigned char* sA = smem + cur * 32768;
        const unsigned char* sB = sA + 16384;
#pragma unroll
        for (int ks = 0; ks < 2; ++ks) {
            bf16x8 af[4], bfv[2];
            const int choff = (((ks * 4 + lg) ^ sw) << 4);
#pragma unroll
            for (int fi = 0; fi < 4; ++fi) af[fi] = *(const bf16x8*)(sA + (wm * 64 + fi * 16 + lr) * 128 + choff);
#pragma unroll
            for (int fj = 0; fj < 2; ++fj) bfv[fj] = *(const bf16x8*)(sB + (wn * 32 + fj * 16 + lr) * 128 + choff);
#pragma unroll
            for (int fi = 0; fi < 4; ++fi)
#pragma unroll
                for (int fj = 0; fj < 2; ++fj) acc[fi][fj] = __builtin_amdgcn_mfma_f32_16x16x32_bf16(af[fi], bfv[fj], acc[fi][fj], 0, 0, 0);
        }
        if (kt + 1 < nk) {
            unsigned char* dA = smem + (cur ^ 1) * 32768;
#pragma unroll
            for (int i = 0; i < 2; ++i) { *(uint4*)(dA + soff[i]) = ra[i]; *(uint4*)(dA + 16384 + soff[i]) = rb[i]; }
        }
        __syncthreads();
    }
    if (MODE == 2) {
#pragma unroll
        for (int fi = 0; fi < 4; ++fi)
#pragma unroll
            for (int fj = 0; fj < 2; ++fj) epi(wm * 64 + fi * 16 + lg * 4, wn * 32 + fj * 16 + lr, acc[fi][fj]);
    } else if (MODE == 1) {
        float* tc = (float*)smem;
#pragma unroll
        for (int fi = 0; fi < 4; ++fi)
#pragma unroll
            for (int fj = 0; fj < 2; ++fj)
#pragma unroll
                for (int j = 0; j < 4; ++j) tc[(wm * 64 + fi * 16 + lg * 4 + j) * 129 + wn * 32 + fj * 16 + lr] = acc[fi][fj][j];
        __syncthreads();
    } else {
#pragma unroll
        for (int fi = 0; fi < 4; ++fi)
#pragma unroll
            for (int fj = 0; fj < 2; ++fj)
#pragma unroll
                for (int j = 0; j < 4; ++j) epi(wm * 64 + fi * 16 + lg * 4 + j, wn * 32 + fj * 16 + lr, f32x4{acc[fi][fj][j], 0.f, 0.f, 0.f});
    }
}

__device__ void phase_prep(const Params& p, unsigned char* smem, int part) {
    const int tid = TIDX, lane = tid & 63, w = tid >> 6;
    unsigned char* ws = p.ws;
    constexpr int N_MOD = 192, N_TR = 1568, N_WQK = 512, N_DFTL = 0, N_DFTS = 32, N_S5T = 8;
    constexpr int O_TR = N_MOD, O_WQK = O_TR + N_TR, O_DFTL = O_WQK + N_WQK, O_DFTS = O_DFTL + N_DFTL, O_S5T = O_DFTS + N_DFTS, N_ALL = O_S5T + N_S5T;
    float* tab = (float*)(smem + 98304);
    if (part == 1) {
        for (int j = tid; j < 4096; j += NTHREADS) tab[j] = cospif((float)j * (1.0f / 2048.0f));
        __syncthreads();
    }
    for (int it = BIDX; it < N_ALL; it += gridDim.x) {
        if (((it < O_TR || it >= O_S5T) ? 0 : 1) != part) continue;
        if (it < O_TR) {
            const int L = it / 96, c0 = (it % 96) * 64;
            float* sv = (float*)smem;
            float* red = (float*)(smem + 36864);
            for (int idx = tid; idx < 9 * 1024; idx += NTHREADS) {
                int r = idx >> 10, k = idx & 1023;
                float v = (r < 8) ? p.in[I_C][r * 1024 + k] : p.in[I_CCTX][k];
                sv[idx] = v / (1.0f + __expf(-v));
            }
            __syncthreads();
            float acc[9];
#pragma unroll
            for (int r = 0; r < 9; ++r) acc[r] = 0.f;
            const float* aw = p.in[I_ADAW] + (size_t)L * 1024 * 6144 + c0 + lane;
#pragma unroll 1
            for (int k0 = w * 128; k0 < w * 128 + 128; k0 += 16) {
                float wv[16];
#pragma unroll
                for (int u = 0; u < 16; ++u) wv[u] = aw[(size_t)(k0 + u) * 6144];
#pragma unroll
                for (int u = 0; u < 16; ++u)
#pragma unroll
                    for (int r = 0; r < 9; ++r) acc[r] += sv[r * 1024 + k0 + u] * wv[u];
            }
#pragma unroll
            for (int r = 0; r < 9; ++r) red[(w * 9 + r) * 64 + lane] = acc[r];
            __syncthreads();
            for (int o = tid; o < 576; o += NTHREADS) {
                int r = o >> 6, col = o & 63;
                float s = 0.f;
#pragma unroll
                for (int ww = 0; ww < 8; ++ww) s += red[(ww * 9 + r) * 64 + col];
                ((float*)(ws + OFF_MOD))[(size_t)(L * 9 + r) * 6144 + c0 + col] = s + p.in[I_ADAB][L * 6144 + c0 + col];
            }
            __syncthreads();
        } else if (it < O_WQK) {
            int idx = it - O_TR;
            const int L = idx / 784; int rem = idx % 784;
            const float* src; bf16_t* dst; int Kd, Nd, tk, tn;
            if (rem < 512) { tk = rem >> 5; tn = rem & 31; Kd = 1024; Nd = 2048; src = p.in[I_WIN] + (size_t)L * 1024 * 2048; dst = (bf16_t*)(ws + OFF_WINT + L * SZ_WINT); }
            else if (rem < 768) { rem -= 512; tk = rem >> 4; tn = rem & 15; Kd = 1024; Nd = 1024; src = p.in[I_WOUT] + (size_t)L * 1024 * 1024; dst = (bf16_t*)(ws + OFF_WOUTT + L * SZ_WOUTT); }
            else { rem -= 768; tk = rem >> 2; tn = rem & 3; Kd = 256; Nd = 256; src = p.in[I_WGLU] + (size_t)L * 256 * 256; dst = (bf16_t*)(ws + OFF_WGLUT + L * SZ_WGLUT); }
            float* tl = (float*)smem;
#pragma unroll
            for (int i = 0; i < 8; ++i) { int kk = i * 8 + w, nn = lane; tl[kk * 65 + nn] = src[(size_t)(tk * 64 + kk) * Nd + tn * 64 + nn]; }
            __syncthreads();
#pragma unroll
            for (int i = 0; i < 8; ++i) { int nn = i * 8 + w, kk = lane; dst[(size_t)(tn * 64 + nn) * Kd + tk * 64 + kk] = f2bf(tl[kk * 65 + nn]); }
            __syncthreads();
        } else if (it < O_DFTL) {
            int idx = it - O_WQK;
            const int L = idx >> 8, hz = (idx >> 4) & 15, kb = idx & 15;
            const int lr = lane & 15, g = lane >> 4;
            const float* keysr = p.in[I_KEYS] + ((size_t)(L * 16 + hz) * 128 + w * 16 + lr) * 128 + 32 * g;
            float af[32];
#pragma unroll
            for (int u = 0; u < 8; ++u) { const float4 v = *(const float4*)(keysr + 4 * u); af[4 * u] = v.x; af[4 * u + 1] = v.y; af[4 * u + 2] = v.z; af[4 * u + 3] = v.w; }
            bf16_t* dst = (bf16_t*)(ws + OFF_WQKT + L * SZ_WQKT);
#pragma unroll 1
            for (int kt = 0; kt < 4; ++kt) {
                const int k0 = kb * 64 + kt * 16;
                const float* wqr = p.in[I_WQ] + (size_t)L * 1024 * 2048 + (size_t)(k0 + lr) * 2048 + hz * 128 + 32 * g;
                float bfv[32];
#pragma unroll
                for (int u = 0; u < 8; ++u) { const float4 v = *(const float4*)(wqr + 4 * u); bfv[4 * u] = v.x; bfv[4 * u + 1] = v.y; bfv[4 * u + 2] = v.z; bfv[4 * u + 3] = v.w; }
                f32x4 acc = f32x4{0.f, 0.f, 0.f, 0.f};
#pragma unroll
                for (int s = 0; s < 32; ++s) acc = __builtin_amdgcn_mfma_f32_16x16x4f32(af[s], bfv[s], acc, 0, 0, 0);
#pragma unroll
                for (int j = 0; j < 4; ++j) dst[(size_t)(hz * 128 + w * 16 + 4 * g + j) * 1024 + k0 + lr] = f2bf(acc[j]);
            }
        } else if (it < O_DFTS) {
            const int k = it - O_DFTL;
            bf16_t* dst = (bf16_t*)(ws + OFF_DFTL) + (size_t)k * 8192;
#pragma unroll
            for (int i = 0; i < 2; ++i) {
                int c = tid + 512 * i, part = c >> 9, l0 = (c & 511) * 8;
                unsigned pk[4];
#pragma unroll
                for (int e = 0; e < 4; ++e) {
                    int i0 = ((k * (l0 + 2 * e)) + part * 1024) & 4095, i1 = ((k * (l0 + 2 * e + 1)) + part * 1024) & 4095;
                    pk[e] = pack2(tab[i0] * (1.0f / 512.0f), tab[i1] * (1.0f / 512.0f));
                }
                *(uint4*)(dst + part * 4096 + l0) = make_uint4(pk[0], pk[1], pk[2], pk[3]);
            }
        } else if (it < O_S5T) {
            const int dsub = it - O_DFTS;
            bf16_t* dc = (bf16_t*)(ws + OFF_DFTC);
            for (int c = tid + NTHREADS * dsub; c < 16384; c += NTHREADS * N_DFTS) {
                int k = c >> 6, cc = c & 63, part = cc >> 5, l0 = (cc & 31) * 8;
                unsigned pk[4];
#pragma unroll
                for (int e = 0; e < 4; ++e) {
                    int i0 = ((((k * (l0 + 2 * e)) & 255) << 4) + part * 3072) & 4095, i1 = ((((k * (l0 + 2 * e + 1)) & 255) << 4) + part * 3072) & 4095;
                    pk[e] = pack2(tab[i0] * (1.0f / 128.0f), tab[i1] * (1.0f / 128.0f));
                }
                *(uint4*)(dc + (size_t)k * 512 + part * 256 + l0) = make_uint4(pk[0], pk[1], pk[2], pk[3]);
            }
            bf16_t* dd = (bf16_t*)(ws + OFF_DFTD);
            for (int c = tid + NTHREADS * dsub; c < 1024; c += NTHREADS * N_DFTS) {
                int m = c >> 3, d0 = (c & 7) * 8, kd = m & 63, sh = (m >= 64) ? 1024 : 0;
                unsigned pk[4];
#pragma unroll
                for (int e = 0; e < 4; ++e) {
                    int i0 = ((((kd * (d0 + 2 * e)) & 63) << 6) + sh) & 4095, i1 = ((((kd * (d0 + 2 * e + 1)) & 63) << 6) + sh) & 4095;
                    pk[e] = pack2(tab[i0], tab[i1]);
                }
                *(uint4*)(dd + m * 64 + d0) = make_uint4(pk[0], pk[1], pk[2], pk[3]);
            }
            bf16_t* mab = (bf16_t*)(ws + OFF_MATAB); bf16_t* mad = (bf16_t*)(ws + OFF_MATAD);
            for (int c = tid + NTHREADS * dsub; c < 128 * 128; c += NTHREADS * N_DFTS) {
                const int m = c >> 7, k = c & 127;
                { const int k1 = m >> 1, ri = m & 1, rz = k >> 6, l1 = k & 63, ph = ((k1 * l1) & 63) << 6;
                  const int idx = (ri == rz) ? ph : (ri == 0 ? ph + 3072 : ph + 1024);
                  mab[c] = f2bf(tab[idx & 4095]); }
                { const int k2 = m & 63, ri = k >> 6, l2 = k & 63, ph = ((k2 * l2) & 63) << 6;
                  mad[c] = f2bf(tab[(ph + (ri ? 3072 : 0)) & 4095]); }
            }
            float2* tw = (float2*)(ws + OFF_TW);
            for (int c = tid + NTHREADS * dsub; c < 4096; c += NTHREADS * N_DFTS) {
                const int k1 = c >> 6, l2 = c & 63, ph = (k1 * l2) & 4095;
                tw[c] = make_float2(tab[ph] * (1.0f / 512.0f), tab[(ph + 3072) & 4095] * (1.0f / 512.0f));
            }
        } else {
            const int gid = (it - O_S5T) * NTHREADS + tid;
            const int ia = gid;
            const float are = p.in[I_ARE][ia], aim = p.in[I_AIM][ia];
            const float dt = expf(p.in[I_LOGDT][ia >> 6]);
            float2* pw = (float2*)(ws + OFF_POWA) + (size_t)(ia >> 6) * 33 * 64 + (ia & 63);
            float abr = 1.f, abi = 0.f;
            for (int tau = 0; tau <= 32; ++tau) {
                float mag = expf(are * dt * (float)tau), s, c;
                sincosf(aim * dt * (float)tau, &s, &c);
                pw[tau * 64] = make_float2(mag * c, mag * s);
                if (tau == 1) { abr = mag * c; abi = mag * s; }
            }
            const float nr = abr - 1.0f, ni = abi, den = are * are + aim * aim;
            const float qr = (nr * are + ni * aim) / den, qi = (ni * are - nr * aim) / den;
            float2* bb = (float2*)(ws + OFF_BBAR) + (size_t)ia * 16;
#pragma unroll
            for (int h = 0; h < 16; ++h) {
                float br = p.in[I_BRE][(size_t)ia * 16 + h], bi = p.in[I_BIM][(size_t)ia * 16 + h];
                bb[h] = make_float2(qr * br - qi * bi, qr * bi + qi * br);
            }
        }
    }
}

__device__ void norm_tokens(const Params& p, int L, int which, int ntok, bool from_input, int item0, int nitems_total) {
    const int tid = TIDX, lane = tid & 63, w = tid >> 6;
    const float* modL = (const float*)(p.ws + OFF_MOD) + (size_t)L * 9 * 6144;
    const float* gvec = p.in[which ? I_N2G : I_N1G] + L * 1024;
    bf16_t* dst = (bf16_t*)(p.ws + OFF_ACT);
    for (int it = item0 + BIDX; it < nitems_total; it += gridDim.x) {
        if (it < item0) continue;
        const int tt = (it - item0) * 8 + w;
        if (tt >= ntok) continue;
        const float* src;
        if (tt < T) src = (from_input ? p.in[I_X] : p.out) + (size_t)tt * 1024;
        else src = (from_input ? p.in[I_CTX] : (const float*)(p.ws + OFF_XCTX)) + (size_t)(tt - T) * 1024;
        const float* sh = modL + (size_t)tok_modrow(tt) * 6144 + (which ? 3072 : 0);
        const float* sc = sh + 1024;
        float4 v[4]; float ss = 0.f;
#pragma unroll
        for (int i = 0; i < 4; ++i) { v[i] = *(const float4*)(src + (i * 64 + lane) * 4); ss += v[i].x * v[i].x + v[i].y * v[i].y + v[i].z * v[i].z + v[i].w * v[i].w; }
        ss = wave_sum(ss);
        const float r = rsqrtf(ss * (1.0f / 1024.0f) + EPS);
#pragma unroll
        for (int i = 0; i < 4; ++i) {
            const int k = (i * 64 + lane) * 4;
            float4 g = *(const float4*)(gvec + k), a = *(const float4*)(sc + k), b = *(const float4*)(sh + k);
            float o0 = v[i].x * r * g.x * (1.f + a.x) + b.x, o1 = v[i].y * r * g.y * (1.f + a.y) + b.y;
            float o2 = v[i].z * r * g.z * (1.f + a.z) + b.z, o3 = v[i].w * r * g.w * (1.f + a.w) + b.w;
            *(uint2*)(dst + (size_t)tt * 1024 + k) = make_uint2(pack2(o0, o1), pack2(o2, o3));
            if (which) {
                int wd = 0;
                const float c0 = fminf(fmaxf(o0 * 8.0f, -448.0f), 448.0f), c1 = fminf(fmaxf(o1 * 8.0f, -448.0f), 448.0f);
                const float c2 = fminf(fmaxf(o2 * 8.0f, -448.0f), 448.0f), c3 = fminf(fmaxf(o3 * 8.0f, -448.0f), 448.0f);
                wd = __builtin_amdgcn_cvt_pk_fp8_f32(c0, c1, wd, false);
                wd = __builtin_amdgcn_cvt_pk_fp8_f32(c2, c3, wd, true);
                *(int*)(p.ws + OFF_H8 + (size_t)tt * 1024 + k) = wd;
            }
        }
    }
}

__device__ void phase_A(const Params& p, int L, unsigned char* smem) {
    if (L == 0) { phase_prep(p, smem, 1); __syncthreads(); }
    const int n_norm = TT / 8;
    const int n_kt = (L == 0) ? 1024 : 0;
    for (int it = BIDX; it < n_kt; it += gridDim.x) {
        const int gid = it * NTHREADS + TIDX;
        const int hp = gid & 15, h = (gid >> 4) & 15, tau = (gid >> 8) & 31, ldg = gid >> 13;
        const float* cre = p.in[I_CRE] + ((size_t)ldg * 16 + h) * 64;
        const float* cim = p.in[I_CIM] + ((size_t)ldg * 16 + h) * 64;
        const float2* pw = (const float2*)(p.ws + OFF_POWA) + ((size_t)ldg * 33 + tau) * 64;
        const float2* bb = (const float2*)(p.ws + OFF_BBAR) + (size_t)ldg * 64 * 16 + hp;
        float acc = 0.f;
#pragma unroll 1
        for (int q0 = 0; q0 < 64; q0 += 16) {
            float2 a[16], b[16]; float cr[16], ci[16];
#pragma unroll
            for (int u = 0; u < 4; ++u) {
                const float4 c4 = *(const float4*)(cre + q0 + 4 * u), d4 = *(const float4*)(cim + q0 + 4 * u);
                cr[4 * u] = c4.x; cr[4 * u + 1] = c4.y; cr[4 * u + 2] = c4.z; cr[4 * u + 3] = c4.w;
                ci[4 * u] = d4.x; ci[4 * u + 1] = d4.y; ci[4 * u + 2] = d4.z; ci[4 * u + 3] = d4.w;
            }
#pragma unroll
            for (int u = 0; u < 16; ++u) { a[u] = pw[q0 + u]; b[u] = bb[(q0 + u) * 16]; }
#pragma unroll
            for (int u = 0; u < 16; ++u) {
                const float wr = cr[u] * a[u].x - ci[u] * a[u].y, wi = cr[u] * a[u].y + ci[u] * a[u].x;
                acc += wr * b[u].x - wi * b[u].y;
            }
        }
        ((float*)(p.ws + OFF_KTAU))[gid] = acc;
    }
    norm_tokens(p, L, 0, TT, L == 0, n_kt, n_kt + n_norm);
}

__device__ void phase_B(const Params& p, int L, unsigned char* smem) {
    unsigned char* ws = p.ws;
    constexpr int N_G = 256, N_WC = 1536, N_WS = 512;
    const bf16_t* A = (const bf16_t*)(ws + OFF_ACT);
    const bf16_t* Bt = (const bf16_t*)(ws + OFF_WINT + L * SZ_WINT);
    bf16_t* xin = (bf16_t*)(ws + OFF_XIN);
    {
        PG8_LAS unsigned char* lds = (PG8_LAS unsigned char*)smem;
        const int bid = BIDX;
        pg8::Gemm g1{A, Bt, T, 1792, 1024};
        pg8::OrderSkipV s1; s1.init(T, 1792, (int)gridDim.x, bid);
        pg8::EpiXinS e1{xin, (bf16_t*)(ws + OFF_VG)};
        pg8::gemm_phase(lds, g1, s1, e1, nullptr);
        pg8::Gemm g2{Bt + (size_t)512 * 1024, A, 256, T, 1024};
        pg8::StaticOrder s2; s2.init(256, T, (int)gridDim.x, (bid + 128) & 255);
        pg8::EpiVT e2{(bf16_t*)(ws + OFF_VT), (bf16_t*)(ws + OFF_VTC)};
        pg8::gemm_phase(lds, g2, s2, e2, nullptr);
        __syncthreads();
    }
    for (int it = BIDX; it < N_G + N_WC + N_WS; it += gridDim.x) {
        if (it < N_G) {
            const int mt = 256 + (it >> 4), nt = it & 15;
            if (nt == 4 || nt == 5) {
                bf16_t* vtc = (bf16_t*)(ws + OFF_VTC);
                const int c = mt * 128 - T;
                bf16_t* base = vtc + (size_t)((c >> 8) * 256) * 256 + (c & 255);
                gemm128<0>([&](int r) { return Bt + (size_t)(nt * 128 + r) * 1024; },
                           [&](int r) { return A + (size_t)(mt * 128 + r) * 1024; }, 1024,
                           [&](int m, int n, f32x4 vv) { base[(size_t)((nt - 4) * 128 + m) * 256 + n] = f2bf(vv[0]); }, smem);
            } else if (nt >= 14) {
                bf16_t* vgp = (bf16_t*)(ws + OFF_VG);
                gemm128<0>([&](int r) { return A + (size_t)(mt * 128 + r) * 1024; },
                           [&](int r) { return Bt + (size_t)(nt * 128 + r) * 1024; }, 1024,
                           [&](int m, int n, f32x4 vv) { const int c = mt * 128 + m - T, cc = (nt - 14) * 128 + n;
                               const int nch = (c >> 8) * NCHB + ((c & 255) >> 5), j = c & 31;
                               vgp[((size_t)(cc >> 4) * NCHP + nch) * KV + 256 + j * 16 + (cc & 15)] = f2bf(vv[0]); }, smem);
            } else {
                gemm128<0>([&](int r) { return A + (size_t)(mt * 128 + r) * 1024; },
                           [&](int r) { return Bt + (size_t)(nt * 128 + r) * 1024; }, 1024,
                           [&](int m, int n, f32x4 vv) { xin[(size_t)(mt * 128 + m) * 2048 + nt * 128 + n] = f2bf(vv[0]); }, smem);
            }
        } else if (it < N_G + N_WC) {
            const int cid = (it - N_G) * NTHREADS + TIDX;
            const int kc = cid % 96, m = (cid / 96) & 511, g = cid / (96 * 512);
            const int i = m >> 4, h = m & 15;
            float vals[8];
            if (kc < 32) {
                const int dr = kc >> 4, ri = (kc >> 3) & 1, p0 = (kc & 7) * 8;
                const int ldg = (L * 2 + dr) * 16 + g;
                const int e = dr == 0 ? (i + 1) : (32 - i);
                const float2* pw = (const float2*)(ws + OFF_POWA) + ((size_t)ldg * 33 + e) * 64 + p0;
                const float* cre = p.in[I_CRE] + ((size_t)ldg * 16 + h) * 64 + p0;
                const float* cim = p.in[I_CIM] + ((size_t)ldg * 16 + h) * 64 + p0;
#pragma unroll
                for (int q = 0; q < 8; ++q) {
                    float2 a = pw[q]; float cr = cre[q], ci = cim[q];
                    float wr = cr * a.x - ci * a.y, wi = cr * a.y + ci * a.x;
                    vals[q] = ri == 0 ? wr : -wi;
                }
            } else {
                const int kk = (kc - 32) * 8, j = kk >> 4, h0 = kk & 15;
                const float* kf = (const float*)(ws + OFF_KTAU) + (size_t)((L * 2 + 0) * 16 + g) * 32 * 256;
                const float* kb = (const float*)(ws + OFF_KTAU) + (size_t)((L * 2 + 1) * 16 + g) * 32 * 256;
#pragma unroll
                for (int q = 0; q < 8; ++q) {
                    float v = 0.f;
                    if (j <= i) v += kf[((i - j) * 16 + h) * 16 + h0 + q];
                    if (j >= i) v += kb[((j - i) * 16 + h) * 16 + h0 + q];
                    vals[q] = v;
                }
            }
            bf16_t* dst = (bf16_t*)(ws + OFF_WCOMB) + ((size_t)g * 512 + m) * KV + kc * 8;
            *(uint4*)dst = make_uint4(pack2(vals[0], vals[1]), pack2(vals[2], vals[3]), pack2(vals[4], vals[5]), pack2(vals[6], vals[7]));
        } else {
            const int cid = (it - N_G - N_WC) * NTHREADS + TIDX;
            const int kc = cid & 63, m = (cid >> 6) & 255, g = cid >> 14;
            const int dr = m >> 7, ri = (m >> 6) & 1, pp = m & 63;
            const int j = kc >> 1, h0 = (kc & 1) * 8;
            const int ldg = (L * 2 + dr) * 16 + g;
            const int e = dr == 0 ? (31 - j) : j;
            const float2 a = ((const float2*)(ws + OFF_POWA))[((size_t)ldg * 33 + e) * 64 + pp];
            const float2* bb = (const float2*)(ws + OFF_BBAR) + ((size_t)ldg * 64 + pp) * 16 + h0;
            float vals[8];
#pragma unroll
            for (int q = 0; q < 8; ++q) { float2 b = bb[q]; vals[q] = ri == 0 ? (a.x * b.x - a.y * b.y) : (a.x * b.y + a.y * b.x); }
            bf16_t* dst = (bf16_t*)(ws + OFF_WST) + ((size_t)g * 256 + m) * 512 + kc * 8;
            *(uint4*)dst = make_uint4(pack2(vals[0], vals[1]), pack2(vals[2], vals[3]), pack2(vals[4], vals[5]), pack2(vals[6], vals[7]));
        }
    }
}

struct AttnStep { bf16x8 kf[4][2]; };

__device__ __forceinline__ void attn_mfma_item(const Params& p, int L, int item, const float* rpb_lds) {
    const int lane = TIDX & 63, lr = lane & 15, g = lane >> 4;
    item = __builtin_amdgcn_readfirstlane(item);
    const bf16_t* xin = (const bf16_t*)(p.ws + OFF_XIN);
    bf16_t* ymix = (bf16_t*)(p.ws + OFF_YMIX);
    int b, h, r = 0, qt0 = 0, qbase;
    const bool lat = item < 4096;
    if (lat) { const int qp = item & 1; h = (item >> 1) & 3; r = (item >> 3) & 63; b = item >> 9; qt0 = 2 * qp; qbase = b * 4096 + r * 64 + qt0 * 16; }
    else { const int q = item - 4096; h = (q >> 3) & 3; b = q >> 5; qbase = T + b * 256 + (q & 7) * 32; }
    const int nsteps = lat ? 12 : 4;
    bf16x8 qf[2][2];
#pragma unroll
    for (int tq = 0; tq < 2; ++tq)
#pragma unroll
        for (int ks = 0; ks < 2; ++ks) qf[tq][ks] = *(const bf16x8*)(xin + (size_t)(qbase + tq * 16 + lr) * 2048 + h * 64 + ks * 32 + g * 8);
    const bf16_t* kctx = xin + (size_t)(T + b * 256) * 2048 + 256 + h * 64;
    const bf16_t* klat = xin + (size_t)(b * 4096) * 2048 + 256 + h * 64;
    const bf16_t* vtc = (const bf16_t*)(p.ws + OFF_VTC) + (size_t)((b * 4 + h) * 64) * 256;
    const bf16_t* vtl = (const bf16_t*)(p.ws + OFF_VT) + (size_t)((b * 4 + h) * 64) * 4096;
    const int rs = min(max(r - 4, 0), 56);
    const float* rpbh = rpb_lds + h * 465;
    f32x4 o[2][4];
    float mrun[2], lsum[2];
#pragma unroll
    for (int tq = 0; tq < 2; ++tq) {
        mrun[tq] = -3.0e38f; lsum[tq] = 0.f;
#pragma unroll
        for (int dt = 0; dt < 4; ++dt) o[tq][dt] = f32x4{0.f, 0.f, 0.f, 0.f};
    }
    const unsigned koff = (unsigned)(lr * 4096 + g * 16);
    const unsigned voffc = (unsigned)(lr * 512 + g * 8), voffl = (unsigned)(lr * 8192 + g * 8);
    uint2 vf[2][4][2];
    auto load_k = [&](int s, AttnStep& st) {
        const unsigned char* kb = (s < 4) ? (const unsigned char*)(kctx + (size_t)(s * 64) * 2048) : (const unsigned char*)(klat + (size_t)((rs + s - 4) * 64) * 2048);
#pragma unroll
        for (int kt = 0; kt < 4; ++kt)
#pragma unroll
            for (int ks = 0; ks < 2; ++ks) st.kf[kt][ks] = *(const bf16x8*)(kb + kt * 65536 + ks * 64 + koff);
    };
    auto load_v = [&](int s) {
        if (s < 4) {
            const unsigned char* vb = (const unsigned char*)(vtc + s * 64);
#pragma unroll
            for (int u = 0; u < 2; ++u)
#pragma unroll
                for (int dt = 0; dt < 4; ++dt) { vf[u][dt][0] = *(const uint2*)(vb + dt * 8192 + u * 64 + voffc); vf[u][dt][1] = *(const uint2*)(vb + dt * 8192 + u * 64 + voffc + 32); }
        } else {
            const unsigned char* vb = (const unsigned char*)(vtl + (rs + s - 4) * 64);
#pragma unroll
            for (int u = 0; u < 2; ++u)
#pragma unroll
                for (int dt = 0; dt < 4; ++dt) { vf[u][dt][0] = *(const uint2*)(vb + dt * 131072 + u * 64 + voffl); vf[u][dt][1] = *(const uint2*)(vb + dt * 131072 + u * 64 + voffl + 32); }
        }
    };
    auto compute_step = [&](int s, const AttnStep& st) {
#pragma unroll
        for (int u = 0; u < 2; ++u)
#pragma unroll
            for (int tq = 0; tq < 2; ++tq) {
                const int qt = qt0 + tq;
                if (s >= 4 && ((qt == 0 && u == 1) || (qt == 3 && u == 0))) continue;
                f32x4 sa[2];
#pragma unroll
                for (int t = 0; t < 2; ++t) {
                    sa[t] = f32x4{0.f, 0.f, 0.f, 0.f};
#pragma unroll
                    for (int ks = 0; ks < 2; ++ks) sa[t] = __builtin_amdgcn_mfma_f32_16x16x32_bf16(st.kf[2 * u + t][ks], qf[tq][ks], sa[t], 0, 0, 0);
                }
                float sc[8];
#pragma unroll
                for (int t = 0; t < 2; ++t)
#pragma unroll
                    for (int j = 0; j < 4; ++j) sc[t * 4 + j] = sa[t][j] * 0.125f;
                if (s >= 4) {
                    const int cq = qt * 16 + lr, cs = min(max(cq - 8, 0), 48);
                    const float* rp = rpbh + (rs + s - 4 - r + 7) * 31 + 15 - cq;
#pragma unroll
                    for (int t = 0; t < 2; ++t)
#pragma unroll
                        for (int j = 0; j < 4; ++j) {
                            const int kc = u * 32 + t * 16 + 4 * g + j;
                            const bool valid = (unsigned)(kc - cs) < 16u;
                            const float bias = rp[min(max(kc, cq - 15), cq + 15)];
                            sc[t * 4 + j] = valid ? (sc[t * 4 + j] + bias) : -1.0e30f;
                        }
                }
                float bm = fmaxf(fmaxf(fmaxf(sc[0], sc[1]), fmaxf(sc[2], sc[3])), fmaxf(fmaxf(sc[4], sc[5]), fmaxf(sc[6], sc[7])));
                bm = max16(bm); bm = max32(bm);
                const float mn = fmaxf(mrun[tq], bm);
                const float corr = __expf(mrun[tq] - mn);
                mrun[tq] = mn; lsum[tq] *= corr;
#pragma unroll
                for (int dt = 0; dt < 4; ++dt) { o[tq][dt][0] *= corr; o[tq][dt][1] *= corr; o[tq][dt][2] *= corr; o[tq][dt][3] *= corr; }
                float pr[8];
#pragma unroll
                for (int i = 0; i < 8; ++i) { pr[i] = __expf(sc[i] - mn); lsum[tq] += pr[i]; }
                const uint4 pbu = make_uint4(pack2(pr[0], pr[1]), pack2(pr[2], pr[3]), pack2(pr[4], pr[5]), pack2(pr[6], pr[7]));
                const bf16x8 pb = __builtin_bit_cast(bf16x8, pbu);
#pragma unroll
                for (int dt = 0; dt < 4; ++dt) {
                    const uint4 vu = make_uint4(vf[u][dt][0].x, vf[u][dt][0].y, vf[u][dt][1].x, vf[u][dt][1].y);
                    o[tq][dt] = __builtin_amdgcn_mfma_f32_16x16x32_bf16(__builtin_bit_cast(bf16x8, vu), pb, o[tq][dt], 0, 0, 0);
                }
            }
    };

    AttnStep sA, sB;
    load_k(0, sA); load_v(0);
#pragma unroll 1
    for (int s = 0; s < nsteps; s += 2) {
        load_k(s + 1, sB);
        compute_step(s, sA);
        load_v(s + 1);
        if (s + 2 < nsteps) load_k(s + 2, sA);
        compute_step(s + 1, sB);
        if (s + 2 < nsteps) load_v(s + 2);
    }
#pragma unroll
    for (int tq = 0; tq < 2; ++tq) {
        float ls = lsum[tq];
        ls = bfly16(ls, ls); ls = bfly32(ls, ls);
        const float inv = 1.0f / ls;
#pragma unroll
        for (int dt = 0; dt < 4; ++dt)
            *(uint2*)(ymix + (size_t)(qbase + tq * 16 + lr) * 1024 + h * 64 + dt * 16 + 4 * g) =
                make_uint2(pack2(o[tq][dt][0] * inv, o[tq][dt][1] * inv), pack2(o[tq][dt][2] * inv, o[tq][dt][3] * inv));
    }
}

__device__ void phase_C(const Params& p, int L, unsigned char* smem) {
    unsigned char* ws = p.ws;
    const int tid = TIDX, w = tid >> 6;
    const bf16_t* xin = (const bf16_t*)(ws + OFF_XIN);
    bf16_t* ymix = (bf16_t*)(ws + OFF_YMIX);
    const int n_attn_w = (L == 0) ? 4096 + 256 : 4096;
    float* rpb_lds = (float*)(smem + 70016);
    for (int i = tid; i < 4 * 465; i += NTHREADS) rpb_lds[i] = p.in[I_RPB][(size_t)L * 4 * 465 + i];
    __syncthreads();
    const int N_ATT = (n_attn_w + 7) / 8;
    const int N_F1 = 1024 + ((L == 0) ? 64 : 0);
    const int N_CONV = TT * 32 / NTHREADS;
    const int N_S1 = 288;
    const int O_F1 = N_ATT, O_CONV = O_F1 + N_F1, O_S1 = O_CONV + N_CONV, N_ALL = O_S1 + N_S1;
    for (int it = BIDX; it < N_ALL; it += gridDim.x) {
        if (it < O_F1) {
            const int item = it * 8 + w;
            if (item < n_attn_w) attn_mfma_item(p, L, item, rpb_lds);
        } else if (it < O_CONV) {
            int idx = it - O_F1;
            const bf16_t* dd = (const bf16_t*)(ws + OFF_DFTD);
            if (idx < 1024) {
                const int b = idx >> 7, h = (idx >> 5) & 3, nt = idx & 31;
                bf16_t* zt = (bf16_t*)(ws + OFF_ZT);
                gemm128<0>([&](int r) { return dd + r * 64; },
                               [&](int r) { const int n = nt * 128 + r; return xin + (size_t)(b * 4096 + 64 * (n & 63) + (n >> 6)) * 2048 + 1536 + h * 64; }, 64,
                               [&](int m, int n, f32x4 vv) { const float v = vv[0]; const int nn = nt * 128 + n;
                                   zt[(((size_t)(b * 256 + h * 64 + (m & 63)) * 64 + (nn >> 6)) * 2 + (m >> 6)) * 64 + (nn & 63)] = f2bf(v); }, smem);
            } else {
                idx -= 1024;
                const int b = idx >> 3, h = (idx >> 1) & 3, nt = idx & 1;
                bf16_t* zt = (bf16_t*)(ws + OFF_ZTC);
                gemm128<0>([&](int r) { return dd + r * 64; },
                               [&](int r) { return xin + (size_t)(T + b * 256 + nt * 128 + r) * 2048 + 1536 + h * 64; }, 64,
                               [&](int m, int n, f32x4 vv) { const float v = vv[0]; zt[((size_t)(b * 256 + h * 64 + (m & 63)) * 2 + (m >> 6)) * 256 + nt * 128 + n] = f2bf(v); }, smem);
            }
        } else if (it < O_S1) {
            const int gid = (it - O_CONV) * NTHREADS + tid;
            const int tt = gid >> 5, ch0 = (gid & 31) * 8;
            bool first, last;
            if (tt < T) { int l = tt & 4095; first = l == 0; last = l == 4095; } else { int j = (tt - T) & 255; first = j == 0; last = j == 255; }
            const bf16_t* row = xin + (size_t)tt * 2048;
            const uint4 cb = *(const uint4*)(row + 768 + ch0), cc = *(const uint4*)(row + 1024 + ch0), cx = *(const uint4*)(row + 1280 + ch0);
            uint4 ccp = make_uint4(0, 0, 0, 0), cxp = ccp, ccn = ccp, cxn = ccp;
            if (!first) { ccp = *(const uint4*)(row - 2048 + 1024 + ch0); cxp = *(const uint4*)(row - 2048 + 1280 + ch0); }
            if (!last) { ccn = *(const uint4*)(row + 2048 + 1024 + ch0); cxn = *(const uint4*)(row + 2048 + 1280 + ch0); }
            const float* cw = p.in[I_CONVW] + (size_t)L * 3 * 256 + ch0;
            const unsigned cbv[4] = {cb.x, cb.y, cb.z, cb.w}, ccv[4] = {cc.x, cc.y, cc.z, cc.w}, cxv[4] = {cx.x, cx.y, cx.z, cx.w};
            const unsigned cpv[4] = {ccp.x, ccp.y, ccp.z, ccp.w}, xpv[4] = {cxp.x, cxp.y, cxp.z, cxp.w};
            const unsigned cnv[4] = {ccn.x, ccn.y, ccn.z, ccn.w}, xnv[4] = {cxn.x, cxn.y, cxn.z, cxn.w};
            unsigned o[4];
#pragma unroll
            for (int e = 0; e < 4; ++e) {
                float w0a = cw[2 * e], w0b = cw[2 * e + 1], w1a = cw[256 + 2 * e], w1b = cw[256 + 2 * e + 1], w2a = cw[512 + 2 * e], w2b = cw[512 + 2 * e + 1];
                float za = w0a * bflo(cpv[e]) * bflo(xpv[e]) + w1a * bflo(ccv[e]) * bflo(cxv[e]) + w2a * bflo(cnv[e]) * bflo(xnv[e]);
                float zb = w0b * bfhi(cpv[e]) * bfhi(xpv[e]) + w1b * bfhi(ccv[e]) * bfhi(cxv[e]) + w2b * bfhi(cnv[e]) * bfhi(xnv[e]);
                o[e] = pack2(bflo(cbv[e]) * za, bfhi(cbv[e]) * zb);
            }
            *(uint4*)(ymix + (size_t)tt * 1024 + 256 + ch0) = make_uint4(o[0], o[1], o[2], o[3]);
        } else {
            const int idx = it - O_S1;
            const int g = idx / 18, rem = idx % 18, mt = rem / 9, nt = rem % 9;
            const bf16_t* wst = (const bf16_t*)(ws + OFF_WST) + (size_t)g * 256 * 512;
            const bf16_t* vg = (const bf16_t*)(ws + OFF_VG) + (size_t)g * NCHP * KV;
            float* sc = (float*)(ws + OFF_SC) + (size_t)g * NCH * 256;
            gemm128<0>([&](int r) { return wst + (size_t)(mt * 128 + r) * 512; },
                           [&](int r) { return vg + (size_t)(nt * 128 + r) * KV + 256; }, 512,
                           [&](int m, int n, f32x4 vv) { const float v = vv[0]; int nn = nt * 128 + n; if (nn < NCH) sc[(size_t)nn * 256 + mt * 128 + m] = v; }, smem);
        }
    }
}

__device__ void s5_scan(const Params& p, int L) {
    unsigned char* ws = p.ws;
    for (int it = BIDX; it < 32; it += gridDim.x) {
        const int gid = it * NTHREADS + TIDX;
        const int b = gid >> 11, g = (gid >> 7) & 15, dr = (gid >> 6) & 1, pp = gid & 63;
        const float2 a32 = ((const float2*)(ws + OFF_POWA))[((size_t)((L * 2 + dr) * 16 + g) * 33 + 32) * 64 + pp];
        bf16_t* vg = (bf16_t*)(ws + OFF_VG) + (size_t)g * NCHP * KV + dr * 128 + pp;
        const float* sc = (const float*)(ws + OFF_SC) + (size_t)g * NCH * 256 + dr * 128 + pp;
        float hr = 0.f, hi = 0.f;
        for (int s0 = 0; s0 < NCHB; s0 += 8) {
            float sr[8], si[8]; int nn[8];
#pragma unroll
            for (int q = 0; q < 8; ++q) {
                const int s = s0 + q;
                const int cidx = dr == 0 ? s : (s < 8 ? 7 - s : NCHB - 1 - (s - 8));
                nn[q] = b * NCHB + cidx;
                sr[q] = sc[(size_t)nn[q] * 256]; si[q] = sc[(size_t)nn[q] * 256 + 64];
            }
#pragma unroll
            for (int q = 0; q < 8; ++q) {
                vg[(size_t)nn[q] * KV] = f2bf(hr); vg[(size_t)nn[q] * KV + 64] = f2bf(hi);
                const float nr = a32.x * hr - a32.y * hi + sr[q], ni = a32.x * hi + a32.y * hr + si[q];
                hr = nr; hi = ni;
            }
        }
    }
}

__device__ void phase_D(const Params& p, int L, unsigned char* smem) {
    unsigned char* ws = p.ws;
    bf16_t* ymix = (bf16_t*)(ws + OFF_YMIX);
    s5_scan(p, L);
    const int N_F2 = 1024, N_F2C = (L == 0) ? 32 : 0, N_S2 = 0;
    const int O_F2C = N_F2, O_S2 = O_F2C + N_F2C, N_ALL = O_S2 + N_S2;
    for (int it = BIDX; it < N_ALL; it += gridDim.x) {
        if (it < O_F2C) {
            const int b = it >> 7, nt = it & 127;
            const bf16_t* mab = (const bf16_t*)(ws + OFF_MATAB);
            const bf16_t* zt = (const bf16_t*)(ws + OFF_ZT) + ((size_t)b * 16384 + nt * 128) * 128;
            const float2* tw = (const float2*)(ws + OFF_TW);
            bf16_t* yp = (bf16_t*)(ws + OFF_YP);
            gemm128<2>([&](int r) { return mab + r * 128; },
                       [&](int r) { return zt + (size_t)r * 128; }, 128,
                       [&](int m0, int n, f32x4 v) {
                           const int nn = nt * 128 + n, ch = nn >> 6, l2 = nn & 63, k1 = m0 >> 1;
#pragma unroll
                           for (int q = 0; q < 2; ++q) {
                               const float yr = v[2 * q], yi = v[2 * q + 1];
                               const float2 t = tw[(k1 + q) * 64 + l2];
                               bf16_t* dst = yp + (((size_t)(b * 64 + k1 + q) * 256 + ch) * 2) * 64 + l2;
                               dst[0] = f2bf(yr * t.x + yi * t.y);
                               dst[64] = f2bf(yi * t.x - yr * t.y);
                           }
                       }, smem);
        } else if (it < O_S2) {
            const int idx = it - O_F2C;
            const int b = idx >> 2, mt = (idx >> 1) & 1, nt = idx & 1;
            const bf16_t* dc = (const bf16_t*)(ws + OFF_DFTC);
            const bf16_t* zt = (const bf16_t*)(ws + OFF_ZTC);
            gemm128<0>([&](int r) { return dc + (size_t)(mt * 128 + r) * 512; },
                           [&](int r) { return zt + (size_t)(b * 256 + nt * 128 + r) * 512; }, 512,
                           [&](int m, int n, f32x4 vv) { const float v = vv[0]; ymix[(size_t)(T + b * 256 + mt * 128 + m) * 1024 + 512 + nt * 128 + n] = f2bf(v); }, smem);
        }
    }
}

__device__ __forceinline__ void convert_peer_rows(const Params& p, int L, int item) {
    unsigned char* ws = p.ws;
    const int lane = TIDX & 63, w = TIDX >> 6;
    const int rid = item * 8 + w;
    const int which = rid >> 14, row = rid & 16383;
    const float* src = p.in[which ? I_PV : I_PU] + ((size_t)L * 16384 + row) * 1024 + lane * 16;
    float4 v[4]; float mx = 0.f;
#pragma unroll
    for (int i = 0; i < 4; ++i) {
        v[i] = *(const float4*)(src + i * 4);
        mx = fmaxf(mx, fmaxf(fmaxf(fabsf(v[i].x), fabsf(v[i].y)), fmaxf(fabsf(v[i].z), fabsf(v[i].w))));
    }
    mx = wave_max(mx);
    mx = fmaxf(mx, 1e-30f);
    const float sc = mx * (1.0f / 448.0f), inv = 448.0f / mx;
    int pk[4];
#pragma unroll
    for (int i = 0; i < 4; ++i) {
        int wd = 0;
        wd = __builtin_amdgcn_cvt_pk_fp8_f32(v[i].x * inv, v[i].y * inv, wd, false);
        wd = __builtin_amdgcn_cvt_pk_fp8_f32(v[i].z * inv, v[i].w * inv, wd, true);
        pk[i] = wd;
    }
    if (which) *(int4*)(ws + OFF_PEERV + (size_t)(lane >> 3) * (16384 * 128) + (size_t)row * 128 + (lane & 7) * 16) = make_int4(pk[0], pk[1], pk[2], pk[3]);
    else *(int4*)(ws + OFF_PEERU + (size_t)row * 1024 + lane * 16) = make_int4(pk[0], pk[1], pk[2], pk[3]);
    if (lane == 0) ((float*)(ws + (which ? OFF_PSCV : OFF_PSCU)))[row] = sc;
}

__device__ void phase_F(const Params& p, int L, unsigned char* smem);
__device__ void phase_E(const Params& p, int L, unsigned char* smem) {
    unsigned char* ws = p.ws;
    phase_F(p, L, smem);
    for (int it = BIDX; it < 4096; it += gridDim.x) convert_peer_rows(p, L, it);
    for (int idx = BIDX; idx < 1024; idx += gridDim.x) {
        const int b = idx >> 7, k1 = (idx >> 1) & 63, nt = idx & 1;
        const bf16_t* mad = (const bf16_t*)(ws + OFF_MATAD);
        const bf16_t* yp = (const bf16_t*)(ws + OFF_YP) + ((size_t)(b * 64 + k1) * 256 + nt * 128) * 128;
        bf16_t* ymix = (bf16_t*)(ws + OFF_YMIX);
        gemm128<0>([&](int r) { return mad + r * 128; },
                   [&](int r) { return yp + (size_t)r * 128; }, 128,
                   [&](int m, int n, f32x4 vv) { if (m < 64) ymix[(size_t)(b * 4096 + k1 + 64 * m) * 1024 + 512 + nt * 128 + n] = f2bf(vv[0]); }, smem);
    }
}

__device__ void phase_F(const Params& p, int L, unsigned char* smem) {
    unsigned char* ws = p.ws;
    bf16_t* gbuf = (bf16_t*)(ws + OFF_GBUF);
    const float* dsk = p.in[I_S5D] + L * 256;
    for (int it = BIDX; it < 576; it += gridDim.x) {
        const int g = it / 36, rem = it % 36, mt = rem >> 2, nt = rem & 3;
        const bf16_t* vg = (const bf16_t*)(ws + OFF_VG) + (size_t)g * NCHP * KV;
        const bf16_t* wc = (const bf16_t*)(ws + OFF_WCOMB) + (size_t)g * 512 * KV;
        gemm128<0>([&](int r) { return vg + (size_t)(mt * 128 + r) * KV; },
                       [&](int r) { return wc + (size_t)(nt * 128 + r) * KV; }, KV,
                       [&](int m, int n, f32x4 vv) { const float v = vv[0];
                           const int nn = mt * 128 + m;
                           if (nn < NCH) {
                               const int nc = nt * 128 + n, i = nc >> 4, h = nc & 15;
                               const int b = nn / NCHB, cidx = nn % NCHB;
                               const int tt = cidx < 8 ? (T + b * 256 + cidx * 32 + i) : (b * 4096 + (cidx - 8) * 32 + i);
                               const float u = bf2f(vg[(size_t)nn * KV + 256 + nc]);
                               const float y = v + dsk[g * 16 + h] * u;
                               gbuf[(size_t)tt * 256 + g * 16 + h] = f2bf(gelu_tanh(y));
                           }
                       }, smem);
    }
}

__device__ void phase_G(const Params& p, int L, unsigned char* smem) {
    unsigned char* ws = p.ws;
    const bf16_t* gbuf = (const bf16_t*)(ws + OFF_GBUF);
    const bf16_t* wg = (const bf16_t*)(ws + OFF_WGLUT + L * SZ_WGLUT);
    bf16_t* ymix = (bf16_t*)(ws + OFF_YMIX);
    for (int it = BIDX; it < (TT / 128) * 2; it += gridDim.x) {
        const int mt = it >> 1, nt = it & 1;
        gemm128<0>([&](int r) { return gbuf + (size_t)(mt * 128 + r) * 256; },
                       [&](int r) { return wg + (size_t)(nt * 128 + r) * 256; }, 256,
                       [&](int m, int n, f32x4 vv) { const float v = vv[0];
                           const size_t tt = mt * 128 + m; const int nn = nt * 128 + n;
                           const float gg = bf2f(gbuf[tt * 256 + nn]);
                           ymix[tt * 1024 + 768 + nn] = f2bf(gg * sigmoidf_(v));
                       }, smem);
    }
}

__device__ void phase_H(const Params& p, int L) {
    const int lane = TIDX & 63, w = TIDX >> 6;
    const bf16_t* ymix = (const bf16_t*)(p.ws + OFF_YMIX);
    bf16_t* dst = (bf16_t*)(p.ws + OFF_ACT);
    const float* gg = p.in[I_GRPG] + (size_t)L * 1024 + lane * 16;
    for (int it = BIDX; it < TT / 8; it += gridDim.x) {
        const int tt = it * 8 + w;
        const uint4* src = (const uint4*)(ymix + (size_t)tt * 1024 + lane * 16);
        const uint4 a = src[0], b = src[1];
        const unsigned u[8] = {a.x, a.y, a.z, a.w, b.x, b.y, b.z, b.w};
        float v[16], ss = 0.f;
#pragma unroll
        for (int e = 0; e < 8; ++e) { v[2 * e] = bflo(u[e]); v[2 * e + 1] = bfhi(u[e]); ss += v[2 * e] * v[2 * e] + v[2 * e + 1] * v[2 * e + 1]; }
        ss += xor_swz<1>(ss); ss += xor_swz<2>(ss); ss += xor_swz<4>(ss); ss += xor_swz<8>(ss);
        const float r = rsqrtf(ss * (1.0f / 256.0f) + EPS);
        unsigned o[8];
#pragma unroll
        for (int e = 0; e < 8; ++e) o[e] = pack2(v[2 * e] * r * gg[2 * e], v[2 * e + 1] * r * gg[2 * e + 1]);
        uint4* d = (uint4*)(dst + (size_t)tt * 1024 + lane * 16);
        d[0] = make_uint4(o[0], o[1], o[2], o[3]); d[1] = make_uint4(o[4], o[5], o[6], o[7]);
    }
}

__device__ void phase_I(const Params& p, int L, unsigned char* smem) {
    unsigned char* ws = p.ws;
    const int mtok = (L == 0) ? TT : T;
    {
        PG8_LAS unsigned char* lds = (PG8_LAS unsigned char*)smem;
        pg8::Gemm g{(const bf16_t*)(ws + OFF_ACT), (const bf16_t*)(ws + OFF_WOUTT + L * SZ_WOUTT), T, 1024, 1024};
        pg8::StaticOrder s; s.init(T, 1024, (int)gridDim.x, BIDX);
        pg8::EpiRes e{(L == 0) ? p.in[I_X] : p.out, p.in[I_CTX], p.out, (float*)(ws + OFF_XCTX), (const float*)(ws + OFF_MOD) + (size_t)L * 9 * 6144 + 2048};
        pg8::gemm_phase(lds, g, s, e, nullptr);
        __syncthreads();
    }
    if (mtok > T) {
        const bf16_t* A = (const bf16_t*)(ws + OFF_ACT);
        const bf16_t* Bt = (const bf16_t*)(ws + OFF_WOUTT + L * SZ_WOUTT);
        const float* g1c = (const float*)(ws + OFF_MOD) + (size_t)L * 9 * 6144 + 2048 + (size_t)8 * 6144;
        float* xctx = (float*)(ws + OFF_XCTX);
        for (int it = BIDX; it < 128; it += gridDim.x) {
            const int mt = it >> 3, nt = it & 7;
            gemm128<0>([&](int r) { return A + (size_t)(T + mt * 128 + r) * 1024; },
                       [&](int r) { return Bt + (size_t)(nt * 128 + r) * 1024; }, 1024,
                       [&](int m, int n, f32x4 vv) { const size_t o = (size_t)(mt * 128 + m) * 1024 + nt * 128 + n; xctx[o] = p.in[I_CTX][o] + g1c[nt * 128 + n] * vv[0]; }, smem);
        }
    }
}

__device__ void phase_K(const Params& p, int L, unsigned char* smem) {
    unsigned char* ws = p.ws;
    const int mtok = (L == 0) ? TT : T;
    PG8_LAS unsigned char* lds = (PG8_LAS unsigned char*)smem;
    pg8::Gemm g{(const bf16_t*)(ws + OFF_ACT), (const bf16_t*)(ws + OFF_WQKT + L * SZ_WQKT), T, 2048, 1024};
    pg8::StaticOrder s; s.init(T, 2048, (int)gridDim.x, BIDX);
    pg8::EpiBf16<0> e{(bf16_t*)(ws + OFF_SCORES), 2048, nullptr, 0, 0};
    pg8::gemm_phase(lds, g, s, e, nullptr);
    __syncthreads();
    if (mtok > T) {
        const bf16_t* A = (const bf16_t*)(ws + OFF_ACT);
        const bf16_t* Bt = (const bf16_t*)(ws + OFF_WQKT + L * SZ_WQKT);
        bf16_t* sc = (bf16_t*)(ws + OFF_SCORES);
        for (int it = BIDX; it < 256; it += gridDim.x) {
            const int mt = 256 + (it >> 4), nt = it & 15;
            gemm128<0>([&](int r) { return A + (size_t)(mt * 128 + r) * 1024; },
                       [&](int r) { return Bt + (size_t)(nt * 128 + r) * 1024; }, 1024,
                       [&](int m, int n, f32x4 vv) { sc[(size_t)(mt * 128 + m) * 2048 + nt * 128 + n] = f2bf(vv[0]); }, smem);
        }
    }
}

__device__ __forceinline__ void bitonic_sort16_desc(int (&a)[16]) {
#pragma unroll
    for (int k = 2; k <= 16; k <<= 1)
#pragma unroll
        for (int j = k >> 1; j > 0; j >>= 1)
#pragma unroll
            for (int i = 0; i < 16; ++i) {
                const int l = i ^ j;
                if (l > i) {
                    const int hi = max(a[i], a[l]), lo = min(a[i], a[l]);
                    if ((i & k) == 0) { a[i] = hi; a[l] = lo; } else { a[i] = lo; a[l] = hi; }
                }
            }
}
__device__ __forceinline__ void merge_top16(int (&top)[16], const int (&g)[16]) {
#pragma unroll
    for (int i = 0; i < 16; ++i) top[i] = max(top[i], g[15 - i]);
#pragma unroll
    for (int j = 8; j > 0; j >>= 1)
#pragma unroll
        for (int i = 0; i < 16; ++i) {
            const int l = i ^ j;
            if (l > i) { const int hi = max(top[i], top[l]), lo = min(top[i], top[l]); top[i] = hi; top[l] = lo; }
        }
}
__device__ __forceinline__ void top16_of_128(const LAS_ unsigned char* sc, int (&top)[16]) {
#pragma unroll 1
    for (int c = 0; c < 8; ++c) {
        const u32x4_t v0 = *(const LAS_ u32x4_t*)(sc + c * 32), v1 = *(const LAS_ u32x4_t*)(sc + c * 32 + 16);
        const unsigned wv[8] = {v0[0], v0[1], v0[2], v0[3], v1[0], v1[1], v1[2], v1[3]};
        int g[16];
#pragma unroll
        for (int e = 0; e < 8; ++e) {
            const int b0 = (int)(wv[e] << 16), b1 = (int)(wv[e] & 0xffff0000u);
            g[2 * e] = ((b0 ^ ((b0 >> 31) & 0x7FFFFFFF)) & ~0x7F) | (c * 16 + 2 * e);
            g[2 * e + 1] = ((b1 ^ ((b1 >> 31) & 0x7FFFFFFF)) & ~0x7F) | (c * 16 + 2 * e + 1);
        }
        bitonic_sort16_desc(g);
        if (c == 0) {
#pragma unroll
            for (int i = 0; i < 16; ++i) top[i] = g[i];
        } else merge_top16(top, g);
    }
}
__device__ void phase_L(const Params& p, int L, unsigned char* smem) {
    const int mtok = (L == 0) ? TT : T;
    const bf16_t* scores = (const bf16_t*)(p.ws + OFF_SCORES);
    int* eidx = (int*)(p.ws + OFF_EIDX);
    float* gate = (float*)(p.ws + OFF_GATE);
    float* sub = (float*)(p.ws + OFF_SU);
    const float* scu = (const float*)(p.ws + OFF_PSCU);
    const float* scv = (const float*)(p.ws + OFF_PSCV);
    const int lane = TIDX & 63, w = TIDX >> 6;
    LAS_ unsigned char* stg = (LAS_ unsigned char*)smem + w * 17408;
    LAS_ int* lst = (LAS_ int*)(stg + lane * 272);
    const int nit = mtok * 8 / NTHREADS;
    for (int it = BIDX; it < nit; it += gridDim.x) {
        const int gid = it * NTHREADS + TIDX;
        const int tt = gid >> 3, hd = gid & 7;
        const size_t gbase = (size_t)it * NTHREADS + w * 64;
        int t1[16], t2[16];
#pragma unroll
        for (int z = 0; z < 2; ++z) {
            asm volatile("s_waitcnt lgkmcnt(0)" ::: "memory");
            uint4 ld[16];
#pragma unroll
            for (int i = 0; i < 16; ++i) ld[i] = *(const uint4*)(scores + (gbase + 4 * i + (lane >> 4)) * 256 + z * 128 + (lane & 15) * 8);
#pragma unroll
            for (int i = 0; i < 16; ++i) *(LAS_ u32x4_t*)(stg + (4 * i + (lane >> 4)) * 272 + (lane & 15) * 16) = u32x4_t{ld[i].x, ld[i].y, ld[i].z, ld[i].w};
            asm volatile("s_waitcnt lgkmcnt(0)" ::: "memory");
            if (z == 0) top16_of_128(stg + lane * 272, t1); else top16_of_128(stg + lane * 272, t2);
        }
        asm volatile("s_waitcnt lgkmcnt(0)" ::: "memory");
        float s1[16], s2[16];
#pragma unroll
        for (int j = 0; j < 16; ++j) { s1[j] = unsortable(t1[j] & ~0x7F); s2[j] = unsortable(t2[j] & ~0x7F); lst[j] = t1[j] & 0x7F; lst[16 + j] = t2[j] & 0x7F; }
        int top[16];
#pragma unroll
        for (int j = 0; j < 16; ++j) top[j] = (int)0x80000000;
#pragma unroll
        for (int i = 0; i < 16; ++i)
#pragma unroll
            for (int j = 0; j < 16; ++j)
                if ((i + 1) * (j + 1) <= 16) top16_insert(top, (sortable(s1[i] + s2[j]) & ~0xFF) | (i * 16 + j));
        float vals[16], sum = 0.f;
        const float mx = unsortable(top[0] & ~0xFF);
#pragma unroll
        for (int j = 0; j < 16; ++j) { vals[j] = __expf(unsortable(top[j] & ~0xFF) - mx); sum += vals[j]; }
        const float inv = 1.0f / sum;
        int ei[16]; float su[16];
#pragma unroll
        for (int j = 0; j < 16; ++j) {
            const int pr = top[j] & 0xFF;
            ei[j] = lst[pr >> 4] * 128 + lst[16 + (pr & 15)];
            vals[j] *= inv * scv[ei[j]];
            su[j] = scu[ei[j]];
        }
        int4* de = (int4*)(eidx + (size_t)tt * 128 + hd * 16);
        float4* dg = (float4*)(gate + (size_t)tt * 128 + hd * 16);
        float4* ds = (float4*)(sub + (size_t)tt * 128 + hd * 16);
#pragma unroll
        for (int q = 0; q < 4; ++q) {
            de[q] = make_int4(ei[q * 4], ei[q * 4 + 1], ei[q * 4 + 2], ei[q * 4 + 3]);
            dg[q] = make_float4(vals[q * 4], vals[q * 4 + 1], vals[q * 4 + 2], vals[q * 4 + 3]);
            ds[q] = make_float4(su[q * 4], su[q * 4 + 1], su[q * 4 + 2], su[q * 4 + 3]);
        }
    }
}

typedef __attribute__((ext_vector_type(2))) float f32x2;
__device__ __forceinline__ float dot16_fp8(const float (&hf)[16], const uint4& u) {
    f32x2 d = f32x2{0.f, 0.f};
    const unsigned wv[4] = {u.x, u.y, u.z, u.w};
#pragma unroll
    for (int i = 0; i < 4; ++i) {
        const f32x2 lo = __builtin_amdgcn_cvt_pk_f32_fp8((int)wv[i], false), hi = __builtin_amdgcn_cvt_pk_f32_fp8((int)wv[i], true);
        d = __builtin_elementwise_fma(f32x2{hf[4 * i], hf[4 * i + 1]}, lo, d);
        d = __builtin_elementwise_fma(f32x2{hf[4 * i + 2], hf[4 * i + 3]}, hi, d);
    }
    return d.x + d.y;
}
__device__ __forceinline__ void axpy16_fp8(float (&acc)[16], float a, const uint4& v) {
    const unsigned wv[4] = {v.x, v.y, v.z, v.w};
    const f32x2 aa = f32x2{a, a};
#pragma unroll
    for (int i = 0; i < 4; ++i) {
        const f32x2 lo = __builtin_amdgcn_cvt_pk_f32_fp8((int)wv[i], false), hi = __builtin_amdgcn_cvt_pk_f32_fp8((int)wv[i], true);
        f32x2 c0 = f32x2{acc[4 * i], acc[4 * i + 1]}, c1 = f32x2{acc[4 * i + 2], acc[4 * i + 3]};
        c0 = __builtin_elementwise_fma(aa, lo, c0); c1 = __builtin_elementwise_fma(aa, hi, c1);
        acc[4 * i] = c0.x; acc[4 * i + 1] = c0.y; acc[4 * i + 2] = c1.x; acc[4 * i + 3] = c1.y;
    }
}

struct XccSplit { int rank, nloc, np; unsigned pop; int myx; };
__device__ __forceinline__ XccSplit xcc_split(const Params& p, unsigned char* smem) {
    XccSplit s;
    volatile LAS_ unsigned* st = (volatile LAS_ unsigned*)(smem + SMEM_BYTES - 16);
    s.nloc = (int)st[0]; s.rank = (int)st[2];
    s.myx = (int)((unsigned)__builtin_amdgcn_s_getreg((3 << 11) | 20) & 0xFu);
    const unsigned* bar = (const unsigned*)(p.ws + OFF_BAR);
    s.np = 0; s.pop = 0u;
#pragma unroll
    for (int j = 0; j < 16; ++j) {
        const unsigned c = __hip_atomic_load(bar + 256 + 64 * j, __ATOMIC_RELAXED, __HIP_MEMORY_SCOPE_AGENT);
        if (c > 0u && s.np < 8) { s.pop |= (unsigned)j << (4 * s.np); ++s.np; }
    }
    if (s.np < 1) s.np = 1;
    if (s.nloc < 1) s.nloc = 1;
    return s;
}
__device__ __forceinline__ int xcc_owner(const XccSplit& s, int slice) { return (int)((s.pop >> (4 * (slice % s.np))) & 0xFu); }

struct M1Tok { int e0, e1; float g0, g1, s0, s1; };
__device__ __forceinline__ M1Tok m1_load(const int* eidx, const float* gate, const float* su, int tt, int lane) {
    M1Tok t;
    t.e0 = eidx[(size_t)tt * 128 + lane]; t.e1 = eidx[(size_t)tt * 128 + 64 + lane];
    t.g0 = gate[(size_t)tt * 128 + lane]; t.g1 = gate[(size_t)tt * 128 + 64 + lane];
    t.s0 = su[(size_t)tt * 128 + lane]; t.s1 = su[(size_t)tt * 128 + 64 + lane];
    return t;
}
struct M1S { int tt, nn, nbat, ce0, cg0, cs0, cj0, ce1, cg1, cs1, cj1; };

__device__ void phase_M1(const Params& p, int L, unsigned char* smem, bool dry) {
    const int lane = TIDX & 63, w = __builtin_amdgcn_readfirstlane(TIDX >> 6), lr = lane & 15, g = lane >> 4;
    const int mtok = (L == 0) ? TT : T;
    const XccSplit xs = xcc_split(p, smem);
    const unsigned char* h8 = p.ws + OFF_H8;
    const unsigned char* pu = p.ws + OFF_PEERU;
    const int* eidx = (const int*)(p.ws + OFF_EIDX);
    float* gate = (float*)(p.ws + OFF_GATE);
    const float* su = (const float*)(p.ws + OFF_SU);
    LAS_ unsigned char* rbuf = (LAS_ unsigned char*)smem + w * 19968;
    LAS_ unsigned char* hbuf = rbuf + 16384;
    LAS_ int* cl = (LAS_ int*)(rbuf + 18432);
    const int q = lr & 7, hh = lr >> 3;
    const int dma_c0 = lane ^ (((lane >> 5) & 1) << 3);
    const int rd_base = q * 1024 + 8 * (g & 1);
    const int rd_x = q ^ (hh << 3), rd_c = hh * 32 + (g >> 1);
    const int jsel = (lr >> 1) & 3;
    const bool fin_lane = (g < 2) && ((lr & 1) == 0) && (lr < 8);
    const int hrd = (lr & 1) * 512 + 8 * g;

    auto prepare = [&](M1S& S, const M1Tok& raw, int tt, int sl) {
        const bool in0 = (raw.e0 >> 11) == sl, in1 = (raw.e1 >> 11) == sl;
        const unsigned long long m0 = __ballot(in0), m1 = __ballot(in1);
        const int n0 = __builtin_popcountll(m0), n = n0 + __builtin_popcountll(m1);
        const int r0 = __builtin_amdgcn_mbcnt_hi((unsigned)(m0 >> 32), __builtin_amdgcn_mbcnt_lo((unsigned)m0, 0u));
        const int r1 = n0 + __builtin_amdgcn_mbcnt_hi((unsigned)(m1 >> 32), __builtin_amdgcn_mbcnt_lo((unsigned)m1, 0u));
        asm volatile("s_waitcnt lgkmcnt(0)" ::: "memory");
        if (in0) { cl[r0] = raw.e0 | (lane << 16); cl[128 + r0] = __builtin_bit_cast(int, raw.g0); cl[256 + r0] = __builtin_bit_cast(int, raw.s0); }
        if (in1) { cl[r1] = raw.e1 | ((64 + lane) << 16); cl[128 + r1] = __builtin_bit_cast(int, raw.g1); cl[256 + r1] = __builtin_bit_cast(int, raw.s1); }
        asm volatile("s_waitcnt lgkmcnt(0)" ::: "memory");
        const int dummy = sl * 2048;
        int a0 = cl[lane], a1 = cl[64 + lane];
        S.cg0 = cl[128 + lane]; S.cg1 = cl[192 + lane]; S.cs0 = cl[256 + lane]; S.cs1 = cl[320 + lane];
        asm volatile("s_waitcnt lgkmcnt(0)" ::: "memory");
        if (lane >= n) { a0 = dummy; S.cg0 = 0; S.cs0 = 0; }
        if (64 + lane >= n) { a1 = dummy; S.cg1 = 0; S.cs1 = 0; }
        S.ce0 = a0 & 0xFFFF; S.cj0 = a0 >> 16; S.ce1 = a1 & 0xFFFF; S.cj1 = a1 >> 16;
        S.nn = n; S.nbat = (n + 7) >> 3; S.tt = tt;
    };
    auto raw_dma = [&](int tt) {
        const unsigned char* s0 = (lane < 32) ? (const unsigned char*)(eidx + (size_t)tt * 128) + lane * 16 : (const unsigned char*)(gate + (size_t)tt * 128) + (lane - 32) * 16;
        __builtin_amdgcn_global_load_lds((const unsigned*)s0, (LAS_ unsigned*)(cl), 16, 0, 0);
        if (lane < 32) __builtin_amdgcn_global_load_lds((const unsigned*)((const unsigned char*)(su + (size_t)tt * 128) + lane * 16), (LAS_ unsigned*)(cl + 256), 16, 0, 0);
    };
    auto raw_from_lds = [&]() {
        M1Tok t;
        t.e0 = cl[lane]; t.e1 = cl[64 + lane];
        t.g0 = __builtin_bit_cast(float, cl[128 + lane]); t.g1 = __builtin_bit_cast(float, cl[192 + lane]);
        t.s0 = __builtin_bit_cast(float, cl[256 + lane]); t.s1 = __builtin_bit_cast(float, cl[320 + lane]);
        asm volatile("s_waitcnt lgkmcnt(0)" ::: "memory");
        return t;
    };
    auto issue = [&](const M1S& S, int j, int gidx) {
        const int cesel = (j < 8) ? S.ce0 : S.ce1;
#pragma unroll
        for (int qq = 0; qq < 8; ++qq) {
            const int e = __builtin_amdgcn_readlane(cesel, (j * 8 + qq) & 63);
            __builtin_amdgcn_global_load_lds((const unsigned*)(pu + (size_t)e * 1024 + 16 * (dma_c0 ^ qq)),
                                             (LAS_ unsigned*)(rbuf + (gidx & 1) * 8192 + qq * 1024), 16, 0, 0);
        }
    };

#pragma unroll 1
    for (int sl = 0; sl < 8; ++sl) {
        if (xcc_owner(xs, sl) != xs.myx) continue;
        const int nb = mtok / 8;
        int tb = xs.rank;
        if (tb >= nb) continue;
        M1S S, N;
        int tpar = 0;
        {
            const M1Tok raw0 = m1_load(eidx, gate, su, tb * 8 + w, lane);
            __builtin_amdgcn_global_load_lds((const unsigned*)(h8 + (size_t)(tb * 8 + w) * 1024 + lane * 16), (LAS_ unsigned*)(hbuf), 16, 0, 0);
            prepare(S, raw0, tb * 8 + w, sl);
        }
        bool hasN = tb + xs.nloc < nb;
        if (hasN) raw_dma((tb + xs.nloc) * 8 + w);
        int gb = 0, isS = 0, isN = 0;
        while (isS < 2 && isS < S.nbat) { issue(S, isS, gb + isS); ++isS; }
        N.nbat = 0;
        bool first = true;
#pragma unroll 1
        for (;;) {
            isN = 0;
            if (hasN) {
                const int ttN = (tb + xs.nloc) * 8 + w;
                if (first || isS == 0) asm volatile("s_waitcnt vmcnt(0)" ::: "memory");
                else if (isS == 1) asm volatile("s_waitcnt vmcnt(8)" ::: "memory");
                else asm volatile("s_waitcnt vmcnt(16)" ::: "memory");
                const M1Tok rawN = raw_from_lds();
                prepare(N, rawN, ttN, sl);
                __builtin_amdgcn_global_load_lds((const unsigned*)(h8 + (size_t)ttN * 1024 + lane * 16), (LAS_ unsigned*)(hbuf + (tpar ^ 1) * 1024), 16, 0, 0);
                if (tb + 2 * xs.nloc < nb) raw_dma((tb + 2 * xs.nloc) * 8 + w);
            }
            long hbv[16];
            float* grow = gate + (size_t)S.tt * 128;
#pragma unroll 1
            for (int b = 0; b < S.nbat; ++b) {
                const int after = (isS - b - 1) + isN;
                if (b == 0) {
                    if (first || !hasN) { if (after > 0) asm volatile("s_waitcnt vmcnt(8)" ::: "memory"); else asm volatile("s_waitcnt vmcnt(0)" ::: "memory"); }
                    else { if (after > 0) asm volatile("s_waitcnt vmcnt(11)" ::: "memory"); else asm volatile("s_waitcnt vmcnt(3)" ::: "memory"); }
                    if (first && hasN) asm volatile("s_waitcnt vmcnt(0)" ::: "memory");
#pragma unroll
                    for (int i = 0; i < 16; ++i) hbv[i] = *(const LAS_ long*)(hbuf + tpar * 1024 + hrd + 32 * i);
                } else {
                    if (after > 0) asm volatile("s_waitcnt vmcnt(8)" ::: "memory"); else asm volatile("s_waitcnt vmcnt(0)" ::: "memory");
                }
                long af[16];
                const LAS_ unsigned char* rb = rbuf + ((gb + b) & 1) * 8192 + rd_base;
#pragma unroll
                for (int i = 0; i < 16; ++i) af[i] = *(const LAS_ long*)(rb + 16 * ((rd_c + 2 * i) ^ rd_x));
                asm volatile("s_waitcnt lgkmcnt(0)" ::: "memory");
                if (isS < S.nbat) { issue(S, isS, gb + isS); ++isS; }
                else if (hasN && isN < 2 && isN < N.nbat) { issue(N, isN, gb + S.nbat + isN); ++isN; }
                f32x4 acc = f32x4{0.f, 0.f, 0.f, 0.f}, acc2 = f32x4{0.f, 0.f, 0.f, 0.f};
#pragma unroll
                for (int i = 0; i < 16; i += 2) {
                    acc = __builtin_amdgcn_mfma_f32_16x16x32_fp8_fp8(af[i], hbv[i], acc, 0, 0, 0);
                    acc2 = __builtin_amdgcn_mfma_f32_16x16x32_fp8_fp8(af[i + 1], hbv[i + 1], acc2, 0, 0, 0);
                }
                acc += acc2;
                const float sel = jsel == 0 ? acc[0] : (jsel == 1 ? acc[1] : (jsel == 2 ? acc[2] : acc[3]));
                const float oth = __builtin_bit_cast(float, __builtin_amdgcn_ds_bpermute(((lane + 33) & 63) << 2, __builtin_bit_cast(int, sel)));
                const int pr = b * 8 + 4 * (g & 1) + jsel;
                const bool hi = b >= 8;
                const float sv = __builtin_bit_cast(float, __builtin_amdgcn_ds_bpermute((pr & 63) << 2, hi ? S.cs1 : S.cs0));
                const float gg = __builtin_bit_cast(float, __builtin_amdgcn_ds_bpermute((pr & 63) << 2, hi ? S.cg1 : S.cg0));
                const int jj = __builtin_amdgcn_ds_bpermute((pr & 63) << 2, hi ? S.cj1 : S.cj0);
                const float a = gelu_tanh((sel + oth) * sv * 0.125f) * gg;
                if (fin_lane && pr < S.nn && (!dry || a == 1234.56789f)) grow[jj] = a;
            }
            if (!hasN) break;
            gb += S.nbat; S = N; isS = isN; tpar ^= 1; tb += xs.nloc; hasN = tb + xs.nloc < nb; first = false;
            while (isS < 2 && isS < S.nbat) { issue(S, isS, gb + isS); ++isS; }
        }
        asm volatile("s_waitcnt vmcnt(0) lgkmcnt(0)" ::: "memory");
    }
}

__device__ void phase_M2(const Params& p, int L, unsigned char* smem, bool dry) {
    const int lane = TIDX & 63, w = __builtin_amdgcn_readfirstlane(TIDX >> 6);
    const int mtok = (L == 0) ? TT : T;
    const XccSplit xs = xcc_split(p, smem);
    const unsigned char* pv = p.ws + OFF_PEERV;
    const int* eidx = (const int*)(p.ws + OFF_EIDX);
    const float* act = (const float*)(p.ws + OFF_GATE);
    const float* g2 = (const float*)(p.ws + OFF_MOD) + (size_t)L * 9 * 6144 + 5120;
    const int grp = lane >> 3, sub = lane & 7;
    const bool b0 = (grp & 1) != 0, b1 = (grp & 2) != 0, b2 = (grp & 4) != 0;
    LAS_ unsigned char* lbuf = (LAS_ unsigned char*)smem + w * 16384;
#pragma unroll 1
    for (int sl = 0; sl < 8; ++sl) {
        if (xcc_owner(xs, sl) != xs.myx) continue;
        const int colbase = sl * 128 + sub * 16;
        const unsigned char* pvs = pv + (size_t)sl * (16384 * 128) + sub * 16;
        const int col = colbase + (b0 ? 8 : 0) + (b1 ? 4 : 0) + (b2 ? 2 : 0);
        unsigned* qc = (unsigned*)(p.ws + OFF_BAR) + QC_WORD(L, 1, sl);
        int cb0;
        {
            unsigned t0 = 0;
            if (lane == 0) t0 = __hip_atomic_fetch_add(qc, 1u, __ATOMIC_RELAXED, __HIP_MEMORY_SCOPE_AGENT);
            cb0 = (int)__builtin_amdgcn_readfirstlane(t0) * 4;
        }
        if (cb0 >= mtok) continue;
        int cb1 = 0x40000000, ci = 0;
        unsigned pend = 0;
        int evn[16];
        {
#pragma unroll
            for (int i = 0; i < 16; ++i) evn[i] = eidx[(size_t)cb0 * 128 + i * 8 + grp];
#pragma unroll
            for (int i = 0; i < 16; ++i)
                __builtin_amdgcn_global_load_lds((const unsigned*)(pvs + (size_t)evn[i] * 128), (LAS_ unsigned*)(lbuf + i * 1024), 16, 0, 0);
#pragma unroll
            for (int i = 0; i < 16; ++i) evn[i] = eidx[(size_t)(cb0 + 1) * 128 + i * 8 + grp];
        }
#pragma unroll 1
        for (;;) {
            const int tt = cb0 + ci;
            float* xr = (tt < T) ? (p.out + (size_t)tt * 1024) : ((float*)(p.ws + OFF_XCTX) + (size_t)(tt - T) * 1024);
            float2 gg = *(const float2*)(g2 + (size_t)tok_modrow(tt) * 6144 + col);
            float2 x = *(const float2*)(xr + col);
            float av[16];
#pragma unroll
            for (int i = 0; i < 16; ++i) av[i] = act[(size_t)tt * 128 + i * 8 + grp];
            asm volatile("s_waitcnt vmcnt(0)" ::: "memory");
#pragma unroll
            for (int i = 0; i < 16; ++i) { asm volatile("" : "+v"(av[i])); asm volatile("" : "+v"(evn[i])); }
            asm volatile("" : "+v"(gg.x), "+v"(gg.y), "+v"(x.x), "+v"(x.y), "+v"(pend));
            if (ci == 1) cb1 = (int)__builtin_amdgcn_readfirstlane(pend) * 4;
            u32x4_t vr[16];
#pragma unroll
            for (int i = 0; i < 16; ++i) vr[i] = *(const LAS_ u32x4_t*)(lbuf + i * 1024 + lane * 16);
            asm volatile("s_waitcnt lgkmcnt(0)" ::: "memory");
            const int n1 = (ci < 3) ? tt + 1 : cb1;
            const int n2 = (ci < 2) ? tt + 2 : cb1 + (ci - 2);
            if (n1 < mtok) {
#pragma unroll
                for (int i = 0; i < 16; ++i)
                    __builtin_amdgcn_global_load_lds((const unsigned*)(pvs + (size_t)evn[i] * 128), (LAS_ unsigned*)(lbuf + i * 1024), 16, 0, 0);
            }
            if (n2 < mtok) {
#pragma unroll
                for (int i = 0; i < 16; ++i) evn[i] = eidx[(size_t)n2 * 128 + i * 8 + grp];
            }
            if (ci == 0 && lane == 0) pend = __hip_atomic_fetch_add(qc, 1u, __ATOMIC_RELAXED, __HIP_MEMORY_SCOPE_AGENT);
            float acc[16];
#pragma unroll
            for (int d = 0; d < 16; ++d) acc[d] = 0.f;
#pragma unroll
            for (int i = 0; i < 16; ++i) axpy16_fp8(acc, av[i], make_uint4(vr[i][0], vr[i][1], vr[i][2], vr[i][3]));
            float r8[8], r4[4], r2[2];
#pragma unroll
            for (int k = 0; k < 8; ++k) { const float keep = b0 ? acc[8 + k] : acc[k], send = b0 ? acc[k] : acc[8 + k]; r8[k] = keep + xor_swz<8>(send); }
#pragma unroll
            for (int k = 0; k < 4; ++k) r4[k] = bfly16(r8[k], r8[4 + k]);
#pragma unroll
            for (int k = 0; k < 2; ++k) r2[k] = bfly32(r4[k], r4[2 + k]);
            x.x += gg.x * r2[0]; x.y += gg.y * r2[1];
            if (!dry || x.x == 1234.56789f) *(float2*)(xr + col) = x;
            if (++ci == 4) { ci = 0; cb0 = cb1; if (cb0 >= mtok) break; }
        }
        asm volatile("s_waitcnt vmcnt(0)" ::: "memory");
    }
}

__device__ void phase_Z(const Params& p) {
    const int lane = TIDX & 63, w = TIDX >> 6;
    const float* fg = p.in[I_FING];
    for (int it = BIDX; it < T / 8; it += gridDim.x) {
        float* xr = p.out + (size_t)(it * 8 + w) * 1024;
        float4 v[4]; float ss = 0.f;
#pragma unroll
        for (int i = 0; i < 4; ++i) { v[i] = *(const float4*)(xr + (i * 64 + lane) * 4); ss += v[i].x * v[i].x + v[i].y * v[i].y + v[i].z * v[i].z + v[i].w * v[i].w; }
        ss = wave_sum(ss);
        const float r = rsqrtf(ss * (1.0f / 1024.0f) + EPS);
#pragma unroll
        for (int i = 0; i < 4; ++i) {
            const float4 g = *(const float4*)(fg + (i * 64 + lane) * 4);
            *(float4*)(xr + (i * 64 + lane) * 4) = make_float4(v[i].x * r * g.x, v[i].y * r * g.y, v[i].z * r * g.z, v[i].w * r * g.w);
        }
    }
}

#define XB_TMO      128
#define XB_XCNT(j)  (256  + 64 * (j))
#define XB_XSUB(j)  (1280 + 64 * (j))
#define XB_XGEN(j)  (2304 + 64 * (j))
#define XB_TOP      3328
#define XB_TOPGEN   3392
#define XCD_BAR_WORDS 3456
#define XB_SPIN_CAP (1u << 22)
#define LAS __attribute__((address_space(3)))
__device__ __forceinline__ unsigned xb_ld(unsigned* p)              { return __hip_atomic_load(p, __ATOMIC_RELAXED, __HIP_MEMORY_SCOPE_AGENT); }
__device__ __forceinline__ unsigned xb_add(unsigned* p, unsigned v) { return __hip_atomic_fetch_add(p, v, __ATOMIC_RELAXED, __HIP_MEMORY_SCOPE_AGENT); }
__device__ __forceinline__ unsigned xb_xcc_id() { return (unsigned)__builtin_amdgcn_s_getreg((3 << 11) | 20) & 0xFu; }
#define XB_SPIN(cond, bar) do { unsigned _sp = 0; while (cond) { __builtin_amdgcn_s_sleep(1); \
    if ((++_sp & 255u) == 0u) { if (xb_ld(&(bar)[XB_TMO])) break; if (_sp > XB_SPIN_CAP) { atomicAdd(&(bar)[XB_TMO], 1u); break; } } } } while (0)
struct XcdBarrier { unsigned* bar; unsigned x; volatile LAS unsigned* st; };
__device__ __forceinline__ XcdBarrier xcd_barrier_post(unsigned* bar, volatile LAS unsigned* st) {
    XcdBarrier b; b.bar = bar; b.x = xb_xcc_id(); b.st = st;
    if (threadIdx.x == 0) st[2] = xb_add(&bar[XB_XCNT(b.x)], 1u);
    return b;
}
__device__ __forceinline__ void xcd_barrier_complete(unsigned* bar, unsigned x, unsigned& nloc, unsigned& nx) {
    const unsigned G = gridDim.x * gridDim.y * gridDim.z;
    unsigned sum, cnt, mine, sp = 0u;
    for (;;) {
        sum = 0u; cnt = 0u; mine = 0u;
#pragma unroll
        for (unsigned j = 0; j < 16; ++j) { const unsigned c = xb_ld(&bar[XB_XCNT(j)]); sum += c; cnt += (c > 0u) ? 1u : 0u; mine = (j == x) ? c : mine; }
        if (sum == G) break;
        __builtin_amdgcn_s_sleep(1);
        if ((++sp & 255u) == 0u) { if (xb_ld(&bar[XB_TMO])) break; if (sp > XB_SPIN_CAP) { atomicAdd(&bar[XB_TMO], 1u); break; } }
    }
    nloc = mine > 0u ? mine : 1u; nx = cnt > 0u ? cnt : 1u;
}
__device__ __forceinline__ void xcd_barrier(const XcdBarrier& b) {
    asm volatile("s_waitcnt vmcnt(0)" ::: "memory");
    __syncthreads();
    if (threadIdx.x == 0) {
        unsigned* bar = b.bar;
        __builtin_amdgcn_s_waitcnt(0);
        unsigned nloc = b.st[0], nx = b.st[1];
        if (nloc == 0u) { xcd_barrier_complete(bar, b.x, nloc, nx); b.st[0] = nloc; b.st[1] = nx; }
        const unsigned old = xb_add(&bar[XB_XSUB(b.x)], 1u);
        const unsigned gen = old / nloc;
        if (old + 1u == (gen + 1u) * nloc) {
            __builtin_amdgcn_fence(__ATOMIC_RELEASE, "agent");
            asm volatile("s_waitcnt vmcnt(0)" ::: "memory");
            const unsigned og = xb_add(&bar[XB_TOP], 1u);
            const unsigned tg = og / nx;
            if (og + 1u == (tg + 1u) * nx) xb_add(&bar[XB_TOPGEN], 1u);
            else XB_SPIN(xb_ld(&bar[XB_TOPGEN]) == tg, bar);
            __builtin_amdgcn_fence(__ATOMIC_ACQUIRE, "agent");
            xb_add(&bar[XB_XGEN(b.x)], 1u);
            asm volatile("s_waitcnt vmcnt(0)" ::: "memory");
        } else {
            XB_SPIN(xb_ld(&bar[XB_XGEN(b.x)]) == gen, bar);
            __builtin_amdgcn_fence(__ATOMIC_ACQUIRE, "agent");
            asm volatile("s_waitcnt vmcnt(0)" ::: "memory");
        }
    }
    __syncthreads();
}

constexpr int NPL = 13;
constexpr int N_PHASES = 1 + 2 * NPL + 1;

__device__ __forceinline__ void run_phase(const Params& p, int ph, unsigned char* smem, bool dry = false) {
    if (ph == 0) { phase_prep(p, smem, 0); return; }
    if (ph == N_PHASES - 1) { phase_Z(p); return; }
    const int L = (ph - 1) / NPL, s = (ph - 1) % NPL;
    switch (s) {
        case 0: phase_A(p, L, smem); break;
        case 1: phase_B(p, L, smem); break;
        case 2: phase_C(p, L, smem); break;
        case 3: phase_D(p, L, smem); break;
        case 4: phase_E(p, L, smem); break;
        case 5: phase_G(p, L, smem); break;
        case 6: phase_H(p, L); break;
        case 7: phase_I(p, L, smem); break;
        case 8: norm_tokens(p, L, 1, (L == 0) ? TT : T, false, 0, ((L == 0) ? TT : T) / 8); break;
        case 9: phase_K(p, L, smem); break;
        case 10: phase_L(p, L, smem); break;
        case 11: phase_M1(p, L, smem, dry); break;
        default: phase_M2(p, L, smem, dry); break;
    }
}

__global__ void __launch_bounds__(NTHREADS) fwd_megakernel(Params p) {
    extern __shared__ __attribute__((aligned(16))) unsigned char smem[];
    cg::grid_group grid = cg::this_grid();
    volatile LAS unsigned* xst = (volatile LAS unsigned*)(smem + SMEM_BYTES - 16);
    if (threadIdx.x == 0) { xst[0] = 0u; xst[1] = 0u; xst[2] = 0u; xst[3] = 0u; }
    __syncthreads();
    const XcdBarrier xb = xcd_barrier_post((unsigned*)(p.ws + OFF_BAR), xst);
    for (int ph = p.ph_lo; ph < p.ph_hi; ++ph) {
#if PROBE_MASK
        if (ph > 0 && ph < N_PHASES - 1 && ((PROBE_MASK >> ((ph - 1) % NPL)) & 1) && ((ph - 1) % NPL) >= 11) { run_phase(p, ph, smem, true); xcd_barrier(xb); }
#endif
        run_phase(p, ph, smem);
#if PROBE_MASK
        if (ph > 0 && ph < N_PHASES - 1 && ((PROBE_MASK >> ((ph - 1) % NPL)) & 1) && !(((ph - 1) % NPL) == 7 && ph > NPL)) {
            const int sidx = (ph - 1) % NPL;
            if (sidx < 11) { xcd_barrier(xb); run_phase(p, ph, smem); }
        }
#endif
        if (ph + 1 < p.ph_hi) {
            if (ph == p.ph_lo) grid.sync();
            else xcd_barrier(xb);
        }
    }
}

extern "C" void kernel_launch(void* const* d_in, const int* in_sizes, int n_in, void* d_out, int out_size, void* d_ws, size_t ws_size,
                              hipStream_t stream) {
    static int grid_blocks = 0;
    if (grid_blocks == 0) {
        if (n_in != 27 || out_size != T * D || ws_size < WS_END) {
            fprintf(stderr, "kernel_launch: unexpected problem (n_in %d, out %d, ws %zu, need %zu)\n", n_in, out_size, ws_size, (size_t)WS_END);
            grid_blocks = -1; return;
        }
        int dev = 0, cus = 0, per_cu = 0;
        hipGetDevice(&dev);
        hipDeviceGetAttribute(&cus, hipDeviceAttributeMultiprocessorCount, dev);
        hipFuncSetAttribute((const void*)fwd_megakernel, hipFuncAttributeMaxDynamicSharedMemorySize, SMEM_BYTES);
        hipOccupancyMaxActiveBlocksPerMultiprocessor(&per_cu, (const void*)fwd_megakernel, NTHREADS, SMEM_BYTES);
        if (per_cu < 1) { fprintf(stderr, "kernel_launch: occupancy query returned %d\n", per_cu); per_cu = 1; }
        if (per_cu > 1) per_cu = 1;
        grid_blocks = cus * per_cu;
    }
    if (grid_blocks < 0) return;
    if (hipMemsetAsync((char*)d_ws + OFF_BAR, 0, SZ_BAR, stream) != hipSuccess) { fprintf(stderr, "kernel_launch: memset of the barrier words failed\n"); return; }
    Params p{};
    for (int i = 0; i < 27; ++i) p.in[i] = (const float*)d_in[i];
    p.out = (float*)d_out; p.ws = (unsigned char*)d_ws;
#if SPLIT_LAUNCH
    for (int ph = 0; ph < N_PHASES; ++ph) {
        p.ph_lo = ph; p.ph_hi = ph + 1;
        void* args[] = {&p};
        hipError_t e = hipLaunchCooperativeKernel((const void*)fwd_megakernel, dim3(grid_blocks), dim3(NTHREADS), args, SMEM_BYTES, stream);
        if (e != hipSuccess) { fprintf(stderr, "launch failed: %s\n", hipGetErrorString(e)); return; }
    }
#else
    p.ph_lo = 0; p.ph_hi = N_PHASES;
    void* args[] = {&p};
    hipError_t e = hipLaunchCooperativeKernel((const void*)fwd_megakernel, dim3(grid_blocks), dim3(NTHREADS), args, SMEM_BYTES, stream);
    if (e != hipSuccess) fprintf(stderr, "cooperative launch failed: %s (grid %d)\n", hipGetErrorString(e), grid_blocks);
#endif
}
```

```cpp
#include <hip/hip_runtime.h>
#include <hip/hip_cooperative_groups.h>
#include <cstdio>
#include <cstdint>
namespace cg = cooperative_groups;

#define NTHREADS 512
#ifndef PROBE_MASK
#define PROBE_MASK 0
#endif
#ifndef SPLIT_LAUNCH
#define SPLIT_LAUNCH 0
#endif

typedef unsigned short bf16_t;
typedef __attribute__((ext_vector_type(8))) short bf16x8;
typedef __attribute__((ext_vector_type(4))) float f32x4;
typedef __attribute__((ext_vector_type(2))) __bf16 bf16x2_t;
typedef __attribute__((ext_vector_type(4))) unsigned u32x4_t;

constexpr int D = 1024, NB = 8, SEQ = 4096, T = NB * SEQ, CTXL = 256, TC = NB * CTXL, TT = T + TC;
constexpr int INW = 2048;
constexpr int NCHB = 136;
constexpr int NCH = NB * NCHB;
constexpr int NCHP = 1152;
constexpr int KV = 768;
constexpr float EPS = 1e-6f;

constexpr size_t al256(size_t x) { return (x + 255) & ~(size_t)255; }
constexpr size_t OFF_ACT = 0;                                   constexpr size_t SZ_ACT = (size_t)TT * 1024 * 2;
constexpr size_t OFF_XIN = al256(OFF_ACT + SZ_ACT);             constexpr size_t SZ_XIN = (size_t)TT * 2048 * 2;
constexpr size_t OFF_YMIX = al256(OFF_XIN + SZ_XIN);            constexpr size_t SZ_YMIX = (size_t)TT * 1024 * 2;
constexpr size_t OFF_XCTX = al256(OFF_YMIX + SZ_YMIX);          constexpr size_t SZ_XCTX = (size_t)TC * 1024 * 4;
constexpr size_t OFF_ZT = al256(OFF_XCTX + SZ_XCTX);            constexpr size_t SZ_ZT = (size_t)NB * 256 * 8192 * 2;
constexpr size_t OFF_ZTC = al256(OFF_ZT + SZ_ZT);               constexpr size_t SZ_ZTC = (size_t)NB * 256 * 512 * 2;
constexpr size_t OFF_VG = al256(OFF_ZTC + SZ_ZTC);              constexpr size_t SZ_VG = (size_t)16 * NCHP * KV * 2;
constexpr size_t OFF_SC = al256(OFF_VG + SZ_VG);                constexpr size_t SZ_SC = (size_t)16 * NCH * 256 * 4;
constexpr size_t OFF_GBUF = al256(OFF_SC + SZ_SC);              constexpr size_t SZ_GBUF = (size_t)TT * 256 * 2;
constexpr size_t OFF_DFTL = al256(OFF_GBUF + SZ_GBUF);          constexpr size_t SZ_DFTL = (size_t)4096 * 8192 * 2;
constexpr size_t OFF_DFTC = al256(OFF_DFTL + SZ_DFTL);          constexpr size_t SZ_DFTC = (size_t)256 * 512 * 2;
constexpr size_t OFF_DFTD = al256(OFF_DFTC + SZ_DFTC);          constexpr size_t SZ_DFTD = (size_t)128 * 64 * 2;
constexpr size_t SZ_WINT = (size_t)2048 * 1024 * 2, SZ_WOUTT = (size_t)1024 * 1024 * 2, SZ_WQKT = (size_t)2048 * 1024 * 2, SZ_WGLUT = (size_t)256 * 256 * 2;
constexpr size_t OFF_WINT = al256(OFF_DFTD + SZ_DFTD);
constexpr size_t OFF_WOUTT = al256(OFF_WINT + 2 * SZ_WINT);
constexpr size_t OFF_WQKT = al256(OFF_WOUTT + 2 * SZ_WOUTT);
constexpr size_t OFF_WGLUT = al256(OFF_WQKT + 2 * SZ_WQKT);
constexpr size_t OFF_WCOMB = al256(OFF_WGLUT + 2 * SZ_WGLUT);   constexpr size_t SZ_WCOMB = (size_t)16 * 512 * KV * 2;
constexpr size_t OFF_WST = al256(OFF_WCOMB + SZ_WCOMB);         constexpr size_t SZ_WST = (size_t)16 * 256 * 512 * 2;
constexpr size_t OFF_POWA = al256(OFF_WST + SZ_WST);            constexpr size_t SZ_POWA = (size_t)2 * 2 * 16 * 33 * 64 * 8;
constexpr size_t OFF_BBAR = al256(OFF_POWA + SZ_POWA);          constexpr size_t SZ_BBAR = (size_t)2 * 2 * 16 * 64 * 16 * 8;
constexpr size_t OFF_KTAU = al256(OFF_BBAR + SZ_BBAR);          constexpr size_t SZ_KTAU = (size_t)2 * 2 * 16 * 32 * 256 * 4;
constexpr size_t OFF_MOD = al256(OFF_KTAU + SZ_KTAU);           constexpr size_t SZ_MOD = (size_t)2 * 9 * 6144 * 4;
constexpr size_t OFF_VT = al256(OFF_MOD + SZ_MOD);              constexpr size_t SZ_VT = (size_t)NB * 256 * 4096 * 2;
constexpr size_t OFF_VTC = al256(OFF_VT + SZ_VT);               constexpr size_t SZ_VTC = (size_t)NB * 256 * 256 * 2;
constexpr size_t OFF_BAR = al256(OFF_VTC + SZ_VTC);              constexpr size_t SZ_BAR = (size_t)3456 * 4;
constexpr size_t OFF_MATAB = al256(OFF_BAR + SZ_BAR);            constexpr size_t SZ_MAT = (size_t)128 * 128 * 2;
constexpr size_t OFF_MATAD = al256(OFF_MATAB + SZ_MAT);
constexpr size_t OFF_TW = al256(OFF_MATAD + SZ_MAT);             constexpr size_t SZ_TW = (size_t)64 * 64 * 8;
constexpr size_t WS_END = al256(OFF_TW + SZ_TW);
constexpr size_t OFF_SCORES = OFF_ZT;
static_assert(OFF_SCORES + (size_t)TT * 2048 * 2 <= OFF_DFTL + SZ_DFTL, "scores overlay");
constexpr size_t OFF_YP = OFF_DFTL;
constexpr size_t OFF_PEERU = OFF_XIN;                            constexpr size_t SZ_PEERT = (size_t)16384 * 1024;
constexpr size_t OFF_PEERV = OFF_PEERU + SZ_PEERT;
constexpr size_t OFF_PSCU = OFF_PEERV + SZ_PEERT;                constexpr size_t SZ_PSC = (size_t)16384 * 4;
constexpr size_t OFF_PSCV = OFF_PSCU + SZ_PSC;
constexpr size_t OFF_CAND = OFF_PSCV + SZ_PSC;                   constexpr size_t SZ_CAND = (size_t)TT * 256 * 4;
constexpr size_t OFF_EIDX = OFF_CAND + SZ_CAND;                  constexpr size_t SZ_EIDX = (size_t)TT * 128 * 4;
constexpr size_t OFF_GATE = OFF_EIDX + SZ_EIDX;
constexpr size_t OFF_H8 = OFF_YMIX;
constexpr size_t OFF_SU = OFF_GATE + SZ_EIDX;
static_assert(OFF_SU + SZ_EIDX <= OFF_XIN + SZ_XIN, "PEER overlays must fit in the XIN region");

constexpr int SMEM_BYTES = 163840;

struct Params {
    const float* in[27];
    float* out;
    unsigned char* ws;
    int ph_lo, ph_hi;
};
enum { I_X = 0, I_C, I_CTX, I_CCTX, I_ADAW, I_ADAB, I_N1G, I_N2G, I_WIN, I_RPB, I_CONVW, I_ARE, I_AIM, I_BRE, I_BIM, I_CRE, I_CIM,
       I_LOGDT, I_S5D, I_WGLU, I_GRPG, I_WOUT, I_WQ, I_KEYS, I_PU, I_PV, I_FING };


__device__ __forceinline__ int tidx_l() { int t = threadIdx.x; asm volatile("" : "+v"(t)); return t; }
__device__ __forceinline__ int bidx_l() { int t = blockIdx.x; asm volatile("" : "+s"(t)); return t; }
#define TIDX (tidx_l())
#define BIDX (bidx_l())
#define LAS_ __attribute__((address_space(3)))
__device__ __forceinline__ bf16_t f2bf(float f) { unsigned u = __float_as_uint(f); u += 0x7FFFu + ((u >> 16) & 1u); return (bf16_t)(u >> 16); }
__device__ __forceinline__ float bf2f(bf16_t h) { return __uint_as_float(((unsigned)h) << 16); }
__device__ __forceinline__ unsigned pack2(float a, float b) { unsigned r; asm("v_cvt_pk_bf16_f32 %0, %1, %2" : "=v"(r) : "v"(a), "v"(b)); return r; }
__device__ __forceinline__ float bflo(unsigned u) { return __uint_as_float(u << 16); }
__device__ __forceinline__ float bfhi(unsigned u) { return __uint_as_float(u & 0xffff0000u); }
__device__ __forceinline__ float dot2bf(unsigned a, unsigned b, float c) {
    return __builtin_amdgcn_fdot2_f32_bf16(__builtin_bit_cast(bf16x2_t, a), __builtin_bit_cast(bf16x2_t, b), c, false);
}
__device__ __forceinline__ float gelu_tanh(float x) {
    const float z = 0.7978845608028654f * (x + 0.044715f * x * x * x);
    return x * __builtin_amdgcn_rcpf(1.0f + __expf(-2.0f * z));
}
__device__ __forceinline__ float sigmoidf_(float x) { return __builtin_amdgcn_rcpf(1.0f + __expf(-x)); }
template <int CTRL> __device__ __forceinline__ float dpp_mov(float v) { return __int_as_float(__builtin_amdgcn_update_dpp(0, __float_as_int(v), CTRL, 0xF, 0xF, true)); }
template <int K> __device__ __forceinline__ float xor_swz(float v) {
    if constexpr (K == 1) return dpp_mov<0xB1>(v);
    else if constexpr (K == 2) return dpp_mov<0x4E>(v);
    else if constexpr (K == 4) return dpp_mov<0x1B>(dpp_mov<0x141>(v));
    else if constexpr (K == 8) return dpp_mov<0x128>(v);
    else return __int_as_float(__builtin_amdgcn_ds_swizzle(__float_as_int(v), (K << 10) | 0x1F));
}
__device__ __forceinline__ float bfly32(float a, float b) { auto r = __builtin_amdgcn_permlane32_swap(__float_as_uint(a), __float_as_uint(b), false, false); return __uint_as_float(r[0]) + __uint_as_float(r[1]); }
__device__ __forceinline__ float bfly16(float a, float b) { auto r = __builtin_amdgcn_permlane16_swap(__float_as_uint(a), __float_as_uint(b), false, false); return __uint_as_float(r[0]) + __uint_as_float(r[1]); }
__device__ __forceinline__ float max32(float a) { auto r = __builtin_amdgcn_permlane32_swap(__float_as_uint(a), __float_as_uint(a), false, false); return fmaxf(__uint_as_float(r[0]), __uint_as_float(r[1])); }
__device__ __forceinline__ float max16(float a) { auto r = __builtin_amdgcn_permlane16_swap(__float_as_uint(a), __float_as_uint(a), false, false); return fmaxf(__uint_as_float(r[0]), __uint_as_float(r[1])); }
__device__ __forceinline__ float wave_sum(float v) {
    v = bfly32(v, v); v = bfly16(v, v);
    v += xor_swz<8>(v); v += xor_swz<4>(v); v += xor_swz<2>(v); v += xor_swz<1>(v);
    return v;
}
__device__ __forceinline__ float wave_max(float v) {
    v = max32(v); v = max16(v);
    v = fmaxf(v, xor_swz<8>(v)); v = fmaxf(v, xor_swz<4>(v)); v = fmaxf(v, xor_swz<2>(v)); v = fmaxf(v, xor_swz<1>(v));
    return v;
}
__device__ __forceinline__ int sortable(float v) { int b = __float_as_int(v); return b ^ ((b >> 31) & 0x7FFFFFFF); }
__device__ __forceinline__ float unsortable(int s) { return __int_as_float(s ^ ((s >> 31) & 0x7FFFFFFF)); }
__device__ __forceinline__ void top16_insert(int (&top)[16], int x) {
#pragma unroll
    for (int j = 0; j < 16; ++j) { int hi = max(top[j], x); x = min(top[j], x); top[j] = hi; }
}
__device__ __forceinline__ int tok_modrow(int tt) { return tt < T ? (tt >> 12) : 8; }

namespace pg8 {
#define PG8_LAS __attribute__((address_space(3)))
typedef unsigned short bf16_t;
typedef short bf16x8 __attribute__((ext_vector_type(8)));
typedef float f32x4 __attribute__((ext_vector_type(4)));
typedef unsigned u32x4 __attribute__((ext_vector_type(4)));
constexpr int BM = 256, BK = 64, HALF = 128, HTB = HALF * BK * 2  , STAGE_BYTES = 8 * HTB, NXCD = 8, WGM = 8;

__host__ __device__ __forceinline__ int lds_byte(int r, int c) { const int st = (r >> 4) * 2 + (c >> 5), rr = r & 15, cc = c & 31, ob = rr * 64 + cc * 2; return st * 1024 + (ob ^ (((ob >> 9) & 1) << 5)); }
__host__ __device__ __forceinline__ void stage_rc(int b, int& R, int& C) { const int st = b / 1024, sb = b % 1024, swz = sb ^ (((sb >> 9) & 1) << 5); R = (st >> 1) * 16 + swz / 64; C = (st & 1) * 32 + (swz % 64) / 2; }
__host__ __device__ __forceinline__ int perm32(int rho) { const int n = rho >> 4, i = rho & 15; return 8 * (i >> 2) + 4 * n + (i & 3); }

struct Unit { int pm, pn; };
struct Gemm { const bf16_t* A; const bf16_t* Bt; int M, N, K; };

struct StaticOrder {
    int nM, nN, nwg, G, c;
    __host__ __device__ void init(int M, int N, int G_, int c_) { nM = M / BM; nN = N / BM; nwg = nM * nN; G = G_; c = c_; }
    __host__ __device__ bool next(int i, Unit& u) const {
        const long L = (long)i * G + c; if (L >= nwg) return false;
        int wgid = (int)L; { const int q = nwg / NXCD, r = nwg % NXCD, xcd = wgid % NXCD, off = wgid / NXCD; wgid = (xcd < r ? xcd * (q + 1) : r * (q + 1) + (xcd - r) * q) + off; }
        const int nig = WGM * nN, gid = wgid / nig, fm = gid * WGM, gsz = (nM - fm) < WGM ? (nM - fm) : WGM;
        u.pm = fm + ((wgid % nig) % gsz); u.pn = (wgid % nig) / gsz; return true;
    }
    __device__ __forceinline__ void a_ready(const Unit&) const {}
    __device__ __forceinline__ void done(const Unit&) const {}
};
__device__ __forceinline__ unsigned cvt_pk_bf16(float lo, float hi) { unsigned r; asm volatile("v_cvt_pk_bf16_f32 %0, %1, %2" : "=v"(r) : "v"(lo), "v"(hi)); return r; }
typedef float f32x2 __attribute__((ext_vector_type(2)));
__device__ __forceinline__ f32x2 gelu_pk(f32x2 v) {
    const f32x2 av = __builtin_elementwise_abs(v), d = av * 0.2316418882f + 1.0f;
    f32x2 t; t.x = __builtin_amdgcn_rcpf(d.x); t.y = __builtin_amdgcn_rcpf(d.y);
    f32x2 q = t * 0.5307027145f + (-0.7265760135f); q = q * t + 0.7107068705f; q = q * t + (-0.142248368f); q = q * t + 0.127414796f; q = q * t;
    const f32x2 s = (v * v) * (-0.72134752044f);
    f32x2 e; e.x = __builtin_amdgcn_exp2f(s.x); e.y = __builtin_amdgcn_exp2f(s.y);
    const f32x2 m = v * (q * e), r = v - m;
    f32x2 o; o.x = v.x < 0.f ? m.x : r.x; o.y = v.y < 0.f ? m.y : r.y; return o;
}

struct EpiF32 {
    static constexpr bool PERM = false, AFTER_DRAIN = false;
    float* C; int ldc; const float* bias;
    __device__ __forceinline__ void operator()(const f32x4 (&acc)[2][2][4][2], const Unit& u, int wr, int wc, int fr, int fq) const {
        const int row0 = u.pm * BM + wr * 64 + fr, col0 = u.pn * BM + wc * 32 + 4 * fq;
        f32x4 bv[2][2];
#pragma unroll
        for (int bj = 0; bj < 2; ++bj)
#pragma unroll
            for (int n = 0; n < 2; ++n) bv[bj][n] = bias ? *(const f32x4*)(bias + col0 + bj * HALF + n * 16) : (f32x4){0.f, 0.f, 0.f, 0.f};
#pragma unroll
        for (int ai = 0; ai < 2; ++ai)
#pragma unroll
            for (int m = 0; m < 4; ++m) { float* rowp = C + (size_t)(row0 + ai * HALF + m * 16) * ldc + col0;
#pragma unroll
                for (int bj = 0; bj < 2; ++bj)
#pragma unroll
                    for (int n = 0; n < 2; ++n) *(f32x4*)(rowp + bj * HALF + n * 16) = acc[ai][bj][m][n] + bv[bj][n]; }
    }
};
template <int ACT  > struct EpiBf16 {
    static constexpr bool PERM = true, AFTER_DRAIN = false;
    bf16_t* O; int ldc; const float* bias; int split_cols; size_t split_stride;
    __device__ __forceinline__ void operator()(const f32x4 (&acc)[2][2][4][2], const Unit& u, int wr, int wc, int fr, int fq) const {
        const int row0 = u.pm * BM + wr * 64 + fr; int colt = u.pn * BM; bf16_t* base = O;
        if (split_cols) { const int t = colt / split_cols; base += (size_t)t * split_stride; colt -= t * split_cols; }
        const int col0 = colt + wc * 32 + 8 * fq, bcol0 = u.pn * BM + wc * 32 + 8 * fq;
        f32x4 bv[2][2];
#pragma unroll
        for (int bj = 0; bj < 2; ++bj)
#pragma unroll
            for (int n = 0; n < 2; ++n) bv[bj][n] = bias ? *(const f32x4*)(bias + bcol0 + bj * HALF + 4 * n) : (f32x4){0.f, 0.f, 0.f, 0.f};
#pragma unroll
        for (int ai = 0; ai < 2; ++ai)
#pragma unroll
            for (int m = 0; m < 4; ++m) { bf16_t* rowp = base + (size_t)(row0 + ai * HALF + m * 16) * ldc + col0;
#pragma unroll
                for (int bj = 0; bj < 2; ++bj) { f32x4 v0 = acc[ai][bj][m][0] + bv[bj][0], v1 = acc[ai][bj][m][1] + bv[bj][1];
                    if (ACT == 1) { f32x2 a = gelu_pk((f32x2){v0[0], v0[1]}), b = gelu_pk((f32x2){v0[2], v0[3]}), c = gelu_pk((f32x2){v1[0], v1[1]}), d = gelu_pk((f32x2){v1[2], v1[3]});
                        v0 = (f32x4){a.x, a.y, b.x, b.y}; v1 = (f32x4){c.x, c.y, d.x, d.y}; }
                    if (ACT == 2) {
#pragma unroll
                        for (int j = 0; j < 4; ++j) { v0[j] = 0.5f * v0[j] * (1.0f + erff(v0[j] * 0.70710678f)); v1[j] = 0.5f * v1[j] * (1.0f + erff(v1[j] * 0.70710678f)); } }
                    u32x4 w; w.x = cvt_pk_bf16(v0[0], v0[1]); w.y = cvt_pk_bf16(v0[2], v0[3]); w.z = cvt_pk_bf16(v1[0], v1[1]); w.w = cvt_pk_bf16(v1[2], v1[3]);
                    *(u32x4*)(rowp + bj * HALF) = w; } }
    }
};

template <class Epi, class Sched, bool STAMP = false>
__device__ __forceinline__ void gemm_phase(PG8_LAS unsigned char* lds, const Gemm g, const Sched& S, const Epi& E, unsigned long long* stamps) {
    const int tid = TIDX, wid = __builtin_amdgcn_readfirstlane(tid >> 6), lane = tid & 63, wr = wid >> 2, wc = wid & 3, fr = lane & 15, fq = lane >> 4;
    const int K = g.K, nt = K / BK;
    int ts_lo = 0, ts_hi = 0, nts = 0; const unsigned long long rt_entry = STAMP ? (unsigned long long)wall_clock64() : 0ull;
#define PG8_STAMP() do { if (STAMP && wid == 0 && nts < 64) { const unsigned long long _c = (unsigned long long)clock64(); \
        ts_lo = (lane == nts) ? (int)(unsigned)_c : ts_lo; ts_hi = (lane == nts) ? (int)(unsigned)(_c >> 32) : ts_hi; ++nts; } } while (0)
    PG8_STAMP();
    unsigned voffA[2], voffB[2];
#pragma unroll
    for (int i = 0; i < 2; ++i) { int R, C; stage_rc(tid * 16 + i * 8192, R, C); const int Rb = Epi::PERM ? ((R & ~31) + perm32(R & 31)) : R;
        voffA[i] = (unsigned)(R * K + C) * 2u; voffB[i] = (unsigned)(Rb * K + C) * 2u; }
    const size_t kstep = (size_t)(BK * 2);
    const size_t hstep = (size_t)HALF * K * 2;
    const size_t tstep = 2 * hstep;
    const unsigned ldsw = (unsigned)wid * 1024u;
    const int aoff = lds_byte(wr * 64 + fr, fq * 8), boff = lds_byte(wc * 32 + fr, fq * 8);
#define PG8_SA(b, h) (((b) * 2 + (h)) * HTB)
#define PG8_SB(b, h) ((4 + (b) * 2 + (h)) * HTB)
#define PG8_STAGE(bufoff, gbase, voff) do { _Pragma("unroll") for (int _i = 0; _i < 2; ++_i) \
        __builtin_amdgcn_global_load_lds((const unsigned*)((const char*)(gbase) + (voff)[_i]), (PG8_LAS unsigned*)(lds + (bufoff) + ldsw + _i * 8192), 16, 0, 0); } while (0)
#define PG8_LDA(dst, b, h) do { _Pragma("unroll") for (int m = 0; m < 4; ++m) _Pragma("unroll") for (int k = 0; k < 2; ++k) dst[m][k] = *(const PG8_LAS bf16x8*)(lds + PG8_SA(b, h) + aoff + m * 2048 + k * 1024); } while (0)
#define PG8_LDB(dst, b, h) do { _Pragma("unroll") for (int n = 0; n < 2; ++n) _Pragma("unroll") for (int k = 0; k < 2; ++k) dst[n][k] = *(const PG8_LAS bf16x8*)(lds + PG8_SB(b, h) + boff + n * 2048 + k * 1024); } while (0)
#define PG8_MMA(ai, bj, At, Bt) do { __builtin_amdgcn_s_setprio(1); _Pragma("unroll") for (int m = 0; m < 4; ++m) _Pragma("unroll") for (int n = 0; n < 2; ++n) _Pragma("unroll") for (int k = 0; k < 2; ++k) \
        acc[ai][bj][m][n] = __builtin_amdgcn_mfma_f32_16x16x32_bf16(Bt[n][k], At[m][k], acc[ai][bj][m][n], 0, 0, 0); __builtin_amdgcn_s_setprio(0); } while (0)
#define PG8_WAIT_V(n) asm volatile("s_waitcnt vmcnt(" #n ")" ::: "memory")
#define PG8_WAIT_L(n) asm volatile("s_waitcnt lgkmcnt(" #n ")" ::: "memory")
#define PG8_BAR __builtin_amdgcn_s_barrier()
#define PG8_SCHED __builtin_amdgcn_sched_barrier(0)
    Unit cur, nxt; int ui = 0;
    if (!S.next(0, cur)) return;
    f32x4 acc[2][2][4][2];
#pragma unroll
    for (int a = 0; a < 2; ++a)
#pragma unroll
        for (int b = 0; b < 2; ++b)
#pragma unroll
            for (int m = 0; m < 4; ++m)
#pragma unroll
                for (int n = 0; n < 2; ++n) acc[a][b][m][n] = (f32x4){0.f, 0.f, 0.f, 0.f};
    bf16x8 At[4][2], B0[2][2], B1[2][2];
    const char* cA = (const char*)g.A + (size_t)cur.pm * tstep; const char* cB = (const char*)g.Bt + (size_t)cur.pn * tstep;
    S.a_ready(cur);
    PG8_STAGE(PG8_SB(0, 0), cB, voffB); PG8_STAGE(PG8_SA(0, 0), cA, voffA); PG8_STAGE(PG8_SB(0, 1), cB + hstep, voffB); PG8_STAGE(PG8_SA(0, 1), cA + hstep, voffA);
    if (wr == 1) PG8_BAR;
    PG8_WAIT_V(4); PG8_BAR;
    PG8_STAGE(PG8_SB(1, 0), cB + kstep, voffB); PG8_STAGE(PG8_SA(1, 0), cA + kstep, voffA); PG8_STAGE(PG8_SB(1, 1), cB + hstep + kstep, voffB);
    PG8_WAIT_V(6); PG8_BAR;
    PG8_STAMP();
    for (;;) {
        const bool has_next = S.next(ui + 1, nxt);
        const char* nA = has_next ? (const char*)g.A + (size_t)nxt.pm * tstep : cA; const char* nB = has_next ? (const char*)g.Bt + (size_t)nxt.pn * tstep : cB;
        for (int t = 0; t < nt; t += 2) {
            const bool last = (t == nt - 2);
            const char* a1 = cA + (size_t)(t + 1) * kstep;
            const char* a2 = last ? nA : cA + (size_t)(t + 2) * kstep; const char* b2 = last ? nB : cB + (size_t)(t + 2) * kstep;
            const char* a3 = a2 + kstep; const char* b3 = b2 + kstep;
            if (last && has_next) S.a_ready(nxt);
            PG8_LDB(B0, 0, 0); PG8_SCHED; PG8_LDA(At, 0, 0); PG8_STAGE(PG8_SA(1, 1), a1 + hstep, voffA);
            PG8_WAIT_L(8); PG8_BAR; PG8_WAIT_L(0); PG8_MMA(0, 0, At, B0); PG8_BAR; PG8_SCHED;
            PG8_LDB(B1, 0, 1); PG8_STAGE(PG8_SB(0, 0), b2, voffB);
            PG8_BAR; PG8_WAIT_L(0); PG8_MMA(0, 1, At, B1); PG8_BAR;
            PG8_LDA(At, 0, 1); PG8_STAGE(PG8_SA(0, 0), a2, voffA);
            PG8_BAR; PG8_WAIT_L(0); PG8_MMA(1, 0, At, B0); PG8_BAR; PG8_SCHED;
            PG8_STAGE(PG8_SB(0, 1), b2 + hstep, voffB);
            PG8_WAIT_V(6); PG8_BAR; PG8_MMA(1, 1, At, B1); PG8_BAR;
            PG8_LDB(B0, 1, 0); PG8_SCHED; PG8_LDA(At, 1, 0); PG8_STAGE(PG8_SA(0, 1), a2 + hstep, voffA);
            PG8_WAIT_L(8); PG8_BAR; PG8_WAIT_L(0); PG8_MMA(0, 0, At, B0); PG8_BAR; PG8_SCHED;
            PG8_LDB(B1, 1, 1); PG8_STAGE(PG8_SB(1, 0), b3, voffB);
            PG8_BAR; PG8_WAIT_L(0); PG8_MMA(0, 1, At, B1); PG8_BAR;
            PG8_LDA(At, 1, 1); PG8_STAGE(PG8_SA(1, 0), a3, voffA);
            PG8_BAR; PG8_WAIT_L(0); PG8_MMA(1, 0, At, B0); PG8_BAR; PG8_SCHED;
            PG8_STAGE(PG8_SB(1, 1), b3 + hstep, voffB);
            PG8_WAIT_V(6); PG8_BAR; PG8_MMA(1, 1, At, B1); PG8_BAR;
        }
        PG8_STAMP();
        if constexpr (!Epi::AFTER_DRAIN) { E(acc, cur, wr, wc, fr, fq); S.done(cur); }
        PG8_STAMP();
        if (!has_next) break;
#pragma unroll
        for (int a = 0; a < 2; ++a)
#pragma unroll
            for (int b = 0; b < 2; ++b)
#pragma unroll
                for (int m = 0; m < 4; ++m)
#pragma unroll
                    for (int n = 0; n < 2; ++n) acc[a][b][m][n] = (f32x4){0.f, 0.f, 0.f, 0.f};
        cur = nxt; cA = nA; cB = nB; ++ui;
    }
    PG8_WAIT_V(0);
    if (wr == 0) PG8_BAR;
    PG8_BAR;
    if constexpr (Epi::AFTER_DRAIN) { E.fused(acc, cur, wr, wc, fr, fq, lds, wid, lane); S.done(cur); }
    PG8_STAMP();
    if (STAMP && wid == 0) { stamps[lane] = lane < nts ? (((unsigned long long)(unsigned)ts_hi << 32) | (unsigned)ts_lo) : 0ull;
        if (lane == 62) stamps[62] = rt_entry; if (lane == 63) stamps[63] = (unsigned long long)wall_clock64(); }
#undef PG8_STAMP
#undef PG8_SA
#undef PG8_SB
#undef PG8_STAGE
#undef PG8_LDA
#undef PG8_LDB
#undef PG8_MMA
#undef PG8_WAIT_V
#undef PG8_WAIT_L
#undef PG8_BAR
#undef PG8_SCHED
}
}

namespace pg8 {
struct OrderSkipV : StaticOrder {
    __device__ __forceinline__ bool next(int i, Unit& u) const { if (!StaticOrder::next(i, u)) return false; u.pn += (u.pn >= 2) ? 1 : 0; return true; }
};
struct EpiVT {
    static constexpr bool PERM = true, AFTER_DRAIN = false;
    bf16_t* vt; bf16_t* vtc;
    __device__ __forceinline__ void operator()(const f32x4 (&acc)[2][2][4][2], const Unit& u, int wr, int wc, int fr, int fq) const {
        bf16_t* base; int ldc;
        if (u.pn < 128) { base = vt + (size_t)((u.pn >> 4) * 256) * 4096 + (u.pn & 15) * 256; ldc = 4096; }
        else { base = vtc + (size_t)((u.pn - 128) * 256) * 256; ldc = 256; }
        const int row0 = wr * 64 + fr, col0 = wc * 32 + 8 * fq;
#pragma unroll
        for (int ai = 0; ai < 2; ++ai)
#pragma unroll
            for (int m = 0; m < 4; ++m) { bf16_t* rowp = base + (size_t)(row0 + ai * HALF + m * 16) * ldc + col0;
#pragma unroll
                for (int bj = 0; bj < 2; ++bj) { const f32x4 v0 = acc[ai][bj][m][0], v1 = acc[ai][bj][m][1];
                    u32x4 w; w.x = cvt_pk_bf16(v0[0], v0[1]); w.y = cvt_pk_bf16(v0[2], v0[3]); w.z = cvt_pk_bf16(v1[0], v1[1]); w.w = cvt_pk_bf16(v1[2], v1[3]);
                    *(u32x4*)(rowp + bj * HALF) = w; } }
    }
};
struct EpiXinS {
    static constexpr bool PERM = true, AFTER_DRAIN = false;
    bf16_t* O; bf16_t* vg;
    __device__ __forceinline__ void operator()(const f32x4 (&acc)[2][2][4][2], const Unit& u, int wr, int wc, int fr, int fq) const {
        const int row0 = u.pm * BM + wr * 64 + fr;
        const bool su = u.pn == 7;
        const int col0 = u.pn * BM + wc * 32 + 8 * fq;
#pragma unroll
        for (int ai = 0; ai < 2; ++ai)
#pragma unroll
            for (int m = 0; m < 4; ++m) {
                const int tt = row0 + ai * HALF + m * 16;
                bf16_t* rowp = O + (size_t)tt * 2048 + col0;
                const int l = tt & 4095, nch = (tt >> 12) * NCHB + 8 + (l >> 5), j = l & 31;
#pragma unroll
                for (int bj = 0; bj < 2; ++bj) { const f32x4 v0 = acc[ai][bj][m][0], v1 = acc[ai][bj][m][1];
                    u32x4 w; w.x = cvt_pk_bf16(v0[0], v0[1]); w.y = cvt_pk_bf16(v0[2], v0[3]); w.z = cvt_pk_bf16(v1[0], v1[1]); w.w = cvt_pk_bf16(v1[2], v1[3]);
                    if (su) { const int c = wc * 32 + 8 * fq + bj * HALF;
                        *(u32x4*)(vg + ((size_t)(c >> 4) * NCHP + nch) * KV + 256 + j * 16 + (c & 15)) = w; }
                    else *(u32x4*)(rowp + bj * HALF) = w; }
            }
    }
};
struct EpiRes {
    static constexpr bool PERM = false, AFTER_DRAIN = false;
    const float* xl; const float* xc; float* ol; float* oc; const float* g1;
    __device__ __forceinline__ void operator()(const f32x4 (&acc)[2][2][4][2], const Unit& u, int wr, int wc, int fr, int fq) const {
        const int row0 = u.pm * BM + wr * 64 + fr, col0 = u.pn * BM + wc * 32 + 4 * fq;
        const bool lat = u.pm < 128;
        const float* gp = g1 + (size_t)(lat ? (u.pm >> 4) : 8) * 6144 + col0;
        const float* __restrict__ src = lat ? xl : xc - (size_t)32768 * 1024; float* __restrict__ dst = lat ? ol : oc - (size_t)32768 * 1024;
        f32x4 gv[2][2];
#pragma unroll
        for (int bj = 0; bj < 2; ++bj)
#pragma unroll
            for (int n = 0; n < 2; ++n) gv[bj][n] = *(const f32x4*)(gp + bj * HALF + n * 16);
#pragma unroll
        for (int ai = 0; ai < 2; ++ai)
#pragma unroll
            for (int m = 0; m < 4; m += 2) { const size_t off = (size_t)(row0 + ai * HALF + m * 16) * 1024 + col0;
                f32x4 x[2][2][2];
#pragma unroll
                for (int mm = 0; mm < 2; ++mm)
#pragma unroll
                    for (int bj = 0; bj < 2; ++bj)
#pragma unroll
                        for (int n = 0; n < 2; ++n) x[mm][bj][n] = *(const f32x4*)(src + off + (size_t)mm * 16 * 1024 + bj * HALF + n * 16);
#pragma unroll
                for (int mm = 0; mm < 2; ++mm)
#pragma unroll
                    for (int bj = 0; bj < 2; ++bj)
#pragma unroll
                        for (int n = 0; n < 2; ++n) *(f32x4*)(dst + off + (size_t)mm * 16 * 1024 + bj * HALF + n * 16) = x[mm][bj][n] + gv[bj][n] * acc[ai][bj][m + mm][n]; }
    }
};
}

template <int MODE, int DEEP = 0, typename FA, typename FB, typename FE>
__device__ __forceinline__ void gemm128(FA arow, FB brow, int K, FE epi, unsigned char* smem) {
    const int tid = TIDX, lane = tid & 63, w = tid >> 6;
    const int wm = w >> 2, wn = w & 3;
    const bf16_t* pa[2]; const bf16_t* pb[2]; int soff[2];
#pragma unroll
    for (int i = 0; i < 2; ++i) {
        int c = tid + 512 * i, row = c >> 3, kc = c & 7;
        pa[i] = arow(row) + kc * 8; pb[i] = brow(row) + kc * 8;
        soff[i] = row * 128 + ((kc ^ (row & 7)) << 4);
    }
    __syncthreads();
    f32x4 acc[4][2];
#pragma unroll
    for (int i = 0; i < 4; ++i)
#pragma unroll
        for (int j = 0; j < 2; ++j) acc[i][j] = f32x4{0.f, 0.f, 0.f, 0.f};
    const int nk = K >> 6;
    const int lr = lane & 15, lg = lane >> 4, sw = lane & 7;
    if constexpr (DEEP != 0) {
    uint4 xa00 = *(const uint4*)pa[0], xb00 = *(const uint4*)pb[0], xa01 = *(const uint4*)pa[1], xb01 = *(const uint4*)pb[1];
    uint4 xa10 = make_uint4(0, 0, 0, 0), xb10 = xa10, xa11 = xa10, xb11 = xa10;
    if (nk > 1) { xa10 = *(const uint4*)(pa[0] + 64); xb10 = *(const uint4*)(pb[0] + 64); xa11 = *(const uint4*)(pa[1] + 64); xb11 = *(const uint4*)(pb[1] + 64); }
    *(uint4*)(smem + soff[0]) = xa00; *(uint4*)(smem + 16384 + soff[0]) = xb00;
    *(uint4*)(smem + soff[1]) = xa01; *(uint4*)(smem + 16384 + soff[1]) = xb01;
    __syncthreads();
    for (int kt = 0; kt < nk; kt += 2) {
        {
            const int kt_ = kt;
            const int cur = kt_ & 1;
            if (kt_ + 2 < nk) {
                xa00 = *(const uint4*)(pa[0] + (kt_ + 2) * 64); xb00 = *(const uint4*)(pb[0] + (kt_ + 2) * 64);
                xa01 = *(const uint4*)(pa[1] + (kt_ + 2) * 64); xb01 = *(const uint4*)(pb[1] + (kt_ + 2) * 64);
            }
            const unsigned char* sA = smem + cur * 32768;
            const unsigned char* sB = sA + 16384;
#pragma unroll
            for (int ks = 0; ks < 2; ++ks) {
                bf16x8 af[4], bfv[2];
                const int choff = (((ks * 4 + lg) ^ sw) << 4);
#pragma unroll
                for (int fi = 0; fi < 4; ++fi) af[fi] = *(const bf16x8*)(sA + (wm * 64 + fi * 16 + lr) * 128 + choff);
#pragma unroll
                for (int fj = 0; fj < 2; ++fj) bfv[fj] = *(const bf16x8*)(sB + (wn * 32 + fj * 16 + lr) * 128 + choff);
#pragma unroll
                for (int fi = 0; fi < 4; ++fi)
#pragma unroll
                    for (int fj = 0; fj < 2; ++fj) acc[fi][fj] = __builtin_amdgcn_mfma_f32_16x16x32_bf16(af[fi], bfv[fj], acc[fi][fj], 0, 0, 0);
            }
            if (kt_ + 1 < nk) {
                unsigned char* dA = smem + (cur ^ 1) * 32768;
                *(uint4*)(dA + soff[0]) = xa10; *(uint4*)(dA + 16384 + soff[0]) = xb10;
                *(uint4*)(dA + soff[1]) = xa11; *(uint4*)(dA + 16384 + soff[1]) = xb11;
            }
            __syncthreads();
        }
        if (kt + 1 < nk)
        {
            const int kt_ = kt + 1;
            const int cur = kt_ & 1;
            if (kt_ + 2 < nk) {
                xa10 = *(const uint4*)(pa[0] + (kt_ + 2) * 64); xb10 = *(const uint4*)(pb[0] + (kt_ + 2) * 64);
                xa11 = *(const uint4*)(pa[1] + (kt_ + 2) * 64); xb11 = *(const uint4*)(pb[1] + (kt_ + 2) * 64);
            }
            const unsigned char* sA = smem + cur * 32768;
            const unsigned char* sB = sA + 16384;
#pragma unroll
            for (int ks = 0; ks < 2; ++ks) {
                bf16x8 af[4], bfv[2];
                const int choff = (((ks * 4 + lg) ^ sw) << 4);
#pragma unroll
                for (int fi = 0; fi < 4; ++fi) af[fi] = *(const bf16x8*)(sA + (wm * 64 + fi * 16 + lr) * 128 + choff);
#pragma unroll
                for (int fj = 0; fj < 2; ++fj) bfv[fj] = *(const bf16x8*)(sB + (wn * 32 + fj * 16 + lr) * 128 + choff);
#pragma unroll
                for (int fi = 0; fi < 4; ++fi)
#pragma unroll
                    for (int fj = 0; fj < 2; ++fj) acc[fi][fj] = __builtin_amdgcn_mfma_f32_16x16x32_bf16(af[fi], bfv[fj], acc[fi][fj], 0, 0, 0);
            }
            if (kt_ + 1 < nk) {
                unsigned char* dA = smem + (cur ^ 1) * 32768;
                *(uint4*)(dA + soff[0]) = xa00; *(uint4*)(dA + 16384 + soff[0]) = xb00;
                *(uint4*)(dA + soff[1]) = xa01; *(uint4*)(dA + 16384 + soff[1]) = xb01;
            }
            __syncthreads();
        }
    }
    } else {
    uint4 ra[2], rb[2];
#pragma unroll
    for (int i = 0; i < 2; ++i) { ra[i] = *(const uint4*)pa[i]; rb[i] = *(const uint4*)pb[i]; }
#pragma unroll
    for (int i = 0; i < 2; ++i) { *(uint4*)(smem + soff[i]) = ra[i]; *(uint4*)(smem + 16384 + soff[i]) = rb[i]; }
    __syncthreads();
    for (int kt = 0; kt < nk; ++kt) {
        const int cur = kt & 1;
        if (kt + 1 < nk) {
#pragma unroll
            for (int i = 0; i < 2; ++i) { ra[i] = *(const uint4*)(pa[i] + (kt + 1) * 64); rb[i] = *(const uint4*)(pb[i] + (kt + 1) * 64); }
        }
        const unsigned char* sA = smem + cur * 32768;
        const unsigned char* sB = sA + 16384;
#pragma unroll
        for (int ks = 0; ks < 2; ++ks) {
            bf16x8 af[4], bfv[2];
            const int choff = (((ks * 4 + lg) ^ sw) << 4);
#pragma unroll
            for (int fi = 0; fi < 4; ++fi) af[fi] = *(const bf16x8*)(sA + (wm * 64 + fi * 16 + lr) * 128 + choff);
#pragma unroll
            for (int fj = 0; fj < 2; ++fj) bfv[fj] = *(const bf16x8*)(sB + (wn * 32 + fj * 16 + lr) * 128 + choff);
#pragma unroll
            for (int fi = 0; fi < 4; ++fi)
#pragma unroll
                for (int fj = 0; fj < 2; ++fj) acc[fi][fj] = __builtin_amdgcn_mfma_f32_16x16x32_bf16(af[fi], bfv[fj], acc[fi][fj], 0, 0, 0);
        }
        if (kt + 1 < nk) {
            unsigned char* dA = smem + (cur ^ 1) * 32768;
#pragma unroll
            for (int i = 0; i < 2; ++i) { *(uint4*)(dA + soff[i]) = ra[i]; *(uint4*)(dA + 16384 + soff[i]) = rb[i]; }
        }
        __syncthreads();
    }
    }
    if (MODE == 2) {
#pragma unroll
        for (int fi = 0; fi < 4; ++fi)
#pragma unroll
            for (int fj = 0; fj < 2; ++fj) epi(wm * 64 + fi * 16 + lg * 4, wn * 32 + fj * 16 + lr, acc[fi][fj]);
    } else if (MODE == 3) {
        float* tc = (float*)smem;
#pragma unroll
        for (int fi = 0; fi < 4; ++fi)
#pragma unroll
            for (int fj = 0; fj < 2; ++fj)
#pragma unroll
                for (int j = 0; j < 4; ++j) tc[(wm * 64 + fi * 16 + lg * 4 + j) * 132 + wn * 32 + fj * 16 + lr] = acc[fi][fj][j];
        __syncthreads();
    } else if (MODE == 1) {
        float* tc = (float*)smem;
#pragma unroll
        for (int fi = 0; fi < 4; ++fi)
#pragma unroll
            for (int fj = 0; fj < 2; ++fj)
#pragma unroll
                for (int j = 0; j < 4; ++j) tc[(wm * 64 + fi * 16 + lg * 4 + j) * 129 + wn * 32 + fj * 16 + lr] = acc[fi][fj][j];
        __syncthreads();
    } else {
#pragma unroll
        for (int fi = 0; fi < 4; ++fi)
#pragma unroll
            for (int fj = 0; fj < 2; ++fj)
#pragma unroll
                for (int j = 0; j < 4; ++j) epi(wm * 64 + fi * 16 + lg * 4 + j, wn * 32 + fj * 16 + lr, f32x4{acc[fi][fj][j], 0.f, 0.f, 0.f});
    }
}

__device__ void phase_prep(const Params& p, unsigned char* smem, int part) {
    const int tid = TIDX, lane = tid & 63, w = tid >> 6;
    unsigned char* ws = p.ws;
    constexpr int N_MOD = 192, N_TR = 1568, N_WQK = 512, N_DFTL = 0, N_DFTS = 32, N_S5T = 8;
    constexpr int O_TR = N_MOD, O_WQK = O_TR + N_TR, O_DFTL = O_WQK + N_WQK, O_DFTS = O_DFTL + N_DFTL, O_S5T = O_DFTS + N_DFTS, N_ALL = O_S5T + N_S5T;
    float* tab = (float*)(smem + 98304);
    if (part == 1) {
        for (int j = tid; j < 4096; j += NTHREADS) tab[j] = cospif((float)j * (1.0f / 2048.0f));
        __syncthreads();
    }
    for (int it = BIDX; it < N_ALL; it += gridDim.x) {
        if (((it < O_TR || it >= O_S5T) ? 0 : 1) != part) continue;
        if (it < O_TR) {
            const int L = it / 96, c0 = (it % 96) * 64;
            float* sv = (float*)smem;
            float* red = (float*)(smem + 36864);
            for (int idx = tid; idx < 9 * 1024; idx += NTHREADS) {
                int r = idx >> 10, k = idx & 1023;
                float v = (r < 8) ? p.in[I_C][r * 1024 + k] : p.in[I_CCTX][k];
                sv[idx] = v / (1.0f + __expf(-v));
            }
            __syncthreads();
            float acc[9];
#pragma unroll
            for (int r = 0; r < 9; ++r) acc[r] = 0.f;
            const float* aw = p.in[I_ADAW] + (size_t)L * 1024 * 6144 + c0 + lane;
#pragma unroll 1
            for (int k0 = w * 128; k0 < w * 128 + 128; k0 += 16) {
                float wv[16];
#pragma unroll
                for (int u = 0; u < 16; ++u) wv[u] = aw[(size_t)(k0 + u) * 6144];
#pragma unroll
                for (int u = 0; u < 16; ++u)
#pragma unroll
                    for (int r = 0; r < 9; ++r) acc[r] += sv[r * 1024 + k0 + u] * wv[u];
            }
#pragma unroll
            for (int r = 0; r < 9; ++r) red[(w * 9 + r) * 64 + lane] = acc[r];
            __syncthreads();
            for (int o = tid; o < 576; o += NTHREADS) {
                int r = o >> 6, col = o & 63;
                float s = 0.f;
#pragma unroll
                for (int ww = 0; ww < 8; ++ww) s += red[(ww * 9 + r) * 64 + col];
                ((float*)(ws + OFF_MOD))[(size_t)(L * 9 + r) * 6144 + c0 + col] = s + p.in[I_ADAB][L * 6144 + c0 + col];
            }
            __syncthreads();
        } else if (it < O_WQK) {
            int idx = it - O_TR;
            const int L = idx / 784; int rem = idx % 784;
            const float* src; bf16_t* dst; int Kd, Nd, tk, tn;
            if (rem < 512) { tk = rem >> 5; tn = rem & 31; Kd = 1024; Nd = 2048; src = p.in[I_WIN] + (size_t)L * 1024 * 2048; dst = (bf16_t*)(ws + OFF_WINT + L * SZ_WINT); }
            else if (rem < 768) { rem -= 512; tk = rem >> 4; tn = rem & 15; Kd = 1024; Nd = 1024; src = p.in[I_WOUT] + (size_t)L * 1024 * 1024; dst = (bf16_t*)(ws + OFF_WOUTT + L * SZ_WOUTT); }
            else { rem -= 768; tk = rem >> 2; tn = rem & 3; Kd = 256; Nd = 256; src = p.in[I_WGLU] + (size_t)L * 256 * 256; dst = (bf16_t*)(ws + OFF_WGLUT + L * SZ_WGLUT); }
            float* tl = (float*)smem;
#pragma unroll
            for (int i = 0; i < 8; ++i) { int kk = i * 8 + w, nn = lane; tl[kk * 65 + nn] = src[(size_t)(tk * 64 + kk) * Nd + tn * 64 + nn]; }
            __syncthreads();
#pragma unroll
            for (int i = 0; i < 1; ++i) {
                const int nn = tid >> 3, k0 = (tid & 7) * 8;
                const unsigned w0 = pack2(tl[(k0 + 0) * 65 + nn], tl[(k0 + 1) * 65 + nn]), w1 = pack2(tl[(k0 + 2) * 65 + nn], tl[(k0 + 3) * 65 + nn]);
                const unsigned w2 = pack2(tl[(k0 + 4) * 65 + nn], tl[(k0 + 5) * 65 + nn]), w3 = pack2(tl[(k0 + 6) * 65 + nn], tl[(k0 + 7) * 65 + nn]);
                *(uint4*)(dst + (size_t)(tn * 64 + nn) * Kd + tk * 64 + k0) = make_uint4(w0, w1, w2, w3);
            }
            __syncthreads();
        } else if (it < O_DFTL) {
            int idx = it - O_WQK;
            const int L = idx >> 8, hz = (idx >> 4) & 15, kb = idx & 15;
            const int lr = lane & 15, g = lane >> 4;
            const float* keysr = p.in[I_KEYS] + ((size_t)(L * 16 + hz) * 128 + w * 16 + lr) * 128 + 32 * g;
            float af[32];
#pragma unroll
            for (int u = 0; u < 8; ++u) { const float4 v = *(const float4*)(keysr + 4 * u); af[4 * u] = v.x; af[4 * u + 1] = v.y; af[4 * u + 2] = v.z; af[4 * u + 3] = v.w; }
            bf16_t* dst = (bf16_t*)(ws + OFF_WQKT + L * SZ_WQKT);
#pragma unroll 1
            for (int kt = 0; kt < 4; ++kt) {
                const int k0 = kb * 64 + kt * 16;
                const float* wqr = p.in[I_WQ] + (size_t)L * 1024 * 2048 + (size_t)(k0 + lr) * 2048 + hz * 128 + 32 * g;
                float bfv[32];
#pragma unroll
                for (int u = 0; u < 8; ++u) { const float4 v = *(const float4*)(wqr + 4 * u); bfv[4 * u] = v.x; bfv[4 * u + 1] = v.y; bfv[4 * u + 2] = v.z; bfv[4 * u + 3] = v.w; }
                f32x4 acc = f32x4{0.f, 0.f, 0.f, 0.f};
#pragma unroll
                for (int s = 0; s < 32; ++s) acc = __builtin_amdgcn_mfma_f32_16x16x4f32(af[s], bfv[s], acc, 0, 0, 0);
#pragma unroll
                for (int j = 0; j < 4; ++j) dst[(size_t)(hz * 128 + w * 16 + 4 * g + j) * 1024 + k0 + lr] = f2bf(acc[j]);
            }
        } else if (it < O_DFTS) {
            const int k = it - O_DFTL;
            bf16_t* dst = (bf16_t*)(ws + OFF_DFTL) + (size_t)k * 8192;
#pragma unroll
            for (int i = 0; i < 2; ++i) {
                int c = tid + 512 * i, part = c >> 9, l0 = (c & 511) * 8;
                unsigned pk[4];
#pragma unroll
                for (int e = 0; e < 4; ++e) {
                    int i0 = ((k * (l0 + 2 * e)) + part * 1024) & 4095, i1 = ((k * (l0 + 2 * e + 1)) + part * 1024) & 4095;
                    pk[e] = pack2(tab[i0] * (1.0f / 512.0f), tab[i1] * (1.0f / 512.0f));
                }
                *(uint4*)(dst + part * 4096 + l0) = make_uint4(pk[0], pk[1], pk[2], pk[3]);
            }
        } else if (it < O_S5T) {
            const int dsub = it - O_DFTS;
            bf16_t* dc = (bf16_t*)(ws + OFF_DFTC);
            for (int c = tid + NTHREADS * dsub; c < 16384; c += NTHREADS * N_DFTS) {
                int k = c >> 6, cc = c & 63, part = cc >> 5, l0 = (cc & 31) * 8;
                unsigned pk[4];
#pragma unroll
                for (int e = 0; e < 4; ++e) {
                    int i0 = ((((k * (l0 + 2 * e)) & 255) << 4) + part * 3072) & 4095, i1 = ((((k * (l0 + 2 * e + 1)) & 255) << 4) + part * 3072) & 4095;
                    pk[e] = pack2(tab[i0] * (1.0f / 128.0f), tab[i1] * (1.0f / 128.0f));
                }
                *(uint4*)(dc + (size_t)k * 512 + part * 256 + l0) = make_uint4(pk[0], pk[1], pk[2], pk[3]);
            }
            bf16_t* dd = (bf16_t*)(ws + OFF_DFTD);
            for (int c = tid + NTHREADS * dsub; c < 1024; c += NTHREADS * N_DFTS) {
                int m = c >> 3, d0 = (c & 7) * 8, kd = m & 63, sh = (m >= 64) ? 1024 : 0;
                unsigned pk[4];
#pragma unroll
                for (int e = 0; e < 4; ++e) {
                    int i0 = ((((kd * (d0 + 2 * e)) & 63) << 6) + sh) & 4095, i1 = ((((kd * (d0 + 2 * e + 1)) & 63) << 6) + sh) & 4095;
                    pk[e] = pack2(tab[i0], tab[i1]);
                }
                *(uint4*)(dd + m * 64 + d0) = make_uint4(pk[0], pk[1], pk[2], pk[3]);
            }
            bf16_t* mab = (bf16_t*)(ws + OFF_MATAB); bf16_t* mad = (bf16_t*)(ws + OFF_MATAD);
            for (int c = tid + NTHREADS * dsub; c < 128 * 128; c += NTHREADS * N_DFTS) {
                const int m = c >> 7, k = c & 127;
                { const int k1 = m >> 1, ri = m & 1, rz = k >> 6, l1 = k & 63, ph = ((k1 * l1) & 63) << 6;
                  const int idx = (ri == rz) ? ph : (ri == 0 ? ph + 3072 : ph + 1024);
                  mab[c] = f2bf(tab[idx & 4095]); }
                { const int k2 = m & 63, ri = k >> 6, l2 = k & 63, ph = ((k2 * l2) & 63) << 6;
                  mad[c] = f2bf(tab[(ph + (ri ? 3072 : 0)) & 4095]); }
            }
            float2* tw = (float2*)(ws + OFF_TW);
            for (int c = tid + NTHREADS * dsub; c < 4096; c += NTHREADS * N_DFTS) {
                const int k1 = c >> 6, l2 = c & 63, ph = (k1 * l2) & 4095;
                tw[c] = make_float2(tab[ph] * (1.0f / 512.0f), tab[(ph + 3072) & 4095] * (1.0f / 512.0f));
            }
        } else {
            const int gid = (it - O_S5T) * NTHREADS + tid;
            const int ia = gid;
            const float are = p.in[I_ARE][ia], aim = p.in[I_AIM][ia];
            const float dt = expf(p.in[I_LOGDT][ia >> 6]);
            float2* pw = (float2*)(ws + OFF_POWA) + (size_t)(ia >> 6) * 33 * 64 + (ia & 63);
            float abr = 1.f, abi = 0.f;
            for (int tau = 0; tau <= 32; ++tau) {
                float mag = expf(are * dt * (float)tau), s, c;
                sincosf(aim * dt * (float)tau, &s, &c);
                pw[tau * 64] = make_float2(mag * c, mag * s);
                if (tau == 1) { abr = mag * c; abi = mag * s; }
            }
            const float nr = abr - 1.0f, ni = abi, den = are * are + aim * aim;
            const float qr = (nr * are + ni * aim) / den, qi = (ni * are - nr * aim) / den;
            float2* bb = (float2*)(ws + OFF_BBAR) + (size_t)ia * 16;
#pragma unroll
            for (int h = 0; h < 16; ++h) {
                float br = p.in[I_BRE][(size_t)ia * 16 + h], bi = p.in[I_BIM][(size_t)ia * 16 + h];
                bb[h] = make_float2(qr * br - qi * bi, qr * bi + qi * br);
            }
        }
    }
}

__device__ void norm_tokens(const Params& p, int L, int which, int ntok, bool from_input, int item0, int nitems_total) {
    const int tid = TIDX, lane = tid & 63, w = tid >> 6;
    const float* modL = (const float*)(p.ws + OFF_MOD) + (size_t)L * 9 * 6144;
    const float* gvec = p.in[which ? I_N2G : I_N1G] + L * 1024;
    bf16_t* dst = (bf16_t*)(p.ws + OFF_ACT);
    float4 gq[4];
#pragma unroll
    for (int i = 0; i < 4; ++i) gq[i] = *(const float4*)(gvec + (i * 64 + lane) * 4);
    int crow = -1;
    float4 aq[4], bq[4];
#pragma unroll
    for (int i = 0; i < 4; ++i) { aq[i] = make_float4(0.f, 0.f, 0.f, 0.f); bq[i] = aq[i]; }
    for (int it = item0 + BIDX; it < nitems_total; it += gridDim.x) {
        if (it < item0) continue;
        const int tt = (it - item0) * 8 + w;
        if (tt >= ntok) continue;
        const float* src;
        if (tt < T) src = (from_input ? p.in[I_X] : p.out) + (size_t)tt * 1024;
        else src = (from_input ? p.in[I_CTX] : (const float*)(p.ws + OFF_XCTX)) + (size_t)(tt - T) * 1024;
        float4 v[4]; float ss = 0.f;
#pragma unroll
        for (int i = 0; i < 4; ++i) v[i] = *(const float4*)(src + (i * 64 + lane) * 4);
        const int mrow = tok_modrow(tt);
        if (mrow != crow) {
            const float* sh = modL + (size_t)mrow * 6144 + (which ? 3072 : 0);
#pragma unroll
            for (int i = 0; i < 4; ++i) { bq[i] = *(const float4*)(sh + (i * 64 + lane) * 4); aq[i] = *(const float4*)(sh + 1024 + (i * 64 + lane) * 4); }
            crow = mrow;
        }
#pragma unroll
        for (int i = 0; i < 4; ++i) ss += v[i].x * v[i].x + v[i].y * v[i].y + v[i].z * v[i].z + v[i].w * v[i].w;
        ss = wave_sum(ss);
        const float r = rsqrtf(ss * (1.0f / 1024.0f) + EPS);
#pragma unroll
        for (int i = 0; i < 4; ++i) {
            const int k = (i * 64 + lane) * 4;
            const float4 g = gq[i], a = aq[i], b = bq[i];
            float o0 = v[i].x * r * g.x * (1.f + a.x) + b.x, o1 = v[i].y * r * g.y * (1.f + a.y) + b.y;
            float o2 = v[i].z * r * g.z * (1.f + a.z) + b.z, o3 = v[i].w * r * g.w * (1.f + a.w) + b.w;
            *(uint2*)(dst + (size_t)tt * 1024 + k) = make_uint2(pack2(o0, o1), pack2(o2, o3));
            if (which) {
                int wd = 0;
                const float c0 = fminf(fmaxf(o0 * 8.0f, -448.0f), 448.0f), c1 = fminf(fmaxf(o1 * 8.0f, -448.0f), 448.0f);
                const float c2 = fminf(fmaxf(o2 * 8.0f, -448.0f), 448.0f), c3 = fminf(fmaxf(o3 * 8.0f, -448.0f), 448.0f);
                wd = __builtin_amdgcn_cvt_pk_fp8_f32(c0, c1, wd, false);
                wd = __builtin_amdgcn_cvt_pk_fp8_f32(c2, c3, wd, true);
                *(int*)(p.ws + OFF_H8 + (size_t)tt * 1024 + k) = wd;
            }
        }
    }
}

__device__ void phase_A(const Params& p, int L, unsigned char* smem) {
    if (L == 0) { phase_prep(p, smem, 1); __syncthreads(); }
    const int n_norm = TT / 8;
    const int n_kt = (L == 0) ? 1024 : 0;
    for (int it = BIDX; it < n_kt; it += gridDim.x) {
        const int gid = it * NTHREADS + TIDX;
        const int hp = gid & 15, h = (gid >> 4) & 15, tau = (gid >> 8) & 31, ldg = gid >> 13;
        const float* cre = p.in[I_CRE] + ((size_t)ldg * 16 + h) * 64;
        const float* cim = p.in[I_CIM] + ((size_t)ldg * 16 + h) * 64;
        const float2* pw = (const float2*)(p.ws + OFF_POWA) + ((size_t)ldg * 33 + tau) * 64;
        const float2* bb = (const float2*)(p.ws + OFF_BBAR) + (size_t)ldg * 64 * 16 + hp;
        float acc = 0.f;
#pragma unroll 1
        for (int q0 = 0; q0 < 64; q0 += 16) {
            float2 a[16], b[16]; float cr[16], ci[16];
#pragma unroll
            for (int u = 0; u < 4; ++u) {
                const float4 c4 = *(const float4*)(cre + q0 + 4 * u), d4 = *(const float4*)(cim + q0 + 4 * u);
                cr[4 * u] = c4.x; cr[4 * u + 1] = c4.y; cr[4 * u + 2] = c4.z; cr[4 * u + 3] = c4.w;
                ci[4 * u] = d4.x; ci[4 * u + 1] = d4.y; ci[4 * u + 2] = d4.z; ci[4 * u + 3] = d4.w;
            }
#pragma unroll
            for (int u = 0; u < 16; ++u) { a[u] = pw[q0 + u]; b[u] = bb[(q0 + u) * 16]; }
#pragma unroll
            for (int u = 0; u < 16; ++u) {
                const float wr = cr[u] * a[u].x - ci[u] * a[u].y, wi = cr[u] * a[u].y + ci[u] * a[u].x;
                acc += wr * b[u].x - wi * b[u].y;
            }
        }
        ((float*)(p.ws + OFF_KTAU))[gid] = acc;
    }
    norm_tokens(p, L, 0, TT, L == 0, n_kt, n_kt + n_norm);
}

__device__ void phase_B(const Params& p, int L, unsigned char* smem) {
    unsigned char* ws = p.ws;
    constexpr int N_G = 256, N_WC = 1536, N_WS = 512;
    const bf16_t* A = (const bf16_t*)(ws + OFF_ACT);
    const bf16_t* Bt = (const bf16_t*)(ws + OFF_WINT + L * SZ_WINT);
    bf16_t* xin = (bf16_t*)(ws + OFF_XIN);
    {
        PG8_LAS unsigned char* lds = (PG8_LAS unsigned char*)smem;
        const int bid = BIDX;
        pg8::Gemm g1{A, Bt, T, 1792, 1024};
        pg8::OrderSkipV s1; s1.init(T, 1792, (int)gridDim.x, bid);
        pg8::EpiXinS e1{xin, (bf16_t*)(ws + OFF_VG)};
        pg8::gemm_phase(lds, g1, s1, e1, nullptr);
        pg8::Gemm g2{Bt + (size_t)512 * 1024, A, 256, T, 1024};
        pg8::StaticOrder s2; s2.init(256, T, (int)gridDim.x, (bid + 128) & 255);
        pg8::EpiVT e2{(bf16_t*)(ws + OFF_VT), (bf16_t*)(ws + OFF_VTC)};
        pg8::gemm_phase(lds, g2, s2, e2, nullptr);
        __syncthreads();
    }
    for (int it = BIDX; it < N_G + N_WC + N_WS; it += gridDim.x) {
        if (it < N_G) {
            const int mt = 256 + (it >> 4), nt = it & 15;
            if (nt == 4 || nt == 5) {
                bf16_t* vtc = (bf16_t*)(ws + OFF_VTC);
                const int c = mt * 128 - T;
                bf16_t* base = vtc + (size_t)((c >> 8) * 256) * 256 + (c & 255);
                gemm128<0, 1>([&](int r) { return Bt + (size_t)(nt * 128 + r) * 1024; },
                           [&](int r) { return A + (size_t)(mt * 128 + r) * 1024; }, 1024,
                           [&](int m, int n, f32x4 vv) { base[(size_t)((nt - 4) * 128 + m) * 256 + n] = f2bf(vv[0]); }, smem);
            } else if (nt >= 14) {
                bf16_t* vgp = (bf16_t*)(ws + OFF_VG);
                gemm128<0, 1>([&](int r) { return A + (size_t)(mt * 128 + r) * 1024; },
                           [&](int r) { return Bt + (size_t)(nt * 128 + r) * 1024; }, 1024,
                           [&](int m, int n, f32x4 vv) { const int c = mt * 128 + m - T, cc = (nt - 14) * 128 + n;
                               const int nch = (c >> 8) * NCHB + ((c & 255) >> 5), j = c & 31;
                               vgp[((size_t)(cc >> 4) * NCHP + nch) * KV + 256 + j * 16 + (cc & 15)] = f2bf(vv[0]); }, smem);
            } else {
                gemm128<0, 1>([&](int r) { return A + (size_t)(mt * 128 + r) * 1024; },
                           [&](int r) { return Bt + (size_t)(nt * 128 + r) * 1024; }, 1024,
                           [&](int m, int n, f32x4 vv) { xin[(size_t)(mt * 128 + m) * 2048 + nt * 128 + n] = f2bf(vv[0]); }, smem);
            }
        } else if (it < N_G + N_WC) {
            const int cid = (it - N_G) * NTHREADS + TIDX;
            const int kc = cid % 96, m = (cid / 96) & 511, g = cid / (96 * 512);
            const int i = m >> 4, h = m & 15;
            float vals[8];
            if (kc < 32) {
                const int dr = kc >> 4, ri = (kc >> 3) & 1, p0 = (kc & 7) * 8;
                const int ldg = (L * 2 + dr) * 16 + g;
                const int e = dr == 0 ? (i + 1) : (32 - i);
                const float2* pw = (const float2*)(ws + OFF_POWA) + ((size_t)ldg * 33 + e) * 64 + p0;
                const float* cre = p.in[I_CRE] + ((size_t)ldg * 16 + h) * 64 + p0;
                const float* cim = p.in[I_CIM] + ((size_t)ldg * 16 + h) * 64 + p0;
#pragma unroll
                for (int q = 0; q < 8; ++q) {
                    float2 a = pw[q]; float cr = cre[q], ci = cim[q];
                    float wr = cr * a.x - ci * a.y, wi = cr * a.y + ci * a.x;
                    vals[q] = ri == 0 ? wr : -wi;
                }
            } else {
                const int kk = (kc - 32) * 8, j = kk >> 4, h0 = kk & 15;
                const float* kf = (const float*)(ws + OFF_KTAU) + (size_t)((L * 2 + 0) * 16 + g) * 32 * 256;
                const float* kb = (const float*)(ws + OFF_KTAU) + (size_t)((L * 2 + 1) * 16 + g) * 32 * 256;
#pragma unroll
                for (int q = 0; q < 8; ++q) {
                    float v = 0.f;
                    if (j <= i) v += kf[((i - j) * 16 + h) * 16 + h0 + q];
                    if (j >= i) v += kb[((j - i) * 16 + h) * 16 + h0 + q];
                    vals[q] = v;
                }
            }
            bf16_t* dst = (bf16_t*)(ws + OFF_WCOMB) + ((size_t)g * 512 + m) * KV + kc * 8;
            *(uint4*)dst = make_uint4(pack2(vals[0], vals[1]), pack2(vals[2], vals[3]), pack2(vals[4], vals[5]), pack2(vals[6], vals[7]));
        } else {
            const int cid = (it - N_G - N_WC) * NTHREADS + TIDX;
            const int kc = cid & 63, m = (cid >> 6) & 255, g = cid >> 14;
            const int dr = m >> 7, ri = (m >> 6) & 1, pp = m & 63;
            const int j = kc >> 1, h0 = (kc & 1) * 8;
            const int ldg = (L * 2 + dr) * 16 + g;
            const int e = dr == 0 ? (31 - j) : j;
            const float2 a = ((const float2*)(ws + OFF_POWA))[((size_t)ldg * 33 + e) * 64 + pp];
            const float2* bb = (const float2*)(ws + OFF_BBAR) + ((size_t)ldg * 64 + pp) * 16 + h0;
            float vals[8];
#pragma unroll
            for (int q = 0; q < 8; ++q) { float2 b = bb[q]; vals[q] = ri == 0 ? (a.x * b.x - a.y * b.y) : (a.x * b.y + a.y * b.x); }
            bf16_t* dst = (bf16_t*)(ws + OFF_WST) + ((size_t)g * 256 + m) * 512 + kc * 8;
            *(uint4*)dst = make_uint4(pack2(vals[0], vals[1]), pack2(vals[2], vals[3]), pack2(vals[4], vals[5]), pack2(vals[6], vals[7]));
        }
    }
}

struct AttnStep { bf16x8 kf[4][2]; };

__device__ __forceinline__ void attn_mfma_item(const Params& p, int L, int item, const float* rpb_lds) {
    const int lane = TIDX & 63, lr = lane & 15, g = lane >> 4;
    item = __builtin_amdgcn_readfirstlane(item);
    const bf16_t* xin = (const bf16_t*)(p.ws + OFF_XIN);
    bf16_t* ymix = (bf16_t*)(p.ws + OFF_YMIX);
    int b, h, r = 0, qt0 = 0, qbase;
    const bool lat = item < 4096;
    if (lat) { const int qp = item & 1; h = (item >> 1) & 3; r = (item >> 3) & 63; b = item >> 9; qt0 = 2 * qp; qbase = b * 4096 + r * 64 + qt0 * 16; }
    else { const int q = item - 4096; h = (q >> 3) & 3; b = q >> 5; qbase = T + b * 256 + (q & 7) * 32; }
    const int nsteps = lat ? 12 : 4;
    bf16x8 qf[2][2];
#pragma unroll
    for (int tq = 0; tq < 2; ++tq)
#pragma unroll
        for (int ks = 0; ks < 2; ++ks) qf[tq][ks] = *(const bf16x8*)(xin + (size_t)(qbase + tq * 16 + lr) * 2048 + h * 64 + ks * 32 + g * 8);
    const bf16_t* kctx = xin + (size_t)(T + b * 256) * 2048 + 256 + h * 64;
    const bf16_t* klat = xin + (size_t)(b * 4096) * 2048 + 256 + h * 64;
    const bf16_t* vtc = (const bf16_t*)(p.ws + OFF_VTC) + (size_t)((b * 4 + h) * 64) * 256;
    const bf16_t* vtl = (const bf16_t*)(p.ws + OFF_VT) + (size_t)((b * 4 + h) * 64) * 4096;
    const int rs = min(max(r - 4, 0), 56);
    const float* rpbh = rpb_lds + h * 465;
    f32x4 o[2][4];
    float mrun[2], lsum[2];
#pragma unroll
    for (int tq = 0; tq < 2; ++tq) {
        mrun[tq] = -3.0e38f; lsum[tq] = 0.f;
#pragma unroll
        for (int dt = 0; dt < 4; ++dt) o[tq][dt] = f32x4{0.f, 0.f, 0.f, 0.f};
    }
    const unsigned koff = (unsigned)(lr * 4096 + g * 16);
    const unsigned voffc = (unsigned)(lr * 512 + g * 8), voffl = (unsigned)(lr * 8192 + g * 8);
    uint2 vf[2][4][2];
    auto load_k = [&](int s, AttnStep& st) {
        const unsigned char* kb = (s < 4) ? (const unsigned char*)(kctx + (size_t)(s * 64) * 2048) : (const unsigned char*)(klat + (size_t)((rs + s - 4) * 64) * 2048);
#pragma unroll
        for (int kt = 0; kt < 4; ++kt)
#pragma unroll
            for (int ks = 0; ks < 2; ++ks) st.kf[kt][ks] = *(const bf16x8*)(kb + kt * 65536 + ks * 64 + koff);
    };
    auto load_v = [&](int s) {
        if (s < 4) {
            const unsigned char* vb = (const unsigned char*)(vtc + s * 64);
#pragma unroll
            for (int u = 0; u < 2; ++u)
#pragma unroll
                for (int dt = 0; dt < 4; ++dt) { vf[u][dt][0] = *(const uint2*)(vb + dt * 8192 + u * 64 + voffc); vf[u][dt][1] = *(const uint2*)(vb + dt * 8192 + u * 64 + voffc + 32); }
        } else {
            const unsigned char* vb = (const unsigned char*)(vtl + (rs + s - 4) * 64);
#pragma unroll
            for (int u = 0; u < 2; ++u)
#pragma unroll
                for (int dt = 0; dt < 4; ++dt) { vf[u][dt][0] = *(const uint2*)(vb + dt * 131072 + u * 64 + voffl); vf[u][dt][1] = *(const uint2*)(vb + dt * 131072 + u * 64 + voffl + 32); }
        }
    };
    auto compute_step = [&](int s, const AttnStep& st) {
#pragma unroll
        for (int u = 0; u < 2; ++u)
#pragma unroll
            for (int tq = 0; tq < 2; ++tq) {
                const int qt = qt0 + tq;
                if (s >= 4 && ((qt == 0 && u == 1) || (qt == 3 && u == 0))) continue;
                f32x4 sa[2];
#pragma unroll
                for (int t = 0; t < 2; ++t) {
                    sa[t] = f32x4{0.f, 0.f, 0.f, 0.f};
#pragma unroll
                    for (int ks = 0; ks < 2; ++ks) sa[t] = __builtin_amdgcn_mfma_f32_16x16x32_bf16(st.kf[2 * u + t][ks], qf[tq][ks], sa[t], 0, 0, 0);
                }
                float sc[8];
#pragma unroll
                for (int t = 0; t < 2; ++t)
#pragma unroll
                    for (int j = 0; j < 4; ++j) sc[t * 4 + j] = sa[t][j] * 0.125f;
                if (s >= 4) {
                    const int cq = qt * 16 + lr, cs = min(max(cq - 8, 0), 48);
                    const float* rp = rpbh + (rs + s - 4 - r + 7) * 31 + 15 - cq;
#pragma unroll
                    for (int t = 0; t < 2; ++t)
#pragma unroll
                        for (int j = 0; j < 4; ++j) {
                            const int kc = u * 32 + t * 16 + 4 * g + j;
                            const bool valid = (unsigned)(kc - cs) < 16u;
                            const float bias = rp[min(max(kc, cq - 15), cq + 15)];
                            sc[t * 4 + j] = valid ? (sc[t * 4 + j] + bias) : -1.0e30f;
                        }
                }
                float bm = fmaxf(fmaxf(fmaxf(sc[0], sc[1]), fmaxf(sc[2], sc[3])), fmaxf(fmaxf(sc[4], sc[5]), fmaxf(sc[6], sc[7])));
                bm = max16(bm); bm = max32(bm);
                const float mn = fmaxf(mrun[tq], bm);
                const float corr = __expf(mrun[tq] - mn);
                mrun[tq] = mn; lsum[tq] *= corr;
#pragma unroll
                for (int dt = 0; dt < 4; ++dt) { o[tq][dt][0] *= corr; o[tq][dt][1] *= corr; o[tq][dt][2] *= corr; o[tq][dt][3] *= corr; }
                float pr[8];
#pragma unroll
                for (int i = 0; i < 8; ++i) { pr[i] = __expf(sc[i] - mn); lsum[tq] += pr[i]; }
                const uint4 pbu = make_uint4(pack2(pr[0], pr[1]), pack2(pr[2], pr[3]), pack2(pr[4], pr[5]), pack2(pr[6], pr[7]));
                const bf16x8 pb = __builtin_bit_cast(bf16x8, pbu);
#pragma unroll
                for (int dt = 0; dt < 4; ++dt) {
                    const uint4 vu = make_uint4(vf[u][dt][0].x, vf[u][dt][0].y, vf[u][dt][1].x, vf[u][dt][1].y);
                    o[tq][dt] = __builtin_amdgcn_mfma_f32_16x16x32_bf16(__builtin_bit_cast(bf16x8, vu), pb, o[tq][dt], 0, 0, 0);
                }
            }
    };

    AttnStep sA, sB;
    load_k(0, sA); load_v(0);
#pragma unroll 1
    for (int s = 0; s < nsteps; s += 2) {
        load_k(s + 1, sB);
        compute_step(s, sA);
        load_v(s + 1);
        if (s + 2 < nsteps) load_k(s + 2, sA);
        compute_step(s + 1, sB);
        if (s + 2 < nsteps) load_v(s + 2);
    }
#pragma unroll
    for (int tq = 0; tq < 2; ++tq) {
        float ls = lsum[tq];
        ls = bfly16(ls, ls); ls = bfly32(ls, ls);
        const float inv = 1.0f / ls;
#pragma unroll
        for (int dt = 0; dt < 4; ++dt)
            *(uint2*)(ymix + (size_t)(qbase + tq * 16 + lr) * 1024 + h * 64 + dt * 16 + 4 * g) =
                make_uint2(pack2(o[tq][dt][0] * inv, o[tq][dt][1] * inv), pack2(o[tq][dt][2] * inv, o[tq][dt][3] * inv));
    }
}

__device__ void phase_C(const Params& p, int L, unsigned char* smem) {
    unsigned char* ws = p.ws;
    const int tid = TIDX, w = tid >> 6;
    const bf16_t* xin = (const bf16_t*)(ws + OFF_XIN);
    bf16_t* ymix = (bf16_t*)(ws + OFF_YMIX);
    const int n_attn_w = (L == 0) ? 4096 + 256 : 4096;
    float* rpb_lds = (float*)(smem + 70016);
    for (int i = tid; i < 4 * 465; i += NTHREADS) rpb_lds[i] = p.in[I_RPB][(size_t)L * 4 * 465 + i];
    __syncthreads();
    const int N_ATT = (n_attn_w + 7) / 8;
    const int N_F1 = 1024 + ((L == 0) ? 64 : 0);
    const int N_CONV = TT * 32 / NTHREADS;
    const int N_S1 = 288;
    const int O_F1 = N_ATT, O_CONV = O_F1 + N_F1, O_S1 = O_CONV + N_CONV, N_ALL = O_S1 + N_S1;
    const int grid = (int)gridDim.x, att_full = N_ATT / grid, att_rem = N_ATT % grid;
    constexpr int C_SKIP = 5;
    const int n_light = N_ALL - N_ATT;
    const int n_early = (att_rem > 0) ? min(C_SKIP * (grid - att_rem), n_light) : 0;
    const int my_att = att_full + ((BIDX < att_rem) ? 1 : 0);
    const int my_early = (att_rem > 0 && BIDX >= att_rem) ? C_SKIP : 0;
    for (int k = 0; ; ++k) {
        int it;
        if (k < my_att) it = BIDX + k * grid;
        else {
            const int kl = k - my_att;
            if (kl < my_early) {
                const int j = kl * (grid - att_rem) + (BIDX - att_rem);
                if (j >= n_early) continue;
                it = N_ATT + j;
            } else {
                const int j = n_early + (kl - my_early) * grid + BIDX;
                if (j >= n_light) break;
                it = N_ATT + j;
            }
        }
        if (it < O_F1) {
            const int item = it * 8 + w;
            if (item < n_attn_w) attn_mfma_item(p, L, item, rpb_lds);
        } else if (it < O_CONV) {
            int idx = it - O_F1;
            const bf16_t* dd = (const bf16_t*)(ws + OFF_DFTD);
            if (idx < 1024) {
                const int b = idx >> 7, h = (idx >> 5) & 3, nt = idx & 31;
                bf16_t* zt = (bf16_t*)(ws + OFF_ZT);
                gemm128<3, 1>([&](int r) { return dd + r * 64; },
                               [&](int r) { const int n = nt * 128 + r; return xin + (size_t)(b * 4096 + 64 * (n & 63) + (n >> 6)) * 2048 + 1536 + h * 64; }, 64,
                               [](int, int, f32x4) {}, smem);
                {
                    const float* tc = (const float*)smem;
                    const int m = tid >> 2, c0 = (tid & 3) * 32, nn0 = nt * 128 + c0;
                    bf16_t* dst = zt + (((size_t)(b * 256 + h * 64 + (m & 63)) * 64 + (nn0 >> 6)) * 2 + (m >> 6)) * 64 + (nn0 & 63);
#pragma unroll
                    for (int q = 0; q < 4; ++q) {
                        const float4 f0 = *(const float4*)(tc + m * 132 + c0 + 8 * q), f1 = *(const float4*)(tc + m * 132 + c0 + 8 * q + 4);
                        *(uint4*)(dst + 8 * q) = make_uint4(pack2(f0.x, f0.y), pack2(f0.z, f0.w), pack2(f1.x, f1.y), pack2(f1.z, f1.w));
                    }
                }
            } else {
                idx -= 1024;
                const int b = idx >> 3, h = (idx >> 1) & 3, nt = idx & 1;
                bf16_t* zt = (bf16_t*)(ws + OFF_ZTC);
                gemm128<0, 1>([&](int r) { return dd + r * 64; },
                               [&](int r) { return xin + (size_t)(T + b * 256 + nt * 128 + r) * 2048 + 1536 + h * 64; }, 64,
                               [&](int m, int n, f32x4 vv) { const float v = vv[0]; zt[((size_t)(b * 256 + h * 64 + (m & 63)) * 2 + (m >> 6)) * 256 + nt * 128 + n] = f2bf(v); }, smem);
            }
        } else if (it < O_S1) {
            const int gid = (it - O_CONV) * NTHREADS + tid;
            const int tt = gid >> 5, ch0 = (gid & 31) * 8;
            bool first, last;
            if (tt < T) { int l = tt & 4095; first = l == 0; last = l == 4095; } else { int j = (tt - T) & 255; first = j == 0; last = j == 255; }
            const bf16_t* row = xin + (size_t)tt * 2048;
            const uint4 cb = *(const uint4*)(row + 768 + ch0), cc = *(const uint4*)(row + 1024 + ch0), cx = *(const uint4*)(row + 1280 + ch0);
            uint4 ccp = make_uint4(0, 0, 0, 0), cxp = ccp, ccn = ccp, cxn = ccp;
            if (!first) { ccp = *(const uint4*)(row - 2048 + 1024 + ch0); cxp = *(const uint4*)(row - 2048 + 1280 + ch0); }
            if (!last) { ccn = *(const uint4*)(row + 2048 + 1024 + ch0); cxn = *(const uint4*)(row + 2048 + 1280 + ch0); }
            const float* cw = p.in[I_CONVW] + (size_t)L * 3 * 256 + ch0;
            const unsigned cbv[4] = {cb.x, cb.y, cb.z, cb.w}, ccv[4] = {cc.x, cc.y, cc.z, cc.w}, cxv[4] = {cx.x, cx.y, cx.z, cx.w};
            const unsigned cpv[4] = {ccp.x, ccp.y, ccp.z, ccp.w}, xpv[4] = {cxp.x, cxp.y, cxp.z, cxp.w};
            const unsigned cnv[4] = {ccn.x, ccn.y, ccn.z, ccn.w}, xnv[4] = {cxn.x, cxn.y, cxn.z, cxn.w};
            unsigned o[4];
            const float4 q00 = *(const float4*)(cw), q01 = *(const float4*)(cw + 4), q10 = *(const float4*)(cw + 256), q11 = *(const float4*)(cw + 260);
            const float4 q20 = *(const float4*)(cw + 512), q21 = *(const float4*)(cw + 516);
            const float wt0[8] = {q00.x, q00.y, q00.z, q00.w, q01.x, q01.y, q01.z, q01.w}, wt1[8] = {q10.x, q10.y, q10.z, q10.w, q11.x, q11.y, q11.z, q11.w};
            const float wt2[8] = {q20.x, q20.y, q20.z, q20.w, q21.x, q21.y, q21.z, q21.w};
#pragma unroll
            for (int e = 0; e < 4; ++e) {
                float w0a = wt0[2 * e], w0b = wt0[2 * e + 1], w1a = wt1[2 * e], w1b = wt1[2 * e + 1], w2a = wt2[2 * e], w2b = wt2[2 * e + 1];
                float za = w0a * bflo(cpv[e]) * bflo(xpv[e]) + w1a * bflo(ccv[e]) * bflo(cxv[e]) + w2a * bflo(cnv[e]) * bflo(xnv[e]);
                float zb = w0b * bfhi(cpv[e]) * bfhi(xpv[e]) + w1b * bfhi(ccv[e]) * bfhi(cxv[e]) + w2b * bfhi(cnv[e]) * bfhi(xnv[e]);
                o[e] = pack2(bflo(cbv[e]) * za, bfhi(cbv[e]) * zb);
            }
            *(uint4*)(ymix + (size_t)tt * 1024 + 256 + ch0) = make_uint4(o[0], o[1], o[2], o[3]);
        } else {
            const int idx = it - O_S1;
            const int g = idx / 18, rem = idx % 18, mt = rem / 9, nt = rem % 9;
            const bf16_t* wst = (const bf16_t*)(ws + OFF_WST) + (size_t)g * 256 * 512;
            const bf16_t* vg = (const bf16_t*)(ws + OFF_VG) + (size_t)g * NCHP * KV;
            float* sc = (float*)(ws + OFF_SC) + (size_t)g * NCH * 256;
            gemm128<3, 1>([&](int r) { return wst + (size_t)(mt * 128 + r) * 512; },
                           [&](int r) { return vg + (size_t)(nt * 128 + r) * KV + 256; }, 512,
                           [](int, int, f32x4) {}, smem);
            {
                const float* tc = (const float*)smem;
                const int n = tid >> 2, m0 = (tid & 3) * 32, nn = nt * 128 + n;
                if (nn < NCH) {
                    float4* dst = (float4*)(sc + (size_t)nn * 256 + mt * 128 + m0);
#pragma unroll
                    for (int q = 0; q < 8; ++q)
                        dst[q] = make_float4(tc[(m0 + 4 * q) * 132 + n], tc[(m0 + 4 * q + 1) * 132 + n], tc[(m0 + 4 * q + 2) * 132 + n], tc[(m0 + 4 * q + 3) * 132 + n]);
                }
            }
        }
    }
}

__device__ void s5_scan(const Params& p, int L) {
    unsigned char* ws = p.ws;
    for (int it = BIDX; it < 32; it += gridDim.x) {
        const int gid = it * NTHREADS + TIDX;
        const int b = gid >> 11, g = (gid >> 7) & 15, dr = (gid >> 6) & 1, pp = gid & 63;
        const float2 a32 = ((const float2*)(ws + OFF_POWA))[((size_t)((L * 2 + dr) * 16 + g) * 33 + 32) * 64 + pp];
        bf16_t* vg = (bf16_t*)(ws + OFF_VG) + (size_t)g * NCHP * KV + dr * 128 + pp;
        const float* sc = (const float*)(ws + OFF_SC) + (size_t)g * NCH * 256 + dr * 128 + pp;
        float hr = 0.f, hi = 0.f;
        for (int s0 = 0; s0 < NCHB; s0 += 8) {
            float sr[8], si[8]; int nn[8];
#pragma unroll
            for (int q = 0; q < 8; ++q) {
                const int s = s0 + q;
                const int cidx = dr == 0 ? s : (s < 8 ? 7 - s : NCHB - 1 - (s - 8));
                nn[q] = b * NCHB + cidx;
                sr[q] = sc[(size_t)nn[q] * 256]; si[q] = sc[(size_t)nn[q] * 256 + 64];
            }
#pragma unroll
            for (int q = 0; q < 8; ++q) {
                vg[(size_t)nn[q] * KV] = f2bf(hr); vg[(size_t)nn[q] * KV + 64] = f2bf(hi);
                const float nr = a32.x * hr - a32.y * hi + sr[q], ni = a32.x * hi + a32.y * hr + si[q];
                hr = nr; hi = ni;
            }
        }
    }
}

__device__ void phase_D(const Params& p, int L, unsigned char* smem) {
    unsigned char* ws = p.ws;
    bf16_t* ymix = (bf16_t*)(ws + OFF_YMIX);
    s5_scan(p, L);
    const int N_F2 = 1024, N_F2C = (L == 0) ? 32 : 0, N_S2 = 0;
    const int O_F2C = N_F2, O_S2 = O_F2C + N_F2C, N_ALL = O_S2 + N_S2;
    for (int it = BIDX; it < N_ALL; it += gridDim.x) {
        if (it < O_F2C) {
            const int b = it >> 7, nt = it & 127;
            const bf16_t* mab = (const bf16_t*)(ws + OFF_MATAB);
            const bf16_t* zt = (const bf16_t*)(ws + OFF_ZT) + ((size_t)b * 16384 + nt * 128) * 128;
            const float2* tw = (const float2*)(ws + OFF_TW);
            bf16_t* yp = (bf16_t*)(ws + OFF_YP);
            gemm128<3, 1>([&](int r) { return mab + r * 128; },
                       [&](int r) { return zt + (size_t)r * 128; }, 128,
                       [](int, int, f32x4) {}, smem);
            {
                const float* tc = (const float*)smem;
                const int grp = TIDX >> 2, k1 = grp >> 1, chl = grp & 1, l0 = (TIDX & 3) * 16;
                const float* rr = tc + (2 * k1) * 132 + chl * 64 + l0;
                const float4* twp = (const float4*)(tw + k1 * 64 + l0);
                bf16_t* dst = yp + (((size_t)(b * 64 + k1) * 256 + (2 * nt + chl)) * 2) * 64 + l0;
                unsigned ore[8], oim[8];
#pragma unroll
                for (int q = 0; q < 4; ++q) {
                    const float4 yr = *(const float4*)(rr + 4 * q), yi = *(const float4*)(rr + 132 + 4 * q);
                    const float4 ta = twp[2 * q], tb = twp[2 * q + 1];
                    ore[2 * q] = pack2(yr.x * ta.x + yi.x * ta.y, yr.y * ta.z + yi.y * ta.w);
                    ore[2 * q + 1] = pack2(yr.z * tb.x + yi.z * tb.y, yr.w * tb.z + yi.w * tb.w);
                    oim[2 * q] = pack2(yi.x * ta.x - yr.x * ta.y, yi.y * ta.z - yr.y * ta.w);
                    oim[2 * q + 1] = pack2(yi.z * tb.x - yr.z * tb.y, yi.w * tb.z - yr.w * tb.w);
                }
                *(uint4*)(dst) = make_uint4(ore[0], ore[1], ore[2], ore[3]); *(uint4*)(dst + 8) = make_uint4(ore[4], ore[5], ore[6], ore[7]);
                *(uint4*)(dst + 64) = make_uint4(oim[0], oim[1], oim[2], oim[3]); *(uint4*)(dst + 72) = make_uint4(oim[4], oim[5], oim[6], oim[7]);
            }
        } else if (it < O_S2) {
            const int idx = it - O_F2C;
            const int b = idx >> 2, mt = (idx >> 1) & 1, nt = idx & 1;
            const bf16_t* dc = (const bf16_t*)(ws + OFF_DFTC);
            const bf16_t* zt = (const bf16_t*)(ws + OFF_ZTC);
            gemm128<0, 1>([&](int r) { return dc + (size_t)(mt * 128 + r) * 512; },
                           [&](int r) { return zt + (size_t)(b * 256 + nt * 128 + r) * 512; }, 512,
                           [&](int m, int n, f32x4 vv) { const float v = vv[0]; ymix[(size_t)(T + b * 256 + mt * 128 + m) * 1024 + 512 + nt * 128 + n] = f2bf(v); }, smem);
        }
    }
}

__device__ __forceinline__ int uperm(int e) { return ((((e >> 7) + e) & 7) << 11) | ((e >> 7) << 4) | ((e >> 3) & 15); }
__device__ __forceinline__ void convert_peer_rows(const Params& p, int L, int item) {
    unsigned char* ws = p.ws;
    const int lane = TIDX & 63, w = TIDX >> 6;
    const int rid = item * 8 + w;
    const int which = rid >> 14, row = rid & 16383;
    const float* src = p.in[which ? I_PV : I_PU] + ((size_t)L * 16384 + row) * 1024 + lane * 16;
    float4 v[4]; float mx = 0.f;
#pragma unroll
    for (int i = 0; i < 4; ++i) {
        v[i] = *(const float4*)(src + i * 4);
        mx = fmaxf(mx, fmaxf(fmaxf(fabsf(v[i].x), fabsf(v[i].y)), fmaxf(fabsf(v[i].z), fabsf(v[i].w))));
    }
    mx = wave_max(mx);
    mx = fmaxf(mx, 1e-30f);
    const float sc = mx * (1.0f / 448.0f), inv = 448.0f / mx;
    int pk[4];
#pragma unroll
    for (int i = 0; i < 4; ++i) {
        int wd = 0;
        wd = __builtin_amdgcn_cvt_pk_fp8_f32(v[i].x * inv, v[i].y * inv, wd, false);
        wd = __builtin_amdgcn_cvt_pk_fp8_f32(v[i].z * inv, v[i].w * inv, wd, true);
        pk[i] = wd;
    }
    if (which) *(int4*)(ws + OFF_PEERV + (size_t)(lane >> 3) * (16384 * 128) + (size_t)row * 128 + (lane & 7) * 16) = make_int4(pk[0], pk[1], pk[2], pk[3]);
    else *(int4*)(ws + OFF_PEERU + (size_t)uperm(row) * 1024 + lane * 16) = make_int4(pk[0], pk[1], pk[2], pk[3]);
    if (lane == 0) ((float*)(ws + (which ? OFF_PSCV : OFF_PSCU)))[row] = sc;
}

__device__ void phase_F(const Params& p, int L, unsigned char* smem);
__device__ void phase_E(const Params& p, int L, unsigned char* smem) {
    unsigned char* ws = p.ws;
    phase_F(p, L, smem);
    {
        const int grid = (int)gridDim.x, f_rem = 576 % grid;
        constexpr int E_SKIP = 5;
        const int n_early = (f_rem > 0) ? min(E_SKIP * (grid - f_rem), 4096) : 0;
        const int my_early = (f_rem > 0 && BIDX >= f_rem) ? E_SKIP : 0;
        for (int kl = 0; ; ++kl) {
            int j;
            if (kl < my_early) { j = kl * (grid - f_rem) + (BIDX - f_rem); if (j >= n_early) continue; }
            else { j = n_early + (kl - my_early) * grid + BIDX; if (j >= 4096) break; }
            convert_peer_rows(p, L, j);
        }
    }
    for (int idx = BIDX; idx < 1024; idx += gridDim.x) {
        const int b = idx >> 7, k1 = (idx >> 1) & 63, nt = idx & 1;
        const bf16_t* mad = (const bf16_t*)(ws + OFF_MATAD);
        const bf16_t* yp = (const bf16_t*)(ws + OFF_YP) + ((size_t)(b * 64 + k1) * 256 + nt * 128) * 128;
        bf16_t* ymix = (bf16_t*)(ws + OFF_YMIX);
        gemm128<3, 1>([&](int r) { return mad + r * 128; },
                   [&](int r) { return yp + (size_t)r * 128; }, 128,
                   [](int, int, f32x4) {}, smem);
        {
            const float* tc = (const float*)smem;
            const int m = TIDX >> 3, c0 = (TIDX & 7) * 16;
            bf16_t* dst = ymix + (size_t)(b * 4096 + k1 + 64 * m) * 1024 + 512 + nt * 128 + c0;
#pragma unroll
            for (int q = 0; q < 2; ++q) {
                const float4 f0 = *(const float4*)(tc + m * 132 + c0 + 8 * q), f1 = *(const float4*)(tc + m * 132 + c0 + 8 * q + 4);
                *(uint4*)(dst + 8 * q) = make_uint4(pack2(f0.x, f0.y), pack2(f0.z, f0.w), pack2(f1.x, f1.y), pack2(f1.z, f1.w));
            }
        }
    }
}

__device__ void phase_F(const Params& p, int L, unsigned char* smem) {
    unsigned char* ws = p.ws;
    bf16_t* gbuf = (bf16_t*)(ws + OFF_GBUF);
    const float* dsk = p.in[I_S5D] + L * 256;
    for (int it = BIDX; it < 576; it += gridDim.x) {
        const int g = it / 36, rem = it % 36, mt = rem >> 2, nt = rem & 3;
        const bf16_t* vg = (const bf16_t*)(ws + OFF_VG) + (size_t)g * NCHP * KV;
        const bf16_t* wc = (const bf16_t*)(ws + OFF_WCOMB) + (size_t)g * 512 * KV;
        gemm128<3, 1>([&](int r) { return vg + (size_t)(mt * 128 + r) * KV; },
                       [&](int r) { return wc + (size_t)(nt * 128 + r) * KV; }, KV,
                       [](int, int, f32x4) {}, smem);
        {
            const float* tc = (const float*)smem;
            const int m = TIDX >> 2, c0 = (TIDX & 3) * 32, nn = mt * 128 + m;
            if (nn < NCH) {
                const int b = nn / NCHB, cidx = nn % NCHB;
                const uint4* up = (const uint4*)(vg + (size_t)nn * KV + 256 + nt * 128 + c0);
                const float4* dp = (const float4*)(dsk + g * 16);
                const float4 d0 = dp[0], d1 = dp[1], d2 = dp[2], d3 = dp[3];
                const float dk[16] = {d0.x, d0.y, d0.z, d0.w, d1.x, d1.y, d1.z, d1.w, d2.x, d2.y, d2.z, d2.w, d3.x, d3.y, d3.z, d3.w};
#pragma unroll
                for (int s = 0; s < 2; ++s) {
                    const int i = (nt * 128 + c0) / 16 + s;
                    const int tt = cidx < 8 ? (T + b * 256 + cidx * 32 + i) : (b * 4096 + (cidx - 8) * 32 + i);
                    const uint4 ua = up[2 * s], ub = up[2 * s + 1];
                    const unsigned uw[8] = {ua.x, ua.y, ua.z, ua.w, ub.x, ub.y, ub.z, ub.w};
                    unsigned o[8];
#pragma unroll
                    for (int q = 0; q < 4; ++q) {
                        const float4 v = *(const float4*)(tc + m * 132 + c0 + 16 * s + 4 * q);
                        const float y0 = v.x + dk[4 * q] * bflo(uw[2 * q]), y1 = v.y + dk[4 * q + 1] * bfhi(uw[2 * q]);
                        const float y2 = v.z + dk[4 * q + 2] * bflo(uw[2 * q + 1]), y3 = v.w + dk[4 * q + 3] * bfhi(uw[2 * q + 1]);
                        o[2 * q] = pack2(gelu_tanh(y0), gelu_tanh(y1)); o[2 * q + 1] = pack2(gelu_tanh(y2), gelu_tanh(y3));
                    }
                    uint4* dst = (uint4*)(gbuf + (size_t)tt * 256 + g * 16);
                    dst[0] = make_uint4(o[0], o[1], o[2], o[3]); dst[1] = make_uint4(o[4], o[5], o[6], o[7]);
                }
            }
        }
    }
}

__device__ void phase_G(const Params& p, int L, unsigned char* smem) {
    unsigned char* ws = p.ws;
    const bf16_t* gbuf = (const bf16_t*)(ws + OFF_GBUF);
    const bf16_t* wg = (const bf16_t*)(ws + OFF_WGLUT + L * SZ_WGLUT);
    bf16_t* ymix = (bf16_t*)(ws + OFF_YMIX);
    for (int it = BIDX; it < (TT / 128) * 2; it += gridDim.x) {
        const int mt = it >> 1, nt = it & 1;
        gemm128<3, 1>([&](int r) { return gbuf + (size_t)(mt * 128 + r) * 256; },
                       [&](int r) { return wg + (size_t)(nt * 128 + r) * 256; }, 256,
                       [](int, int, f32x4) {}, smem);
        {
            const float* tc = (const float*)smem;
            const int m = TIDX >> 2, c0 = (TIDX & 3) * 32;
            const size_t tt = (size_t)mt * 128 + m; const int nn0 = nt * 128 + c0;
            const uint4* gp = (const uint4*)(gbuf + tt * 256 + nn0);
            uint4* dst = (uint4*)(ymix + tt * 1024 + 768 + nn0);
#pragma unroll
            for (int q = 0; q < 4; ++q) {
                const uint4 gw = gp[q];
                const float4 v0 = *(const float4*)(tc + m * 132 + c0 + 8 * q), v1 = *(const float4*)(tc + m * 132 + c0 + 8 * q + 4);
                dst[q] = make_uint4(pack2(bflo(gw.x) * sigmoidf_(v0.x), bfhi(gw.x) * sigmoidf_(v0.y)), pack2(bflo(gw.y) * sigmoidf_(v0.z), bfhi(gw.y) * sigmoidf_(v0.w)),
                                    pack2(bflo(gw.z) * sigmoidf_(v1.x), bfhi(gw.z) * sigmoidf_(v1.y)), pack2(bflo(gw.w) * sigmoidf_(v1.z), bfhi(gw.w) * sigmoidf_(v1.w)));
            }
        }
    }
}

__device__ void phase_H(const Params& p, int L) {
    const int lane = TIDX & 63, w = TIDX >> 6;
    const bf16_t* ymix = (const bf16_t*)(p.ws + OFF_YMIX);
    bf16_t* dst = (bf16_t*)(p.ws + OFF_ACT);
    const float* gg = p.in[I_GRPG] + (size_t)L * 1024 + lane * 16;
    float ggr[16];
    {
        const float4 h0 = *(const float4*)(gg), h1 = *(const float4*)(gg + 4), h2 = *(const float4*)(gg + 8), h3 = *(const float4*)(gg + 12);
        ggr[0] = h0.x; ggr[1] = h0.y; ggr[2] = h0.z; ggr[3] = h0.w; ggr[4] = h1.x; ggr[5] = h1.y; ggr[6] = h1.z; ggr[7] = h1.w;
        ggr[8] = h2.x; ggr[9] = h2.y; ggr[10] = h2.z; ggr[11] = h2.w; ggr[12] = h3.x; ggr[13] = h3.y; ggr[14] = h3.z; ggr[15] = h3.w;
    }
    for (int it = BIDX; it < TT / 8; it += gridDim.x) {
        const int tt = it * 8 + w;
        const uint4* src = (const uint4*)(ymix + (size_t)tt * 1024 + lane * 16);
        const uint4 a = src[0], b = src[1];
        const unsigned u[8] = {a.x, a.y, a.z, a.w, b.x, b.y, b.z, b.w};
        float v[16], ss = 0.f;
#pragma unroll
        for (int e = 0; e < 8; ++e) { v[2 * e] = bflo(u[e]); v[2 * e + 1] = bfhi(u[e]); ss += v[2 * e] * v[2 * e] + v[2 * e + 1] * v[2 * e + 1]; }
        ss += xor_swz<1>(ss); ss += xor_swz<2>(ss); ss += xor_swz<4>(ss); ss += xor_swz<8>(ss);
        const float r = rsqrtf(ss * (1.0f / 256.0f) + EPS);
        unsigned o[8];
#pragma unroll
        for (int e = 0; e < 8; ++e) o[e] = pack2(v[2 * e] * r * ggr[2 * e], v[2 * e + 1] * r * ggr[2 * e + 1]);
        uint4* d = (uint4*)(dst + (size_t)tt * 1024 + lane * 16);
        d[0] = make_uint4(o[0], o[1], o[2], o[3]); d[1] = make_uint4(o[4], o[5], o[6], o[7]);
    }
}

__device__ void phase_I(const Params& p, int L, unsigned char* smem) {
    unsigned char* ws = p.ws;
    const int mtok = (L == 0) ? TT : T;
    {
        PG8_LAS unsigned char* lds = (PG8_LAS unsigned char*)smem;
        pg8::Gemm g{(const bf16_t*)(ws + OFF_ACT), (const bf16_t*)(ws + OFF_WOUTT + L * SZ_WOUTT), T, 1024, 1024};
        pg8::StaticOrder s; s.init(T, 1024, (int)gridDim.x, BIDX);
        pg8::EpiRes e{(L == 0) ? p.in[I_X] : p.out, p.in[I_CTX], p.out, (float*)(ws + OFF_XCTX), (const float*)(ws + OFF_MOD) + (size_t)L * 9 * 6144 + 2048};
        pg8::gemm_phase(lds, g, s, e, nullptr);
        __syncthreads();
    }
    if (mtok > T) {
        const bf16_t* A = (const bf16_t*)(ws + OFF_ACT);
        const bf16_t* Bt = (const bf16_t*)(ws + OFF_WOUTT + L * SZ_WOUTT);
        const float* g1c = (const float*)(ws + OFF_MOD) + (size_t)L * 9 * 6144 + 2048 + (size_t)8 * 6144;
        float* xctx = (float*)(ws + OFF_XCTX);
        for (int it = BIDX; it < 128; it += gridDim.x) {
            const int mt = it >> 3, nt = it & 7;
            gemm128<0, 1>([&](int r) { return A + (size_t)(T + mt * 128 + r) * 1024; },
                       [&](int r) { return Bt + (size_t)(nt * 128 + r) * 1024; }, 1024,
                       [&](int m, int n, f32x4 vv) { const size_t o = (size_t)(mt * 128 + m) * 1024 + nt * 128 + n; xctx[o] = p.in[I_CTX][o] + g1c[nt * 128 + n] * vv[0]; }, smem);
        }
    }
}

__device__ void phase_K(const Params& p, int L, unsigned char* smem) {
    unsigned char* ws = p.ws;
    const int mtok = (L == 0) ? TT : T;
    PG8_LAS unsigned char* lds = (PG8_LAS unsigned char*)smem;
    pg8::Gemm g{(const bf16_t*)(ws + OFF_ACT), (const bf16_t*)(ws + OFF_WQKT + L * SZ_WQKT), T, 2048, 1024};
    pg8::StaticOrder s; s.init(T, 2048, (int)gridDim.x, BIDX);
    pg8::EpiBf16<0> e{(bf16_t*)(ws + OFF_SCORES), 2048, nullptr, 0, 0};
    pg8::gemm_phase(lds, g, s, e, nullptr);
    __syncthreads();
    if (mtok > T) {
        const bf16_t* A = (const bf16_t*)(ws + OFF_ACT);
        const bf16_t* Bt = (const bf16_t*)(ws + OFF_WQKT + L * SZ_WQKT);
        bf16_t* sc = (bf16_t*)(ws + OFF_SCORES);
        for (int it = BIDX; it < 256; it += gridDim.x) {
            const int mt = 256 + (it >> 4), nt = it & 15;
            gemm128<0, 1>([&](int r) { return A + (size_t)(mt * 128 + r) * 1024; },
                       [&](int r) { return Bt + (size_t)(nt * 128 + r) * 1024; }, 1024,
                       [&](int m, int n, f32x4 vv) { sc[(size_t)(mt * 128 + m) * 2048 + nt * 128 + n] = f2bf(vv[0]); }, smem);
        }
    }
}

__device__ __forceinline__ void bitonic_sort16_desc(int (&a)[16]) {
#pragma unroll
    for (int k = 2; k <= 16; k <<= 1)
#pragma unroll
        for (int j = k >> 1; j > 0; j >>= 1)
#pragma unroll
            for (int i = 0; i < 16; ++i) {
                const int l = i ^ j;
                if (l > i) {
                    const int hi = max(a[i], a[l]), lo = min(a[i], a[l]);
                    if ((i & k) == 0) { a[i] = hi; a[l] = lo; } else { a[i] = lo; a[l] = hi; }
                }
            }
}
__device__ __forceinline__ void oem_sort16_desc(int (&a)[16]) {
#define CE_(i, j) { const int hi_ = max(a[i], a[j]), lo_ = min(a[i], a[j]); a[i] = hi_; a[j] = lo_; }
    CE_(0, 1) CE_(2, 3) CE_(0, 2) CE_(1, 3) CE_(1, 2) CE_(4, 5) CE_(6, 7) CE_(4, 6)
    CE_(5, 7) CE_(5, 6) CE_(0, 4) CE_(2, 6) CE_(2, 4) CE_(1, 5) CE_(3, 7) CE_(3, 5)
    CE_(1, 2) CE_(3, 4) CE_(5, 6) CE_(8, 9) CE_(10, 11) CE_(8, 10) CE_(9, 11) CE_(9, 10)
    CE_(12, 13) CE_(14, 15) CE_(12, 14) CE_(13, 15) CE_(13, 14) CE_(8, 12) CE_(10, 14) CE_(10, 12)
    CE_(9, 13) CE_(11, 15) CE_(11, 13) CE_(9, 10) CE_(11, 12) CE_(13, 14) CE_(0, 8) CE_(4, 12)
    CE_(4, 8) CE_(2, 10) CE_(6, 14) CE_(6, 10) CE_(2, 4) CE_(6, 8) CE_(10, 12) CE_(1, 9)
    CE_(5, 13) CE_(5, 9) CE_(3, 11) CE_(7, 15) CE_(7, 11) CE_(3, 5) CE_(7, 9) CE_(11, 13)
    CE_(1, 2) CE_(3, 4) CE_(5, 6) CE_(7, 8) CE_(9, 10) CE_(11, 12) CE_(13, 14)
#undef CE_
}
__device__ __forceinline__ void merge_top16(int (&top)[16], const int (&g)[16]) {
#pragma unroll
    for (int i = 0; i < 16; ++i) top[i] = max(top[i], g[15 - i]);
#pragma unroll
    for (int j = 8; j > 0; j >>= 1)
#pragma unroll
        for (int i = 0; i < 16; ++i) {
            const int l = i ^ j;
            if (l > i) { const int hi = max(top[i], top[l]), lo = min(top[i], top[l]); top[i] = hi; top[l] = lo; }
        }
}
__device__ __forceinline__ void top16_of_128(const LAS_ unsigned char* sc, int (&top)[16]) {
#pragma unroll 1
    for (int c = 0; c < 8; ++c) {
        const u32x4_t v0 = *(const LAS_ u32x4_t*)(sc + c * 32), v1 = *(const LAS_ u32x4_t*)(sc + c * 32 + 16);
        const unsigned wv[8] = {v0[0], v0[1], v0[2], v0[3], v1[0], v1[1], v1[2], v1[3]};
        int g[16];
#pragma unroll
        for (int e = 0; e < 8; ++e) {
            const int b0 = (int)(wv[e] << 16), b1 = (int)(wv[e] & 0xffff0000u);
            g[2 * e] = ((b0 ^ ((b0 >> 31) & 0x7FFFFFFF)) & ~0x7F) | (c * 16 + 2 * e);
            g[2 * e + 1] = ((b1 ^ ((b1 >> 31) & 0x7FFFFFFF)) & ~0x7F) | (c * 16 + 2 * e + 1);
        }
        oem_sort16_desc(g);
        if (c == 0) {
#pragma unroll
            for (int i = 0; i < 16; ++i) top[i] = g[i];
        } else merge_top16(top, g);
    }
}
__device__ void phase_L(const Params& p, int L, unsigned char* smem) {
    const int mtok = (L == 0) ? TT : T;
    const bf16_t* scores = (const bf16_t*)(p.ws + OFF_SCORES);
    int* eidx = (int*)(p.ws + OFF_EIDX);
    float* gate = (float*)(p.ws + OFF_GATE);
    float* sub = (float*)(p.ws + OFF_SU);
    const float* scu = (const float*)(p.ws + OFF_PSCU);
    const float* scv = (const float*)(p.ws + OFF_PSCV);
    const int lane = TIDX & 63, w = TIDX >> 6;
    LAS_ unsigned char* stg = (LAS_ unsigned char*)smem + w * 17408;
    LAS_ int* lst = (LAS_ int*)(stg + lane * 272);
    const int nit = mtok * 8 / NTHREADS;
    uint4 ld[16];
    auto issue_loads = [&](int it_, int z) {
        const size_t gb = (size_t)it_ * NTHREADS + w * 64;
#pragma unroll
        for (int i = 0; i < 16; ++i) ld[i] = *(const uint4*)(scores + (gb + 4 * i + (lane >> 4)) * 256 + z * 128 + (lane & 15) * 8);
    };
    auto stage = [&]() {
#pragma unroll
        for (int i = 0; i < 16; ++i) *(LAS_ u32x4_t*)(stg + (4 * i + (lane >> 4)) * 272 + (lane & 15) * 16) = u32x4_t{ld[i].x, ld[i].y, ld[i].z, ld[i].w};
    };
    if (BIDX < nit) issue_loads(BIDX, 0);
    for (int it = BIDX; it < nit; it += gridDim.x) {
        const int gid = it * NTHREADS + TIDX;
        const int tt = gid >> 3, hd = gid & 7;
        int t1[16], t2[16];
        asm volatile("s_waitcnt lgkmcnt(0)" ::: "memory");
        stage();
        issue_loads(it, 1);
        asm volatile("s_waitcnt lgkmcnt(0)" ::: "memory");
        top16_of_128(stg + lane * 272, t1);
        asm volatile("s_waitcnt lgkmcnt(0)" ::: "memory");
        stage();
        if (it + (int)gridDim.x < nit) issue_loads(it + (int)gridDim.x, 0);
        asm volatile("s_waitcnt lgkmcnt(0)" ::: "memory");
        top16_of_128(stg + lane * 272, t2);
        asm volatile("s_waitcnt lgkmcnt(0)" ::: "memory");
        float s1[16], s2[16];
#pragma unroll
        for (int j = 0; j < 16; ++j) { s1[j] = unsortable(t1[j] & ~0x7F); s2[j] = unsortable(t2[j] & ~0x7F); lst[j] = t1[j] & 0x7F; lst[16 + j] = t2[j] & 0x7F; }
        int top[16];
        {
            int g[16];
            g[0] = (sortable(s1[0] + s2[0]) & ~0xFF) | 0;
            g[1] = (sortable(s1[0] + s2[1]) & ~0xFF) | 1;
            g[2] = (sortable(s1[0] + s2[2]) & ~0xFF) | 2;
            g[3] = (sortable(s1[0] + s2[3]) & ~0xFF) | 3;
            g[4] = (sortable(s1[0] + s2[4]) & ~0xFF) | 4;
            g[5] = (sortable(s1[0] + s2[5]) & ~0xFF) | 5;
            g[6] = (sortable(s1[0] + s2[6]) & ~0xFF) | 6;
            g[7] = (sortable(s1[0] + s2[7]) & ~0xFF) | 7;
            g[8] = (sortable(s1[0] + s2[8]) & ~0xFF) | 8;
            g[9] = (sortable(s1[0] + s2[9]) & ~0xFF) | 9;
            g[10] = (sortable(s1[0] + s2[10]) & ~0xFF) | 10;
            g[11] = (sortable(s1[0] + s2[11]) & ~0xFF) | 11;
            g[12] = (sortable(s1[0] + s2[12]) & ~0xFF) | 12;
            g[13] = (sortable(s1[0] + s2[13]) & ~0xFF) | 13;
            g[14] = (sortable(s1[0] + s2[14]) & ~0xFF) | 14;
            g[15] = (sortable(s1[0] + s2[15]) & ~0xFF) | 15;
            oem_sort16_desc(g);
#pragma unroll
            for (int q = 0; q < 16; ++q) top[q] = g[q];
        }
        {
            int g[16];
            g[0] = (sortable(s1[1] + s2[0]) & ~0xFF) | 16;
            g[1] = (sortable(s1[1] + s2[1]) & ~0xFF) | 17;
            g[2] = (sortable(s1[1] + s2[2]) & ~0xFF) | 18;
            g[3] = (sortable(s1[1] + s2[3]) & ~0xFF) | 19;
            g[4] = (sortable(s1[1] + s2[4]) & ~0xFF) | 20;
            g[5] = (sortable(s1[1] + s2[5]) & ~0xFF) | 21;
            g[6] = (sortable(s1[1] + s2[6]) & ~0xFF) | 22;
            g[7] = (sortable(s1[1] + s2[7]) & ~0xFF) | 23;
            g[8] = (sortable(s1[2] + s2[0]) & ~0xFF) | 32;
            g[9] = (sortable(s1[2] + s2[1]) & ~0xFF) | 33;
            g[10] = (sortable(s1[2] + s2[2]) & ~0xFF) | 34;
            g[11] = (sortable(s1[2] + s2[3]) & ~0xFF) | 35;
            g[12] = (sortable(s1[2] + s2[4]) & ~0xFF) | 36;
            g[13] = (sortable(s1[3] + s2[0]) & ~0xFF) | 48;
            g[14] = (sortable(s1[3] + s2[1]) & ~0xFF) | 49;
            g[15] = (sortable(s1[3] + s2[2]) & ~0xFF) | 50;
            oem_sort16_desc(g);
            merge_top16(top, g);
        }
        {
            int g[16];
            g[0] = (sortable(s1[3] + s2[3]) & ~0xFF) | 51;
            g[1] = (sortable(s1[4] + s2[0]) & ~0xFF) | 64;
            g[2] = (sortable(s1[4] + s2[1]) & ~0xFF) | 65;
            g[3] = (sortable(s1[4] + s2[2]) & ~0xFF) | 66;
            g[4] = (sortable(s1[5] + s2[0]) & ~0xFF) | 80;
            g[5] = (sortable(s1[5] + s2[1]) & ~0xFF) | 81;
            g[6] = (sortable(s1[6] + s2[0]) & ~0xFF) | 96;
            g[7] = (sortable(s1[6] + s2[1]) & ~0xFF) | 97;
            g[8] = (sortable(s1[7] + s2[0]) & ~0xFF) | 112;
            g[9] = (sortable(s1[7] + s2[1]) & ~0xFF) | 113;
            g[10] = (sortable(s1[8] + s2[0]) & ~0xFF) | 128;
            g[11] = (sortable(s1[9] + s2[0]) & ~0xFF) | 144;
            g[12] = (sortable(s1[10] + s2[0]) & ~0xFF) | 160;
            g[13] = (sortable(s1[11] + s2[0]) & ~0xFF) | 176;
            g[14] = (sortable(s1[12] + s2[0]) & ~0xFF) | 192;
            g[15] = (sortable(s1[13] + s2[0]) & ~0xFF) | 208;
            oem_sort16_desc(g);
            merge_top16(top, g);
        }
        top16_insert(top, (sortable(s1[14] + s2[0]) & ~0xFF) | 224);
        top16_insert(top, (sortable(s1[15] + s2[0]) & ~0xFF) | 240);
        float vals[16], sum = 0.f;
        const float mx = unsortable(top[0] & ~0xFF);
#pragma unroll
        for (int j = 0; j < 16; ++j) { vals[j] = __expf(unsortable(top[j] & ~0xFF) - mx); sum += vals[j]; }
        const float inv = 1.0f / sum;
        int ei[16]; float su[16];
#pragma unroll
        for (int j = 0; j < 16; ++j) {
            const int pr = top[j] & 0xFF;
            ei[j] = lst[pr >> 4] * 128 + lst[16 + (pr & 15)];
            vals[j] *= inv * scv[ei[j]];
            su[j] = scu[ei[j]];
        }
        int4* de = (int4*)(eidx + (size_t)tt * 128 + hd * 16);
        float4* dg = (float4*)(gate + (size_t)tt * 128 + hd * 16);
        float4* ds = (float4*)(sub + (size_t)tt * 128 + hd * 16);
#pragma unroll
        for (int q = 0; q < 4; ++q) {
            de[q] = make_int4(ei[q * 4], ei[q * 4 + 1], ei[q * 4 + 2], ei[q * 4 + 3]);
            dg[q] = make_float4(vals[q * 4], vals[q * 4 + 1], vals[q * 4 + 2], vals[q * 4 + 3]);
            ds[q] = make_float4(su[q * 4], su[q * 4 + 1], su[q * 4 + 2], su[q * 4 + 3]);
        }
    }
}

typedef __attribute__((ext_vector_type(2))) float f32x2;
__device__ __forceinline__ float dot16_fp8(const float (&hf)[16], const uint4& u) {
    f32x2 d = f32x2{0.f, 0.f};
    const unsigned wv[4] = {u.x, u.y, u.z, u.w};
#pragma unroll
    for (int i = 0; i < 4; ++i) {
        const f32x2 lo = __builtin_amdgcn_cvt_pk_f32_fp8((int)wv[i], false), hi = __builtin_amdgcn_cvt_pk_f32_fp8((int)wv[i], true);
        d = __builtin_elementwise_fma(f32x2{hf[4 * i], hf[4 * i + 1]}, lo, d);
        d = __builtin_elementwise_fma(f32x2{hf[4 * i + 2], hf[4 * i + 3]}, hi, d);
    }
    return d.x + d.y;
}
__device__ __forceinline__ void axpy16_fp8(float (&acc)[16], float a, const uint4& v) {
    const unsigned wv[4] = {v.x, v.y, v.z, v.w};
    const f32x2 aa = f32x2{a, a};
#pragma unroll
    for (int i = 0; i < 4; ++i) {
        const f32x2 lo = __builtin_amdgcn_cvt_pk_f32_fp8((int)wv[i], false), hi = __builtin_amdgcn_cvt_pk_f32_fp8((int)wv[i], true);
        f32x2 c0 = f32x2{acc[4 * i], acc[4 * i + 1]}, c1 = f32x2{acc[4 * i + 2], acc[4 * i + 3]};
        c0 = __builtin_elementwise_fma(aa, lo, c0); c1 = __builtin_elementwise_fma(aa, hi, c1);
        acc[4 * i] = c0.x; acc[4 * i + 1] = c0.y; acc[4 * i + 2] = c1.x; acc[4 * i + 3] = c1.y;
    }
}

struct XccSplit { int rank, nloc, np; unsigned pop; int myx; };
__device__ __forceinline__ XccSplit xcc_split(const Params& p, unsigned char* smem) {
    XccSplit s;
    volatile LAS_ unsigned* st = (volatile LAS_ unsigned*)(smem + SMEM_BYTES - 16);
    s.nloc = (int)st[0]; s.rank = (int)st[2];
    s.myx = (int)((unsigned)__builtin_amdgcn_s_getreg((3 << 11) | 20) & 0xFu);
    const unsigned* bar = (const unsigned*)(p.ws + OFF_BAR);
    s.np = 0; s.pop = 0u;
#pragma unroll
    for (int j = 0; j < 16; ++j) {
        const unsigned c = __hip_atomic_load(bar + 256 + 64 * j, __ATOMIC_RELAXED, __HIP_MEMORY_SCOPE_AGENT);
        if (c > 0u && s.np < 8) { s.pop |= (unsigned)j << (4 * s.np); ++s.np; }
    }
    if (s.np < 1) s.np = 1;
    if (s.nloc < 1) s.nloc = 1;
    return s;
}
__device__ __forceinline__ int xcc_owner(const XccSplit& s, int slice) { return (int)((s.pop >> (4 * (slice % s.np))) & 0xFu); }

__device__ __forceinline__ long pack64(unsigned lo, unsigned hi) { return (long)(((unsigned long long)hi << 32) | (unsigned long long)lo); }
struct M1Tok { int e0, e1; float g0, g1, s0, s1; };
__device__ __forceinline__ M1Tok m1_load(const int* eidx, const float* gate, const float* su, int tt, int lane) {
    M1Tok t;
    t.e0 = eidx[(size_t)tt * 128 + lane]; t.e1 = eidx[(size_t)tt * 128 + 64 + lane];
    t.g0 = gate[(size_t)tt * 128 + lane]; t.g1 = gate[(size_t)tt * 128 + 64 + lane];
    t.s0 = su[(size_t)tt * 128 + lane]; t.s1 = su[(size_t)tt * 128 + 64 + lane];
    return t;
}
struct M1S { int tt, nn, nbat, ce0, cg0, cs0, cj0, ce1, cg1, cs1, cj1; };

__device__ void phase_M1(const Params& p, int L, unsigned char* smem, bool dry) {
    const int lane = TIDX & 63, w = __builtin_amdgcn_readfirstlane(TIDX >> 6), lr = lane & 15, g = lane >> 4;
    const int mtok = (L == 0) ? TT : T;
    const XccSplit xs = xcc_split(p, smem);
    const unsigned char* h8 = p.ws + OFF_H8;
    const unsigned char* pu = p.ws + OFF_PEERU;
    const int* eidx = (const int*)(p.ws + OFF_EIDX);
    float* gate = (float*)(p.ws + OFF_GATE);
    const float* su = (const float*)(p.ws + OFF_SU);
    LAS_ unsigned char* rbuf = (LAS_ unsigned char*)smem + w * 19968;
    LAS_ unsigned char* hbuf = rbuf + 16384;
    LAS_ int* cl = (LAS_ int*)(rbuf + 18432);
    const int q = lr & 7, hh = lr >> 3;
    const int dma_c0 = lane ^ (((lane >> 5) & 1) << 3);
    const int rd_base = q * 1024;
    const int rd_x = q ^ (hh << 3), rd_c = hh * 32 + g;
    const int jsel = (lr >> 1) & 3;
    const int pull = (16 * ((lane >> 2) & 1) + 2 * (lane & 3)) << 2;
    const int hrd = (lr & 1) * 512 + 16 * g;

    auto prepare = [&](M1S& S, const M1Tok& raw, int tt, int sl) {
        const int pe0 = uperm(raw.e0), pe1 = uperm(raw.e1);
        const bool in0 = (pe0 >> 11) == sl, in1 = (pe1 >> 11) == sl;
        const unsigned long long m0 = __ballot(in0), m1 = __ballot(in1);
        const int n0 = __builtin_popcountll(m0), n = n0 + __builtin_popcountll(m1);
        const int r0 = __builtin_amdgcn_mbcnt_hi((unsigned)(m0 >> 32), __builtin_amdgcn_mbcnt_lo((unsigned)m0, 0u));
        const int r1 = n0 + __builtin_amdgcn_mbcnt_hi((unsigned)(m1 >> 32), __builtin_amdgcn_mbcnt_lo((unsigned)m1, 0u));
        asm volatile("s_waitcnt lgkmcnt(0)" ::: "memory");
        if (in0) { cl[r0] = pe0 | (lane << 16); cl[128 + r0] = __builtin_bit_cast(int, raw.g0); cl[256 + r0] = __builtin_bit_cast(int, raw.s0); }
        if (in1) { cl[r1] = pe1 | ((64 + lane) << 16); cl[128 + r1] = __builtin_bit_cast(int, raw.g1); cl[256 + r1] = __builtin_bit_cast(int, raw.s1); }
        asm volatile("s_waitcnt lgkmcnt(0)" ::: "memory");
        const int dummy = sl * 2048;
        int a0 = cl[lane], a1 = cl[64 + lane];
        S.cg0 = cl[128 + lane]; S.cg1 = cl[192 + lane]; S.cs0 = cl[256 + lane]; S.cs1 = cl[320 + lane];
        asm volatile("s_waitcnt lgkmcnt(0)" ::: "memory");
        if (lane >= n) { a0 = dummy; S.cg0 = 0; S.cs0 = 0; }
        if (64 + lane >= n) { a1 = dummy; S.cg1 = 0; S.cs1 = 0; }
        S.ce0 = a0 & 0xFFFF; S.cj0 = a0 >> 16; S.ce1 = a1 & 0xFFFF; S.cj1 = a1 >> 16;
        S.nn = n; S.nbat = (n + 7) >> 3; S.tt = tt;
    };
    auto raw_dma = [&](int tt) {
        const unsigned char* s0 = (lane < 32) ? (const unsigned char*)(eidx + (size_t)tt * 128) + lane * 16 : (const unsigned char*)(gate + (size_t)tt * 128) + (lane - 32) * 16;
        __builtin_amdgcn_global_load_lds((const unsigned*)s0, (LAS_ unsigned*)(cl), 16, 0, 0);
        if (lane < 32) __builtin_amdgcn_global_load_lds((const unsigned*)((const unsigned char*)(su + (size_t)tt * 128) + lane * 16), (LAS_ unsigned*)(cl + 256), 16, 0, 0);
    };
    auto raw_from_lds = [&]() {
        M1Tok t;
        t.e0 = cl[lane]; t.e1 = cl[64 + lane];
        t.g0 = __builtin_bit_cast(float, cl[128 + lane]); t.g1 = __builtin_bit_cast(float, cl[192 + lane]);
        t.s0 = __builtin_bit_cast(float, cl[256 + lane]); t.s1 = __builtin_bit_cast(float, cl[320 + lane]);
        asm volatile("s_waitcnt lgkmcnt(0)" ::: "memory");
        return t;
    };
    auto issue = [&](const M1S& S, int j, int gidx) {
        const int cesel = (j < 8) ? S.ce0 : S.ce1;
#pragma unroll
        for (int qq = 0; qq < 8; ++qq) {
            const int e = __builtin_amdgcn_readlane(cesel, (j * 8 + qq) & 63);
            __builtin_amdgcn_global_load_lds((const unsigned*)(pu + (size_t)e * 1024 + 16 * (dma_c0 ^ qq)),
                                             (LAS_ unsigned*)(rbuf + (gidx & 1) * 8192 + qq * 1024), 16, 0, 0);
        }
    };

#pragma unroll 1
    for (int sl = 0; sl < 8; ++sl) {
        if (xcc_owner(xs, sl) != xs.myx) continue;
        const int nb = mtok / 8;
        int tb = xs.rank;
        if (tb >= nb) continue;
        M1S S, N;
        int tpar = 0;
        {
            const M1Tok raw0 = m1_load(eidx, gate, su, tb * 8 + w, lane);
            __builtin_amdgcn_global_load_lds((const unsigned*)(h8 + (size_t)(tb * 8 + w) * 1024 + lane * 16), (LAS_ unsigned*)(hbuf), 16, 0, 0);
            prepare(S, raw0, tb * 8 + w, sl);
        }
        bool hasN = tb + xs.nloc < nb;
        if (hasN) raw_dma((tb + xs.nloc) * 8 + w);
        int gb = 0, isS = 0, isN = 0;
        while (isS < 2 && isS < S.nbat) { issue(S, isS, gb + isS); ++isS; }
        N.nbat = 0;
        bool first = true;
#pragma unroll 1
        for (;;) {
            isN = 0;
            if (hasN) {
                const int ttN = (tb + xs.nloc) * 8 + w;
                if (first || isS == 0) asm volatile("s_waitcnt vmcnt(0)" ::: "memory");
                else if (isS == 1) asm volatile("s_waitcnt vmcnt(8)" ::: "memory");
                else asm volatile("s_waitcnt vmcnt(16)" ::: "memory");
                const M1Tok rawN = raw_from_lds();
                prepare(N, rawN, ttN, sl);
                __builtin_amdgcn_global_load_lds((const unsigned*)(h8 + (size_t)ttN * 1024 + lane * 16), (LAS_ unsigned*)(hbuf + (tpar ^ 1) * 1024), 16, 0, 0);
                if (tb + 2 * xs.nloc < nb) raw_dma((tb + 2 * xs.nloc) * 8 + w);
            }
            u32x4_t hbv[8];
            float* grow = gate + (size_t)S.tt * 128;
            float D0 = 0.f, D1 = 0.f;
#pragma unroll 1
            for (int b = 0; b < S.nbat; ++b) {
                const int after = (isS - b - 1) + isN;
                if (b == 0) {
                    if (first || !hasN) { if (after > 0) asm volatile("s_waitcnt vmcnt(8)" ::: "memory"); else asm volatile("s_waitcnt vmcnt(0)" ::: "memory"); }
                    else if (tb + 2 * xs.nloc < nb) { if (after > 0) asm volatile("s_waitcnt vmcnt(11)" ::: "memory"); else asm volatile("s_waitcnt vmcnt(3)" ::: "memory"); }
                    else { if (after > 0) asm volatile("s_waitcnt vmcnt(9)" ::: "memory"); else asm volatile("s_waitcnt vmcnt(1)" ::: "memory"); }
                    if (first && hasN) asm volatile("s_waitcnt vmcnt(0)" ::: "memory");
#pragma unroll
                    for (int i = 0; i < 8; ++i) hbv[i] = *(const LAS_ u32x4_t*)(hbuf + tpar * 1024 + hrd + 64 * i);
                } else {
                    if (after > 0) asm volatile("s_waitcnt vmcnt(8)" ::: "memory"); else asm volatile("s_waitcnt vmcnt(0)" ::: "memory");
                }
                u32x4_t af[8];
                const LAS_ unsigned char* rb = rbuf + ((gb + b) & 1) * 8192 + rd_base;
#pragma unroll
                for (int i = 0; i < 8; ++i) af[i] = *(const LAS_ u32x4_t*)(rb + 16 * ((rd_c + 4 * i) ^ rd_x));
                asm volatile("s_waitcnt lgkmcnt(0)" ::: "memory");
                int cesel = 0, jx = 0, gx = 0; bool doref = false;
                if (isS < S.nbat) { cesel = (isS < 8) ? S.ce0 : S.ce1; jx = isS; gx = gb + isS; doref = true; ++isS; }
                else if (hasN && isN < 2 && isN < N.nbat) { cesel = (isN < 8) ? N.ce0 : N.ce1; jx = isN; gx = gb + S.nbat + isN; doref = true; ++isN; }
                f32x4 acc = f32x4{0.f, 0.f, 0.f, 0.f}, acc2 = f32x4{0.f, 0.f, 0.f, 0.f};
                if (doref) {
#pragma unroll
                    for (int i = 0; i < 8; ++i) {
                        acc = __builtin_amdgcn_mfma_f32_16x16x32_fp8_fp8(pack64(af[i][0], af[i][1]), pack64(hbv[i][0], hbv[i][1]), acc, 0, 0, 0);
                        acc2 = __builtin_amdgcn_mfma_f32_16x16x32_fp8_fp8(pack64(af[i][2], af[i][3]), pack64(hbv[i][2], hbv[i][3]), acc2, 0, 0, 0);
                        const int e = __builtin_amdgcn_readlane(cesel, (jx * 8 + i) & 63);
                        __builtin_amdgcn_global_load_lds((const unsigned*)(pu + (size_t)e * 1024 + 16 * (dma_c0 ^ i)),
                                                         (LAS_ unsigned*)(rbuf + (gx & 1) * 8192 + i * 1024), 16, 0, 0);
                        __builtin_amdgcn_sched_barrier(0);
                    }
                } else {
#pragma unroll
                    for (int i = 0; i < 8; ++i) {
                        acc = __builtin_amdgcn_mfma_f32_16x16x32_fp8_fp8(pack64(af[i][0], af[i][1]), pack64(hbv[i][0], hbv[i][1]), acc, 0, 0, 0);
                        acc2 = __builtin_amdgcn_mfma_f32_16x16x32_fp8_fp8(pack64(af[i][2], af[i][3]), pack64(hbv[i][2], hbv[i][3]), acc2, 0, 0, 0);
                    }
                }
                __builtin_amdgcn_sched_barrier(0);
                acc += acc2;
                const float sel = jsel == 0 ? acc[0] : (jsel == 1 ? acc[1] : (jsel == 2 ? acc[2] : acc[3]));
                const float dx = dpp_mov<0xF5>(sel);
                const auto sw = __builtin_amdgcn_permlane32_swap(__float_as_uint(dx), __float_as_uint(dx), false, false);
                const float dot = sel + __uint_as_float(sw[1]);
                const float pulled = __builtin_bit_cast(float, __builtin_amdgcn_ds_bpermute(pull, __builtin_bit_cast(int, dot)));
                if (b < 8) D0 = ((lane >> 3) == b) ? pulled : D0;
                else D1 = ((lane >> 3) == b - 8) ? pulled : D1;
            }
            if (S.nbat > 0) {
                const float a0 = gelu_tanh(D0 * __builtin_bit_cast(float, S.cs0) * 0.125f) * __builtin_bit_cast(float, S.cg0);
                if (lane < S.nn && (!dry || a0 == 1234.56789f)) grow[S.cj0] = a0;
                if (S.nn > 64) {
                    const float a1 = gelu_tanh(D1 * __builtin_bit_cast(float, S.cs1) * 0.125f) * __builtin_bit_cast(float, S.cg1);
                    if (64 + lane < S.nn && (!dry || a1 == 1234.56789f)) grow[S.cj1] = a1;
                }
            }
            if (!hasN) break;
            gb += S.nbat; S = N; isS = isN; tpar ^= 1; tb += xs.nloc; hasN = tb + xs.nloc < nb; first = false;
            while (isS < 2 && isS < S.nbat) { issue(S, isS, gb + isS); ++isS; }
        }
        asm volatile("s_waitcnt vmcnt(0) lgkmcnt(0)" ::: "memory");
    }
}

__device__ void phase_M2(const Params& p, int L, unsigned char* smem, bool dry) {
    const int lane = TIDX & 63, w = __builtin_amdgcn_readfirstlane(TIDX >> 6);
    const int mtok = (L == 0) ? TT : T;
    const XccSplit xs = xcc_split(p, smem);
    const unsigned char* pv = p.ws + OFF_PEERV;
    const int* eidx = (const int*)(p.ws + OFF_EIDX);
    const float* act = (const float*)(p.ws + OFF_GATE);
    const float* g2 = (const float*)(p.ws + OFF_MOD) + (size_t)L * 9 * 6144 + 5120;
    const int grp = lane >> 3, sub = lane & 7;
    const bool b0 = (grp & 1) != 0, b1 = (grp & 2) != 0, b2 = (grp & 4) != 0;
    LAS_ unsigned char* lbuf = (LAS_ unsigned char*)smem + w * 16384;
#pragma unroll 1
    for (int sl = 0; sl < 8; ++sl) {
        if (xcc_owner(xs, sl) != xs.myx) continue;
        const int colbase = sl * 128 + sub * 16;
        const unsigned char* pvsl = pv + (size_t)sl * (16384 * 128);
        const unsigned so = (unsigned)sub * 16u;
        const int col = colbase + (b0 ? 8 : 0) + (b1 ? 4 : 0) + (b2 ? 2 : 0);
        const int nb = mtok / 8;
        int tb = xs.rank;
        if (tb >= nb) continue;
        int evn[16];
        {
#pragma unroll
            for (int i = 0; i < 16; ++i) evn[i] = eidx[(size_t)(tb * 8 + w) * 128 + i * 8 + grp];
#pragma unroll
            for (int i = 0; i < 16; ++i)
                __builtin_amdgcn_global_load_lds((const unsigned*)(pvsl + ((unsigned)evn[i] * 128u + so)), (LAS_ unsigned*)(lbuf + i * 1024), 16, 0, 0);
            const int tn = (tb + xs.nloc < nb) ? (tb + xs.nloc) * 8 + w : tb * 8 + w;
#pragma unroll
            for (int i = 0; i < 16; ++i) evn[i] = eidx[(size_t)tn * 128 + i * 8 + grp];
        }
#pragma unroll 1
        for (; tb < nb; tb += xs.nloc) {
            const int tt = tb * 8 + w;
            float* xr = (tt < T) ? (p.out + (size_t)tt * 1024) : ((float*)(p.ws + OFF_XCTX) + (size_t)(tt - T) * 1024);
            float2 gg = *(const float2*)(g2 + (size_t)tok_modrow(tt) * 6144 + col);
            float2 x = *(const float2*)(xr + col);
            float av[16];
#pragma unroll
            for (int i = 0; i < 16; ++i) av[i] = act[(size_t)tt * 128 + i * 8 + grp];
            asm volatile("s_waitcnt vmcnt(0)" ::: "memory");
#pragma unroll
            for (int i = 0; i < 16; ++i) { asm volatile("" : "+v"(av[i])); asm volatile("" : "+v"(evn[i])); }
            asm volatile("" : "+v"(gg.x), "+v"(gg.y), "+v"(x.x), "+v"(x.y));
            float acc[16];
#pragma unroll
            for (int d = 0; d < 16; ++d) acc[d] = 0.f;
            if (tb + xs.nloc < nb) {
                u32x4_t q0 = *(const LAS_ u32x4_t*)(lbuf + 0 * 1024 + lane * 16);
                u32x4_t q1 = *(const LAS_ u32x4_t*)(lbuf + 1 * 1024 + lane * 16);
                u32x4_t q2 = *(const LAS_ u32x4_t*)(lbuf + 2 * 1024 + lane * 16);
                asm volatile("s_waitcnt lgkmcnt(2)" ::: "memory");
                asm volatile("" : "+v"(q0[0]), "+v"(q0[1]), "+v"(q0[2]), "+v"(q0[3]));
                __builtin_amdgcn_global_load_lds((const unsigned*)(pvsl + ((unsigned)evn[0] * 128u + so)), (LAS_ unsigned*)(lbuf + 0 * 1024), 16, 0, 0);
                axpy16_fp8(acc, av[0], make_uint4(q0[0], q0[1], q0[2], q0[3]));
                u32x4_t q3 = *(const LAS_ u32x4_t*)(lbuf + 3 * 1024 + lane * 16);
                asm volatile("s_waitcnt lgkmcnt(2)" ::: "memory");
                asm volatile("" : "+v"(q1[0]), "+v"(q1[1]), "+v"(q1[2]), "+v"(q1[3]));
                __builtin_amdgcn_global_load_lds((const unsigned*)(pvsl + ((unsigned)evn[1] * 128u + so)), (LAS_ unsigned*)(lbuf + 1 * 1024), 16, 0, 0);
                axpy16_fp8(acc, av[1], make_uint4(q1[0], q1[1], q1[2], q1[3]));
                u32x4_t q4 = *(const LAS_ u32x4_t*)(lbuf + 4 * 1024 + lane * 16);
                asm volatile("s_waitcnt lgkmcnt(2)" ::: "memory");
                asm volatile("" : "+v"(q2[0]), "+v"(q2[1]), "+v"(q2[2]), "+v"(q2[3]));
                __builtin_amdgcn_global_load_lds((const unsigned*)(pvsl + ((unsigned)evn[2] * 128u + so)), (LAS_ unsigned*)(lbuf + 2 * 1024), 16, 0, 0);
                axpy16_fp8(acc, av[2], make_uint4(q2[0], q2[1], q2[2], q2[3]));
                u32x4_t q5 = *(const LAS_ u32x4_t*)(lbuf + 5 * 1024 + lane * 16);
                asm volatile("s_waitcnt lgkmcnt(2)" ::: "memory");
                asm volatile("" : "+v"(q3[0]), "+v"(q3[1]), "+v"(q3[2]), "+v"(q3[3]));
                __builtin_amdgcn_global_load_lds((const unsigned*)(pvsl + ((unsigned)evn[3] * 128u + so)), (LAS_ unsigned*)(lbuf + 3 * 1024), 16, 0, 0);
                axpy16_fp8(acc, av[3], make_uint4(q3[0], q3[1], q3[2], q3[3]));
                u32x4_t q6 = *(const LAS_ u32x4_t*)(lbuf + 6 * 1024 + lane * 16);
                asm volatile("s_waitcnt lgkmcnt(2)" ::: "memory");
                asm volatile("" : "+v"(q4[0]), "+v"(q4[1]), "+v"(q4[2]), "+v"(q4[3]));
                __builtin_amdgcn_global_load_lds((const unsigned*)(pvsl + ((unsigned)evn[4] * 128u + so)), (LAS_ unsigned*)(lbuf + 4 * 1024), 16, 0, 0);
                axpy16_fp8(acc, av[4], make_uint4(q4[0], q4[1], q4[2], q4[3]));
                u32x4_t q7 = *(const LAS_ u32x4_t*)(lbuf + 7 * 1024 + lane * 16);
                asm volatile("s_waitcnt lgkmcnt(2)" ::: "memory");
                asm volatile("" : "+v"(q5[0]), "+v"(q5[1]), "+v"(q5[2]), "+v"(q5[3]));
                __builtin_amdgcn_global_load_lds((const unsigned*)(pvsl + ((unsigned)evn[5] * 128u + so)), (LAS_ unsigned*)(lbuf + 5 * 1024), 16, 0, 0);
                axpy16_fp8(acc, av[5], make_uint4(q5[0], q5[1], q5[2], q5[3]));
                u32x4_t q8 = *(const LAS_ u32x4_t*)(lbuf + 8 * 1024 + lane * 16);
                asm volatile("s_waitcnt lgkmcnt(2)" ::: "memory");
                asm volatile("" : "+v"(q6[0]), "+v"(q6[1]), "+v"(q6[2]), "+v"(q6[3]));
                __builtin_amdgcn_global_load_lds((const unsigned*)(pvsl + ((unsigned)evn[6] * 128u + so)), (LAS_ unsigned*)(lbuf + 6 * 1024), 16, 0, 0);
                axpy16_fp8(acc, av[6], make_uint4(q6[0], q6[1], q6[2], q6[3]));
                u32x4_t q9 = *(const LAS_ u32x4_t*)(lbuf + 9 * 1024 + lane * 16);
                asm volatile("s_waitcnt lgkmcnt(2)" ::: "memory");
                asm volatile("" : "+v"(q7[0]), "+v"(q7[1]), "+v"(q7[2]), "+v"(q7[3]));
                __builtin_amdgcn_global_load_lds((const unsigned*)(pvsl + ((unsigned)evn[7] * 128u + so)), (LAS_ unsigned*)(lbuf + 7 * 1024), 16, 0, 0);
                axpy16_fp8(acc, av[7], make_uint4(q7[0], q7[1], q7[2], q7[3]));
                u32x4_t q10 = *(const LAS_ u32x4_t*)(lbuf + 10 * 1024 + lane * 16);
                asm volatile("s_waitcnt lgkmcnt(2)" ::: "memory");
                asm volatile("" : "+v"(q8[0]), "+v"(q8[1]), "+v"(q8[2]), "+v"(q8[3]));
                __builtin_amdgcn_global_load_lds((const unsigned*)(pvsl + ((unsigned)evn[8] * 128u + so)), (LAS_ unsigned*)(lbuf + 8 * 1024), 16, 0, 0);
                axpy16_fp8(acc, av[8], make_uint4(q8[0], q8[1], q8[2], q8[3]));
                u32x4_t q11 = *(const LAS_ u32x4_t*)(lbuf + 11 * 1024 + lane * 16);
                asm volatile("s_waitcnt lgkmcnt(2)" ::: "memory");
                asm volatile("" : "+v"(q9[0]), "+v"(q9[1]), "+v"(q9[2]), "+v"(q9[3]));
                __builtin_amdgcn_global_load_lds((const unsigned*)(pvsl + ((unsigned)evn[9] * 128u + so)), (LAS_ unsigned*)(lbuf + 9 * 1024), 16, 0, 0);
                axpy16_fp8(acc, av[9], make_uint4(q9[0], q9[1], q9[2], q9[3]));
                u32x4_t q12 = *(const LAS_ u32x4_t*)(lbuf + 12 * 1024 + lane * 16);
                asm volatile("s_waitcnt lgkmcnt(2)" ::: "memory");
                asm volatile("" : "+v"(q10[0]), "+v"(q10[1]), "+v"(q10[2]), "+v"(q10[3]));
                __builtin_amdgcn_global_load_lds((const unsigned*)(pvsl + ((unsigned)evn[10] * 128u + so)), (LAS_ unsigned*)(lbuf + 10 * 1024), 16, 0, 0);
                axpy16_fp8(acc, av[10], make_uint4(q10[0], q10[1], q10[2], q10[3]));
                u32x4_t q13 = *(const LAS_ u32x4_t*)(lbuf + 13 * 1024 + lane * 16);
                asm volatile("s_waitcnt lgkmcnt(2)" ::: "memory");
                asm volatile("" : "+v"(q11[0]), "+v"(q11[1]), "+v"(q11[2]), "+v"(q11[3]));
                __builtin_amdgcn_global_load_lds((const unsigned*)(pvsl + ((unsigned)evn[11] * 128u + so)), (LAS_ unsigned*)(lbuf + 11 * 1024), 16, 0, 0);
                axpy16_fp8(acc, av[11], make_uint4(q11[0], q11[1], q11[2], q11[3]));
                u32x4_t q14 = *(const LAS_ u32x4_t*)(lbuf + 14 * 1024 + lane * 16);
                asm volatile("s_waitcnt lgkmcnt(2)" ::: "memory");
                asm volatile("" : "+v"(q12[0]), "+v"(q12[1]), "+v"(q12[2]), "+v"(q12[3]));
                __builtin_amdgcn_global_load_lds((const unsigned*)(pvsl + ((unsigned)evn[12] * 128u + so)), (LAS_ unsigned*)(lbuf + 12 * 1024), 16, 0, 0);
                axpy16_fp8(acc, av[12], make_uint4(q12[0], q12[1], q12[2], q12[3]));
                u32x4_t q15 = *(const LAS_ u32x4_t*)(lbuf + 15 * 1024 + lane * 16);
                asm volatile("s_waitcnt lgkmcnt(2)" ::: "memory");
                asm volatile("" : "+v"(q13[0]), "+v"(q13[1]), "+v"(q13[2]), "+v"(q13[3]));
                __builtin_amdgcn_global_load_lds((const unsigned*)(pvsl + ((unsigned)evn[13] * 128u + so)), (LAS_ unsigned*)(lbuf + 13 * 1024), 16, 0, 0);
                axpy16_fp8(acc, av[13], make_uint4(q13[0], q13[1], q13[2], q13[3]));
                asm volatile("s_waitcnt lgkmcnt(1)" ::: "memory");
                asm volatile("" : "+v"(q14[0]), "+v"(q14[1]), "+v"(q14[2]), "+v"(q14[3]));
                __builtin_amdgcn_global_load_lds((const unsigned*)(pvsl + ((unsigned)evn[14] * 128u + so)), (LAS_ unsigned*)(lbuf + 14 * 1024), 16, 0, 0);
                axpy16_fp8(acc, av[14], make_uint4(q14[0], q14[1], q14[2], q14[3]));
                asm volatile("s_waitcnt lgkmcnt(0)" ::: "memory");
                asm volatile("" : "+v"(q15[0]), "+v"(q15[1]), "+v"(q15[2]), "+v"(q15[3]));
                __builtin_amdgcn_global_load_lds((const unsigned*)(pvsl + ((unsigned)evn[15] * 128u + so)), (LAS_ unsigned*)(lbuf + 15 * 1024), 16, 0, 0);
                axpy16_fp8(acc, av[15], make_uint4(q15[0], q15[1], q15[2], q15[3]));
            } else {
                u32x4_t q0 = *(const LAS_ u32x4_t*)(lbuf + 0 * 1024 + lane * 16);
                u32x4_t q1 = *(const LAS_ u32x4_t*)(lbuf + 1 * 1024 + lane * 16);
                u32x4_t q2 = *(const LAS_ u32x4_t*)(lbuf + 2 * 1024 + lane * 16);
                asm volatile("s_waitcnt lgkmcnt(2)" ::: "memory");
                asm volatile("" : "+v"(q0[0]), "+v"(q0[1]), "+v"(q0[2]), "+v"(q0[3]));
                axpy16_fp8(acc, av[0], make_uint4(q0[0], q0[1], q0[2], q0[3]));
                u32x4_t q3 = *(const LAS_ u32x4_t*)(lbuf + 3 * 1024 + lane * 16);
                asm volatile("s_waitcnt lgkmcnt(2)" ::: "memory");
                asm volatile("" : "+v"(q1[0]), "+v"(q1[1]), "+v"(q1[2]), "+v"(q1[3]));
                axpy16_fp8(acc, av[1], make_uint4(q1[0], q1[1], q1[2], q1[3]));
                u32x4_t q4 = *(const LAS_ u32x4_t*)(lbuf + 4 * 1024 + lane * 16);
                asm volatile("s_waitcnt lgkmcnt(2)" ::: "memory");
                asm volatile("" : "+v"(q2[0]), "+v"(q2[1]), "+v"(q2[2]), "+v"(q2[3]));
                axpy16_fp8(acc, av[2], make_uint4(q2[0], q2[1], q2[2], q2[3]));
                u32x4_t q5 = *(const LAS_ u32x4_t*)(lbuf + 5 * 1024 + lane * 16);
                asm volatile("s_waitcnt lgkmcnt(2)" ::: "memory");
                asm volatile("" : "+v"(q3[0]), "+v"(q3[1]), "+v"(q3[2]), "+v"(q3[3]));
                axpy16_fp8(acc, av[3], make_uint4(q3[0], q3[1], q3[2], q3[3]));
                u32x4_t q6 = *(const LAS_ u32x4_t*)(lbuf + 6 * 1024 + lane * 16);
                asm volatile("s_waitcnt lgkmcnt(2)" ::: "memory");
                asm volatile("" : "+v"(q4[0]), "+v"(q4[1]), "+v"(q4[2]), "+v"(q4[3]));
                axpy16_fp8(acc, av[4], make_uint4(q4[0], q4[1], q4[2], q4[3]));
                u32x4_t q7 = *(const LAS_ u32x4_t*)(lbuf + 7 * 1024 + lane * 16);
                asm volatile("s_waitcnt lgkmcnt(2)" ::: "memory");
                asm volatile("" : "+v"(q5[0]), "+v"(q5[1]), "+v"(q5[2]), "+v"(q5[3]));
                axpy16_fp8(acc, av[5], make_uint4(q5[0], q5[1], q5[2], q5[3]));
                u32x4_t q8 = *(const LAS_ u32x4_t*)(lbuf + 8 * 1024 + lane * 16);
                asm volatile("s_waitcnt lgkmcnt(2)" ::: "memory");
                asm volatile("" : "+v"(q6[0]), "+v"(q6[1]), "+v"(q6[2]), "+v"(q6[3]));
                axpy16_fp8(acc, av[6], make_uint4(q6[0], q6[1], q6[2], q6[3]));
                u32x4_t q9 = *(const LAS_ u32x4_t*)(lbuf + 9 * 1024 + lane * 16);
                asm volatile("s_waitcnt lgkmcnt(2)" ::: "memory");
                asm volatile("" : "+v"(q7[0]), "+v"(q7[1]), "+v"(q7[2]), "+v"(q7[3]));
                axpy16_fp8(acc, av[7], make_uint4(q7[0], q7[1], q7[2], q7[3]));
                u32x4_t q10 = *(const LAS_ u32x4_t*)(lbuf + 10 * 1024 + lane * 16);
                asm volatile("s_waitcnt lgkmcnt(2)" ::: "memory");
                asm volatile("" : "+v"(q8[0]), "+v"(q8[1]), "+v"(q8[2]), "+v"(q8[3]));
                axpy16_fp8(acc, av[8], make_uint4(q8[0], q8[1], q8[2], q8[3]));
                u32x4_t q11 = *(const LAS_ u32x4_t*)(lbuf + 11 * 1024 + lane * 16);
                asm volatile("s_waitcnt lgkmcnt(2)" ::: "memory");
                asm volatile("" : "+v"(q9[0]), "+v"(q9[1]), "+v"(q9[2]), "+v"(q9[3]));
                axpy16_fp8(acc, av[9], make_uint4(q9[0], q9[1], q9[2], q9[3]));
                u32x4_t q12 = *(const LAS_ u32x4_t*)(lbuf + 12 * 1024 + lane * 16);
                asm volatile("s_waitcnt lgkmcnt(2)" ::: "memory");
                asm volatile("" : "+v"(q10[0]), "+v"(q10[1]), "+v"(q10[2]), "+v"(q10[3]));
                axpy16_fp8(acc, av[10], make_uint4(q10[0], q10[1], q10[2], q10[3]));
                u32x4_t q13 = *(const LAS_ u32x4_t*)(lbuf + 13 * 1024 + lane * 16);
                asm volatile("s_waitcnt lgkmcnt(2)" ::: "memory");
                asm volatile("" : "+v"(q11[0]), "+v"(q11[1]), "+v"(q11[2]), "+v"(q11[3]));
                axpy16_fp8(acc, av[11], make_uint4(q11[0], q11[1], q11[2], q11[3]));
                u32x4_t q14 = *(const LAS_ u32x4_t*)(lbuf + 14 * 1024 + lane * 16);
                asm volatile("s_waitcnt lgkmcnt(2)" ::: "memory");
                asm volatile("" : "+v"(q12[0]), "+v"(q12[1]), "+v"(q12[2]), "+v"(q12[3]));
                axpy16_fp8(acc, av[12], make_uint4(q12[0], q12[1], q12[2], q12[3]));
                u32x4_t q15 = *(const LAS_ u32x4_t*)(lbuf + 15 * 1024 + lane * 16);
                asm volatile("s_waitcnt lgkmcnt(2)" ::: "memory");
                asm volatile("" : "+v"(q13[0]), "+v"(q13[1]), "+v"(q13[2]), "+v"(q13[3]));
                axpy16_fp8(acc, av[13], make_uint4(q13[0], q13[1], q13[2], q13[3]));
                asm volatile("s_waitcnt lgkmcnt(1)" ::: "memory");
                asm volatile("" : "+v"(q14[0]), "+v"(q14[1]), "+v"(q14[2]), "+v"(q14[3]));
                axpy16_fp8(acc, av[14], make_uint4(q14[0], q14[1], q14[2], q14[3]));
                asm volatile("s_waitcnt lgkmcnt(0)" ::: "memory");
                asm volatile("" : "+v"(q15[0]), "+v"(q15[1]), "+v"(q15[2]), "+v"(q15[3]));
                axpy16_fp8(acc, av[15], make_uint4(q15[0], q15[1], q15[2], q15[3]));
            }
            if (tb + 2 * xs.nloc < nb) {
                const int tn = (tb + 2 * xs.nloc) * 8 + w;
#pragma unroll
                for (int i = 0; i < 16; ++i) evn[i] = eidx[(size_t)tn * 128 + i * 8 + grp];
            }
            float r8[8], r4[4], r2[2];
#pragma unroll
            for (int k = 0; k < 8; ++k) { const float keep = b0 ? acc[8 + k] : acc[k], send = b0 ? acc[k] : acc[8 + k]; r8[k] = keep + xor_swz<8>(send); }
#pragma unroll
            for (int k = 0; k < 4; ++k) r4[k] = bfly16(r8[k], r8[4 + k]);
#pragma unroll
            for (int k = 0; k < 2; ++k) r2[k] = bfly32(r4[k], r4[2 + k]);
            x.x += gg.x * r2[0]; x.y += gg.y * r2[1];
            if (!dry || x.x == 1234.56789f) *(float2*)(xr + col) = x;
        }
        asm volatile("s_waitcnt vmcnt(0)" ::: "memory");
    }
}

__device__ void phase_Z(const Params& p) {
    const int lane = TIDX & 63, w = TIDX >> 6;
    const float* fg = p.in[I_FING];
    float4 fq[4];
#pragma unroll
    for (int i = 0; i < 4; ++i) fq[i] = *(const float4*)(fg + (i * 64 + lane) * 4);
    for (int it = BIDX; it < T / 8; it += gridDim.x) {
        float* xr = p.out + (size_t)(it * 8 + w) * 1024;
        float4 v[4]; float ss = 0.f;
#pragma unroll
        for (int i = 0; i < 4; ++i) { v[i] = *(const float4*)(xr + (i * 64 + lane) * 4); ss += v[i].x * v[i].x + v[i].y * v[i].y + v[i].z * v[i].z + v[i].w * v[i].w; }
        ss = wave_sum(ss);
        const float r = rsqrtf(ss * (1.0f / 1024.0f) + EPS);
#pragma unroll
        for (int i = 0; i < 4; ++i) {
            const float4 g = fq[i];
            *(float4*)(xr + (i * 64 + lane) * 4) = make_float4(v[i].x * r * g.x, v[i].y * r * g.y, v[i].z * r * g.z, v[i].w * r * g.w);
        }
    }
}

#define XB_TMO      128
#define XB_XCNT(j)  (256  + 64 * (j))
#define XB_XSUB(j)  (1280 + 64 * (j))
#define XB_XGEN(j)  (2304 + 64 * (j))
#define XB_TOP      3328
#define XB_TOPGEN   3392
#define XCD_BAR_WORDS 3456
#define XB_SPIN_CAP (1u << 22)
#define LAS __attribute__((address_space(3)))
__device__ __forceinline__ unsigned xb_ld(unsigned* p)              { return __hip_atomic_load(p, __ATOMIC_RELAXED, __HIP_MEMORY_SCOPE_AGENT); }
__device__ __forceinline__ unsigned xb_add(unsigned* p, unsigned v) { return __hip_atomic_fetch_add(p, v, __ATOMIC_RELAXED, __HIP_MEMORY_SCOPE_AGENT); }
__device__ __forceinline__ unsigned xb_xcc_id() { return (unsigned)__builtin_amdgcn_s_getreg((3 << 11) | 20) & 0xFu; }
#define XB_SPIN(cond, bar) do { unsigned _sp = 0; while (cond) { __builtin_amdgcn_s_sleep(1); \
    if ((++_sp & 255u) == 0u) { if (xb_ld(&(bar)[XB_TMO])) break; if (_sp > XB_SPIN_CAP) { atomicAdd(&(bar)[XB_TMO], 1u); break; } } } } while (0)
struct XcdBarrier { unsigned* bar; unsigned x; volatile LAS unsigned* st; };
__device__ __forceinline__ XcdBarrier xcd_barrier_post(unsigned* bar, volatile LAS unsigned* st) {
    XcdBarrier b; b.bar = bar; b.x = xb_xcc_id(); b.st = st;
    if (threadIdx.x == 0) st[2] = xb_add(&bar[XB_XCNT(b.x)], 1u);
    return b;
}
__device__ __forceinline__ void xcd_barrier_complete(unsigned* bar, unsigned x, unsigned& nloc, unsigned& nx) {
    const unsigned G = gridDim.x * gridDim.y * gridDim.z;
    unsigned sum, cnt, mine, sp = 0u;
    for (;;) {
        sum = 0u; cnt = 0u; mine = 0u;
#pragma unroll
        for (unsigned j = 0; j < 16; ++j) { const unsigned c = xb_ld(&bar[XB_XCNT(j)]); sum += c; cnt += (c > 0u) ? 1u : 0u; mine = (j == x) ? c : mine; }
        if (sum == G) break;
        __builtin_amdgcn_s_sleep(1);
        if ((++sp & 255u) == 0u) { if (xb_ld(&bar[XB_TMO])) break; if (sp > XB_SPIN_CAP) { atomicAdd(&bar[XB_TMO], 1u); break; } }
    }
    nloc = mine > 0u ? mine : 1u; nx = cnt > 0u ? cnt : 1u;
}
__device__ __forceinline__ void xcd_barrier(const XcdBarrier& b) {
    asm volatile("s_waitcnt vmcnt(0)" ::: "memory");
    __syncthreads();
    if (threadIdx.x == 0) {
        unsigned* bar = b.bar;
        __builtin_amdgcn_s_waitcnt(0);
        unsigned nloc = b.st[0], nx = b.st[1];
        if (nloc == 0u) { xcd_barrier_complete(bar, b.x, nloc, nx); b.st[0] = nloc; b.st[1] = nx; }
        const unsigned old = xb_add(&bar[XB_XSUB(b.x)], 1u);
        const unsigned gen = old / nloc;
        if (old + 1u == (gen + 1u) * nloc) {
            __builtin_amdgcn_fence(__ATOMIC_RELEASE, "agent");
            asm volatile("s_waitcnt vmcnt(0)" ::: "memory");
            const unsigned og = xb_add(&bar[XB_TOP], 1u);
            const unsigned tg = og / nx;
            if (og + 1u == (tg + 1u) * nx) xb_add(&bar[XB_TOPGEN], 1u);
            else XB_SPIN(xb_ld(&bar[XB_TOPGEN]) == tg, bar);
            __builtin_amdgcn_fence(__ATOMIC_ACQUIRE, "agent");
            xb_add(&bar[XB_XGEN(b.x)], 1u);
            asm volatile("s_waitcnt vmcnt(0)" ::: "memory");
        } else {
            XB_SPIN(xb_ld(&bar[XB_XGEN(b.x)]) == gen, bar);
            __builtin_amdgcn_fence(__ATOMIC_ACQUIRE, "agent");
            asm volatile("s_waitcnt vmcnt(0)" ::: "memory");
        }
    }
    __syncthreads();
}

constexpr int NPL = 13;
constexpr int N_PHASES = 1 + 2 * NPL + 1;

__device__ __forceinline__ void run_phase(const Params& p, int ph, unsigned char* smem, bool dry = false) {
    if (ph == 0) { phase_prep(p, smem, 0); return; }
    if (ph == N_PHASES - 1) { phase_Z(p); return; }
    const int L = (ph - 1) / NPL, s = (ph - 1) % NPL;
    switch (s) {
        case 0: phase_A(p, L, smem); break;
        case 1: phase_B(p, L, smem); break;
        case 2: phase_C(p, L, smem); break;
        case 3: phase_D(p, L, smem); break;
        case 4: phase_E(p, L, smem); break;
        case 5: phase_G(p, L, smem); break;
        case 6: phase_H(p, L); break;
        case 7: phase_I(p, L, smem); break;
        case 8: norm_tokens(p, L, 1, (L == 0) ? TT : T, false, 0, ((L == 0) ? TT : T) / 8); break;
        case 9: phase_K(p, L, smem); break;
        case 10: phase_L(p, L, smem); break;
        case 11: phase_M1(p, L, smem, dry); break;
        default: phase_M2(p, L, smem, dry); break;
    }
}

__global__ void __launch_bounds__(NTHREADS) fwd_megakernel(Params p) {
    extern __shared__ __attribute__((aligned(16))) unsigned char smem[];
    cg::grid_group grid = cg::this_grid();
    volatile LAS unsigned* xst = (volatile LAS unsigned*)(smem + SMEM_BYTES - 16);
    if (threadIdx.x == 0) { xst[0] = 0u; xst[1] = 0u; xst[2] = 0u; xst[3] = 0u; }
    __syncthreads();
    const XcdBarrier xb = xcd_barrier_post((unsigned*)(p.ws + OFF_BAR), xst);
    for (int ph = p.ph_lo; ph < p.ph_hi; ++ph) {
#if PROBE_MASK
        if (ph > 0 && ph < N_PHASES - 1 && ((PROBE_MASK >> ((ph - 1) % NPL)) & 1) && ((ph - 1) % NPL) >= 11) { run_phase(p, ph, smem, true); xcd_barrier(xb); }
#endif
        run_phase(p, ph, smem);
#if PROBE_MASK
        if (ph > 0 && ph < N_PHASES - 1 && ((PROBE_MASK >> ((ph - 1) % NPL)) & 1) && !(((ph - 1) % NPL) == 7 && ph > NPL)) {
            const int sidx = (ph - 1) % NPL;
            if (sidx < 11) { xcd_barrier(xb); run_phase(p, ph, smem); }
        }
#endif
        if (ph + 1 < p.ph_hi) {
            if (ph == p.ph_lo) grid.sync();
            else xcd_barrier(xb);
        }
    }
}

extern "C" void kernel_launch(void* const* d_in, const int* in_sizes, int n_in, void* d_out, int out_size, void* d_ws, size_t ws_size,
                              hipStream_t stream) {
    static int grid_blocks = 0;
    if (grid_blocks == 0) {
        if (n_in != 27 || out_size != T * D || ws_size < WS_END) {
            fprintf(stderr, "kernel_launch: unexpected problem (n_in %d, out %d, ws %zu, need %zu)\n", n_in, out_size, ws_size, (size_t)WS_END);
            grid_blocks = -1; return;
        }
        int dev = 0, cus = 0, per_cu = 0;
        hipGetDevice(&dev);
        hipDeviceGetAttribute(&cus, hipDeviceAttributeMultiprocessorCount, dev);
        hipFuncSetAttribute((const void*)fwd_megakernel, hipFuncAttributeMaxDynamicSharedMemorySize, SMEM_BYTES);
        hipOccupancyMaxActiveBlocksPerMultiprocessor(&per_cu, (const void*)fwd_megakernel, NTHREADS, SMEM_BYTES);
        if (per_cu < 1) { fprintf(stderr, "kernel_launch: occupancy query returned %d\n", per_cu); per_cu = 1; }
        if (per_cu > 1) per_cu = 1;
        grid_blocks = cus * per_cu;
    }
    if (grid_blocks < 0) return;
    if (hipMemsetAsync((char*)d_ws + OFF_BAR, 0, SZ_BAR, stream) != hipSuccess) { fprintf(stderr, "kernel_launch: memset of the barrier words failed\n"); return; }
    Params p{};
    for (int i = 0; i < 27; ++i) p.in[i] = (const float*)d_in[i];
    p.out = (float*)d_out; p.ws = (unsigned char*)d_ws;
#if SPLIT_LAUNCH
    for (int ph = 0; ph < N_PHASES; ++ph) {
        p.ph_lo = ph; p.ph_hi = ph + 1;
        void* args[] = {&p};
        hipError_t e = hipLaunchCooperativeKernel((const void*)fwd_megakernel, dim3(grid_blocks), dim3(NTHREADS), args, SMEM_BYTES, stream);
        if (e != hipSuccess) { fprintf(stderr, "launch failed: %s\n", hipGetErrorString(e)); return; }
    }
#else
    p.ph_lo = 0; p.ph_hi = N_PHASES;
    void* args[] = {&p};
    hipError_t e = hipLaunchCooperativeKernel((const void*)fwd_megakernel, dim3(grid_blocks), dim3(NTHREADS), args, SMEM_BYTES, stream);
    if (e != hipSuccess) fprintf(stderr, "cooperative launch failed: %s (grid %d)\n", hipGetErrorString(e), grid_blocks);
#endif
}
```
